# Optimizing an MI355X kernel written in HIP

```python
import jax, jax.numpy as jnp
from jax import lax
import numpy as np

D_MODEL = 1024
BATCH = 2
SEQ = 8192
DEPTH = 1

D_MIX = D_MODEL
GLA_WIDTH = D_MIX // 2
GLA_HEADS = 4
GLA_DV = GLA_WIDTH // GLA_HEADS
GLA_DK = GLA_DV // 2
GLA_KW = GLA_HEADS * GLA_DK
GLA_GATE_RANK = 16
GLA_TAU = 16.0
GLA_CHUNK = 64
ATT_WIDTH = D_MIX - GLA_WIDTH
ATT_HEADS = 8
ATT_HD = ATT_WIDTH // ATT_HEADS
ROT_DIM = ATT_HD // 4
ROPE_THETA = 500000.0
DILATED_PATTERNS = ((128, 1), (512, 4), (2048, 16))
ATT_BLOCK = 128
D_FF = 2816
EPS = 1e-6
IN_SIZES = (GLA_KW, GLA_KW, GLA_WIDTH, GLA_WIDTH, GLA_GATE_RANK, ATT_WIDTH, ATT_WIDTH, ATT_WIDTH)
D_IN = GLA_KW * 2 + GLA_WIDTH * 2 + GLA_GATE_RANK + ATT_WIDTH * 3

kernel_name = "hymba_gla_dilated_macaron_layer"


def rms_norm(x, g):
    xf = x.astype(jnp.float32)
    y = xf * lax.rsqrt(jnp.mean(xf * xf, axis=-1, keepdims=True) + EPS)
    return (y * g.astype(jnp.float32)).astype(x.dtype)


def swiglu(x, w1, w3, w2):
    return (jax.nn.silu(x @ w1) * (x @ w3)) @ w2


def rope_tables(positions):
    inv_freq = ROPE_THETA ** (-jnp.arange(0, ROT_DIM, 2, dtype=jnp.float32) / ROT_DIM)
    ang = positions.astype(jnp.float32)[..., None] * inv_freq
    return jnp.cos(ang)[:, :, None, :], jnp.sin(ang)[:, :, None, :]


def rope_partial(t, cos, sin):
    half = ROT_DIM // 2
    cos = cos.astype(t.dtype)
    sin = sin.astype(t.dtype)
    t1 = t[..., :half]
    t2 = t[..., half:ROT_DIM]
    return jnp.concatenate([t1 * cos - t2 * sin, t2 * cos + t1 * sin, t[..., ROT_DIM:]], axis=-1)


def gla_chunked(q, k, v, log_a):
    B, H, S, dk = q.shape
    dv = v.shape[-1]
    n = S // GLA_CHUNK

    def chunks(t):
        return t.astype(jnp.float32).reshape(B, H, n, GLA_CHUNK, t.shape[-1])

    q, k, v, g = chunks(q), chunks(k), chunks(v), chunks(log_a)
    b = jnp.cumsum(g, axis=3)
    b_last = b[:, :, :, -1:, :]
    q_dec = q * jnp.exp(b)
    k_inv = k * jnp.exp(-b)
    k_tail = k * jnp.exp(b_last - b)
    causal = jnp.tril(jnp.ones((GLA_CHUNK, GLA_CHUNK), dtype=bool))
    a = jnp.where(causal, jnp.einsum('bhnid,bhnjd->bhnij', q_dec, k_inv), 0.0)
    o_intra = jnp.einsum('bhnij,bhnje->bhnie', a, v)
    u = jnp.einsum('bhnjd,bhnje->bhnde', k_tail, v)
    decay = jnp.exp(b_last[:, :, :, 0, :])

    def step(state, inp):
        dec_c, u_c = inp
        return dec_c[..., None] * state + u_c, state

    init = jnp.zeros((B, H, dk, dv), jnp.float32)
    _, s_prev = lax.scan(step, init, (jnp.moveaxis(decay, 2, 0), jnp.moveaxis(u, 2, 0)))
    s_prev = jnp.moveaxis(s_prev, 0, 2)
    o_inter = jnp.einsum('bhnid,bhnde->bhnie', q_dec, s_prev)
    return (o_intra + o_inter).reshape(B, H, S, dv)


def dilated_branch(q, k, v, window, dilation):
    B, H, S, hd = q.shape
    L = S // dilation
    span = window // dilation
    nb = -(-L // ATT_BLOCK)
    Lp = nb * ATT_BLOCK

    def to_blocks(t):
        t = t.reshape(B, H, L, dilation, hd).transpose(0, 1, 3, 2, 4)
        t = jnp.pad(t, ((0, 0), (0, 0), (0, 0), (0, Lp - L), (0, 0)))
        return t.reshape(B, H, dilation, nb, ATT_BLOCK, hd)

    qb, kb, vb = to_blocks(q), to_blocks(k), to_blocks(v)
    shift = ((0, 0), (0, 0), (0, 0), (1, 0), (0, 0), (0, 0))
    kk = jnp.concatenate([jnp.pad(kb[:, :, :, :-1], shift), kb], axis=4)
    vv = jnp.concatenate([jnp.pad(vb[:, :, :, :-1], shift), vb], axis=4)
    s = jnp.einsum('bhrnqd,bhrnkd->bhrnqk', qb, kk).astype(jnp.float32)
    blk = jnp.arange(nb)[:, None, None]
    qi = jnp.arange(ATT_BLOCK)[None, :, None] + ATT_BLOCK
    ki = jnp.arange(2 * ATT_BLOCK)[None, None, :]
    dist = qi - ki
    mask = (dist >= 0) & (dist <= span) & (blk * ATT_BLOCK + ki - ATT_BLOCK >= 0)
    s = jnp.where(mask, s, -jnp.inf)
    m = jnp.max(s, axis=-1, keepdims=True)
    p = jnp.exp(s - m)
    den = jnp.sum(p, axis=-1, keepdims=True)
    o = jnp.einsum('bhrnqk,bhrnkd->bhrnqd', p.astype(v.dtype), vv).astype(jnp.float32) / den
    lse = (m + jnp.log(den))[..., 0]
    o = o.reshape(B, H, dilation, Lp, hd)[:, :, :, :L].transpose(0, 1, 3, 2, 4).reshape(B, H, S, hd)
    lse = lse.reshape(B, H, dilation, Lp)[:, :, :, :L].transpose(0, 1, 3, 2).reshape(B, H, S)
    return o, lse


def dilated_attention(q, k, v):
    outs, lses = [], []
    for window, dilation in DILATED_PATTERNS:
        o, lse = dilated_branch(q, k, v, window, dilation)
        outs.append(o)
        lses.append(lse)
    w = jax.nn.softmax(jnp.stack(lses, axis=0), axis=0)
    return jnp.sum(w[..., None] * jnp.stack(outs, axis=0), axis=0)


def setup_inputs(seed: int = 0) -> dict:
    key = jax.random.key(seed)
    ks = jax.random.split(key, 20)
    f32 = jnp.float32

    def nrm(k, shape, fan_in):
        return jax.random.normal(k, shape, f32) * (fan_in ** -0.5)

    def gain(k, shape):
        return 1.0 + 0.02 * jax.random.normal(k, shape, f32)

    x = jax.random.normal(ks[0], (BATCH, SEQ, D_MODEL), f32)
    positions = jnp.broadcast_to(jnp.arange(SEQ, dtype=jnp.int32)[None, :], (BATCH, SEQ))
    return {
        "x": x,
        "positions": positions,
        "ffn1_norm": gain(ks[1], (DEPTH, D_MODEL)),
        "ffn1_w1": nrm(ks[2], (DEPTH, D_MODEL, D_FF), D_MODEL),
        "ffn1_w3": nrm(ks[3], (DEPTH, D_MODEL, D_FF), D_MODEL),
        "ffn1_w2": nrm(ks[4], (DEPTH, D_FF, D_MODEL), D_FF),
        "mix_norm": gain(ks[5], (DEPTH, D_MODEL)),
        "w_in": nrm(ks[6], (DEPTH, D_MODEL, D_IN), D_MODEL),
        "gla_w_a2": nrm(ks[7], (DEPTH, GLA_GATE_RANK, GLA_KW), GLA_GATE_RANK),
        "gla_b_a": 0.01 * jax.random.normal(ks[8], (DEPTH, GLA_KW), f32),
        "gla_out_norm": gain(ks[9], (DEPTH, GLA_WIDTH)),
        "att_out_norm": gain(ks[10], (DEPTH, ATT_WIDTH)),
        "w_out": nrm(ks[11], (DEPTH, D_MIX, D_MODEL), D_MIX),
        "ffn2_norm": gain(ks[12], (DEPTH, D_MODEL)),
        "ffn2_w1": nrm(ks[13], (DEPTH, D_MODEL, D_FF), D_MODEL),
        "ffn2_w3": nrm(ks[14], (DEPTH, D_MODEL, D_FF), D_MODEL),
        "ffn2_w2": nrm(ks[15], (DEPTH, D_FF, D_MODEL), D_FF),
        "final_norm": gain(ks[16], (D_MODEL,)),
    }


def reference(x, positions, ffn1_norm, ffn1_w1, ffn1_w3, ffn1_w2, mix_norm, w_in, gla_w_a2, gla_b_a,
              gla_out_norm, att_out_norm, w_out, ffn2_norm, ffn2_w1, ffn2_w3, ffn2_w2, final_norm):
    B, S, _ = x.shape
    cos, sin = rope_tables(positions)
    offsets = []
    acc = 0
    for size in IN_SIZES[:-1]:
        acc += size
        offsets.append(acc)

    for l in range(DEPTH):
        x = x + 0.5 * swiglu(rms_norm(x, ffn1_norm[l]), ffn1_w1[l], ffn1_w3[l], ffn1_w2[l])

        h = rms_norm(x, mix_norm[l])
        proj = h @ w_in[l]
        gq, gk, gv, gr, ga, aq, ak, av = jnp.split(proj, offsets, axis=-1)

        def heads(t, nh):
            return t.reshape(B, S, nh, -1).transpose(0, 2, 1, 3)

        log_a = jax.nn.log_sigmoid((ga @ gla_w_a2[l] + gla_b_a[l]).astype(jnp.float32)) / GLA_TAU
        o_gla = gla_chunked(heads(gq, GLA_HEADS) * (GLA_DK ** -0.5), heads(gk, GLA_HEADS),
                            heads(gv, GLA_HEADS), heads(log_a, GLA_HEADS))
        o_gla = rms_norm(o_gla, gla_out_norm[l].reshape(GLA_HEADS, 1, GLA_DV))
        o_gla = o_gla.transpose(0, 2, 1, 3).reshape(B, S, GLA_WIDTH).astype(x.dtype) * jax.nn.silu(gr)

        q = rope_partial(aq.reshape(B, S, ATT_HEADS, ATT_HD), cos, sin) * (ATT_HD ** -0.5)
        k = rope_partial(ak.reshape(B, S, ATT_HEADS, ATT_HD), cos, sin)
        v = av.reshape(B, S, ATT_HEADS, ATT_HD)
        o_att = dilated_attention(q.transpose(0, 2, 1, 3), k.transpose(0, 2, 1, 3), v.transpose(0, 2, 1, 3))
        o_att = o_att.transpose(0, 2, 1, 3).reshape(B, S, ATT_WIDTH)
        o_att = rms_norm(o_att, att_out_norm[l]).astype(x.dtype)

        x = x + jnp.concatenate([o_gla, o_att], axis=-1) @ w_out[l]

        x = x + 0.5 * swiglu(rms_norm(x, ffn2_norm[l]), ffn2_w1[l], ffn2_w3[l], ffn2_w2[l])

    return rms_norm(x, final_norm)
```

```cpp
#include <hip/hip_runtime.h>
#include <hip/hip_cooperative_groups.h>
#include <cstdio>
#include <cstdint>
namespace cg = cooperative_groups;
namespace pg8 {
#define PG8_LAS __attribute__((address_space(3)))
typedef unsigned short bf16_t;
typedef short bf16x8 __attribute__((ext_vector_type(8)));
typedef float f32x4 __attribute__((ext_vector_type(4)));
typedef unsigned u32x4 __attribute__((ext_vector_type(4)));
constexpr int BM = 256, BK = 64, HALF = 128, HTB = HALF * BK * 2  , STAGE_BYTES = 8 * HTB, NXCD = 8, WGM = 8;

__host__ __device__ __forceinline__ int lds_byte(int r, int c) { const int st = (r >> 4) * 2 + (c >> 5), rr = r & 15, cc = c & 31, ob = rr * 64 + cc * 2; return st * 1024 + (ob ^ (((ob >> 9) & 1) << 5)); }
__host__ __device__ __forceinline__ void stage_rc(int b, int& R, int& C) { const int st = b / 1024, sb = b % 1024, swz = sb ^ (((sb >> 9) & 1) << 5); R = (st >> 1) * 16 + swz / 64; C = (st & 1) * 32 + (swz % 64) / 2; }
__host__ __device__ __forceinline__ int perm32(int rho) { const int n = rho >> 4, i = rho & 15; return 8 * (i >> 2) + 4 * n + (i & 3); }

struct Unit { int pm, pn; };
struct Gemm { const bf16_t* A; const bf16_t* Bt; int M, N, K; };

struct StaticOrder {
    int nM, nN, nwg, G, c;
    __host__ __device__ void init(int M, int N, int G_, int c_) { nM = M / BM; nN = N / BM; nwg = nM * nN; G = G_; c = c_; }
    __host__ __device__ bool next(int i, Unit& u) const {
        const long L = (long)i * G + c; if (L >= nwg) return false;
        int wgid = (int)L; { const int q = nwg / NXCD, r = nwg % NXCD, xcd = wgid % NXCD, off = wgid / NXCD; wgid = (xcd < r ? xcd * (q + 1) : r * (q + 1) + (xcd - r) * q) + off; }
        const int nig = WGM * nN, gid = wgid / nig, fm = gid * WGM, gsz = (nM - fm) < WGM ? (nM - fm) : WGM;
        u.pm = fm + ((wgid % nig) % gsz); u.pn = (wgid % nig) / gsz; return true;
    }
    __device__ __forceinline__ void a_ready(const Unit&) const {}
    __device__ __forceinline__ void done(const Unit&) const {}
};

__device__ __forceinline__ unsigned cvt_pk_bf16(float lo, float hi) { unsigned r; asm volatile("v_cvt_pk_bf16_f32 %0, %1, %2" : "=v"(r) : "v"(lo), "v"(hi)); return r; }
constexpr float RMS_EPS = 1e-6f;
__device__ __forceinline__ float silu_f(float x) { return x * __builtin_amdgcn_rcpf(1.0f + __expf(-x)); }
struct EpiSwiglu {
    static constexpr bool PERM = true, AFTER_DRAIN = false;
    bf16_t* O; int ldc; const float* ss;
    __device__ __forceinline__ void operator()(const f32x4 (&acc)[2][2][4][2], const Unit& u, int wr, int wc, int fr, int fq) const {
        const int row0 = u.pm * BM + wr * 64 + fr, col0 = u.pn * HALF + wc * 32 + 8 * fq;
#pragma unroll
        for (int ai = 0; ai < 2; ++ai)
#pragma unroll
            for (int m = 0; m < 4; ++m) {
                const int row = row0 + ai * HALF + m * 16;
                const float rs = __builtin_amdgcn_rsqf(ss[row] * (1.0f / 1024.0f) + RMS_EPS);
                const f32x4 a0 = acc[ai][0][m][0] * rs, a1 = acc[ai][0][m][1] * rs, b0 = acc[ai][1][m][0] * rs, b1 = acc[ai][1][m][1] * rs;
                u32x4 w;
                w.x = cvt_pk_bf16(silu_f(a0[0]) * b0[0], silu_f(a0[1]) * b0[1]); w.y = cvt_pk_bf16(silu_f(a0[2]) * b0[2], silu_f(a0[3]) * b0[3]);
                w.z = cvt_pk_bf16(silu_f(a1[0]) * b1[0], silu_f(a1[1]) * b1[1]); w.w = cvt_pk_bf16(silu_f(a1[2]) * b1[2], silu_f(a1[3]) * b1[3]);
                *(u32x4*)(O + (size_t)row * ldc + col0) = w;
            }
    }
};
struct EpiProj {
    static constexpr bool PERM = true, AFTER_DRAIN = false;
    bf16_t* PG; bf16_t* PA; const float* ss; const float* cs;
    __device__ __forceinline__ void operator()(const f32x4 (&acc)[2][2][4][2], const Unit& u, int wr, int wc, int fr, int fq) const {
        const int row0 = u.pm * BM + wr * 64 + fr;
        bf16_t* base; int ldc;
        if (u.pn < 6) { base = PG + u.pn * BM; ldc = 1792; } else { base = PA + (u.pn - 6) * BM; ldc = 1536; }
        base += wc * 32 + 8 * fq;
        const bool rot = (u.pn >= 6) && (u.pn < 10) && ((wc & 1) == 0);
        const float qs = (u.pn == 6 || u.pn == 7) ? 0.125f : 1.0f;
#pragma unroll
        for (int ai = 0; ai < 2; ++ai)
#pragma unroll
            for (int m = 0; m < 4; ++m) {
                const int row = row0 + ai * HALF + m * 16;
                const float rs = __builtin_amdgcn_rsqf(ss[row] * (1.0f / 1024.0f) + RMS_EPS);
                f32x4 c0 = {1.f, 1.f, 1.f, 1.f}, c1 = c0, s0 = {0.f, 0.f, 0.f, 0.f}, s1 = s0;
                if (rot && fq < 2) { const float* cr = cs + (size_t)row * 16; c0 = *(const f32x4*)cr; c1 = *(const f32x4*)(cr + 4); s0 = *(const f32x4*)(cr + 8); s1 = *(const f32x4*)(cr + 12);
                    if (fq == 0) { s0 = -s0; s1 = -s1; } }
#pragma unroll
                for (int bj = 0; bj < 2; ++bj) {
                    f32x4 v0 = acc[ai][bj][m][0] * rs, v1 = acc[ai][bj][m][1] * rs;
                    if (rot) {
                        f32x4 p0, p1;
#pragma unroll
                        for (int j = 0; j < 4; ++j) { p0[j] = __shfl_xor(v0[j], 16); p1[j] = __shfl_xor(v1[j], 16); }
                        v0 = v0 * c0 + p0 * s0; v1 = v1 * c1 + p1 * s1;
                    }
                    v0 = v0 * qs; v1 = v1 * qs;
                    u32x4 w; w.x = cvt_pk_bf16(v0[0], v0[1]); w.y = cvt_pk_bf16(v0[2], v0[3]); w.z = cvt_pk_bf16(v1[0], v1[1]); w.w = cvt_pk_bf16(v1[2], v1[3]);
                    *(u32x4*)(base + (size_t)row * ldc + bj * HALF) = w;
                }
            }
    }
};
struct EpiResidF {
    static constexpr bool PERM = true, AFTER_DRAIN = false;
    const bf16_t* base; float* out; float alpha; int ldc;
    __device__ __forceinline__ void operator()(const f32x4 (&acc)[2][2][4][2], const Unit& u, int wr, int wc, int fr, int fq) const {
        const int row0 = u.pm * BM + wr * 64 + fr, col0 = u.pn * BM + wc * 32 + 8 * fq;
#pragma unroll
        for (int ai = 0; ai < 2; ++ai)
#pragma unroll
            for (int m = 0; m < 4; ++m) {
                const size_t off = (size_t)(row0 + ai * HALF + m * 16) * ldc + col0;
#pragma unroll
                for (int bj = 0; bj < 2; ++bj) {
                    const u32x4 w = *(const u32x4*)(base + off + bj * HALF);
                    const f32x4 r0 = {__uint_as_float(w.x << 16), __uint_as_float(w.x & 0xffff0000u), __uint_as_float(w.y << 16), __uint_as_float(w.y & 0xffff0000u)};
                    const f32x4 r1 = {__uint_as_float(w.z << 16), __uint_as_float(w.z & 0xffff0000u), __uint_as_float(w.w << 16), __uint_as_float(w.w & 0xffff0000u)};
                    *(f32x4*)(out + off + bj * HALF) = r0 + acc[ai][bj][m][0] * alpha; *(f32x4*)(out + off + bj * HALF + 4) = r1 + acc[ai][bj][m][1] * alpha;
                }
            }
    }
};
__device__ __forceinline__ void unpack8(const u32x4 w, f32x4& a, f32x4& b) {
    a = (f32x4){__uint_as_float(w.x << 16), __uint_as_float(w.x & 0xffff0000u), __uint_as_float(w.y << 16), __uint_as_float(w.y & 0xffff0000u)};
    b = (f32x4){__uint_as_float(w.z << 16), __uint_as_float(w.z & 0xffff0000u), __uint_as_float(w.w << 16), __uint_as_float(w.w & 0xffff0000u)};
}
template <bool BASE_BF16> struct EpiResidB {
    static constexpr bool PERM = true, AFTER_DRAIN = false;
    const void* base; bf16_t* xn; float* ss; float alpha; int ldc;
    __device__ __forceinline__ void operator()(const f32x4 (&acc)[2][2][4][2], const Unit& u, int wr, int wc, int fr, int fq) const {
        const int row0 = u.pm * BM + wr * 64 + fr, col0 = u.pn * BM + wc * 32 + 8 * fq;
#pragma unroll
        for (int ai = 0; ai < 2; ++ai)
#pragma unroll
            for (int m = 0; m < 4; ++m) {
                const int row = row0 + ai * HALF + m * 16; const size_t off = (size_t)row * ldc + col0; float s = 0.f;
#pragma unroll
                for (int bj = 0; bj < 2; ++bj) {
                    f32x4 r0, r1;
                    if constexpr (BASE_BF16) unpack8(*(const u32x4*)((const bf16_t*)base + off + bj * HALF), r0, r1);
                    else { r0 = *(const f32x4*)((const float*)base + off + bj * HALF); r1 = *(const f32x4*)((const float*)base + off + bj * HALF + 4); }
                    const f32x4 o0 = r0 + acc[ai][bj][m][0] * alpha, o1 = r1 + acc[ai][bj][m][1] * alpha;
                    u32x4 w; w.x = cvt_pk_bf16(o0[0], o0[1]); w.y = cvt_pk_bf16(o0[2], o0[3]); w.z = cvt_pk_bf16(o1[0], o1[1]); w.w = cvt_pk_bf16(o1[2], o1[3]);
                    *(u32x4*)(xn + off + bj * HALF) = w;
                    s += (o0[0] * o0[0] + o0[1] * o0[1]) + (o0[2] * o0[2] + o0[3] * o0[3]) + (o1[0] * o1[0] + o1[1] * o1[1]) + (o1[2] * o1[2] + o1[3] * o1[3]);
                }
                s += __shfl_xor(s, 16); s += __shfl_xor(s, 32); if (fq == 0) atomicAdd(ss + row, s);
            }
    }
};
struct EpiFinal {
    static constexpr bool PERM = true, AFTER_DRAIN = false;
    const bf16_t* base; float* out; float* ss; unsigned* cnt; const float* gf; float alpha; int ldc; unsigned want;
    __device__ __forceinline__ void operator()(f32x4 (&acc)[2][2][4][2], const Unit& u, int wr, int wc, int fr, int fq) const {
        const int row0 = u.pm * BM + wr * 64 + fr, col0 = u.pn * BM + wc * 32 + 8 * fq;
#pragma unroll
        for (int ai = 0; ai < 2; ++ai)
#pragma unroll
            for (int m = 0; m < 4; ++m) {
                const int row = row0 + ai * HALF + m * 16; const size_t off = (size_t)row * ldc + col0; float s = 0.f;
#pragma unroll
                for (int bj = 0; bj < 2; ++bj) {
                    f32x4 r0, r1; unpack8(*(const u32x4*)(base + off + bj * HALF), r0, r1);
                    const f32x4 o0 = r0 + acc[ai][bj][m][0] * alpha, o1 = r1 + acc[ai][bj][m][1] * alpha;
                    acc[ai][bj][m][0] = o0; acc[ai][bj][m][1] = o1;
                    s += (o0[0] * o0[0] + o0[1] * o0[1]) + (o0[2] * o0[2] + o0[3] * o0[3]) + (o1[0] * o1[0] + o1[1] * o1[1]) + (o1[2] * o1[2] + o1[3] * o1[3]);
                }
                s += __shfl_xor(s, 16); s += __shfl_xor(s, 32);
                if (fq == 0) { const float old = __hip_atomic_fetch_add(ss + row, s, __ATOMIC_RELAXED, __HIP_MEMORY_SCOPE_AGENT); asm volatile("" :: "v"(old)); }
            }
        asm volatile("s_waitcnt vmcnt(0)" ::: "memory");
        unsigned* pc = cnt + 64 * u.pm;
        if ((threadIdx.x & 63) == 0) __hip_atomic_fetch_add(pc, 1u, __ATOMIC_RELAXED, __HIP_MEMORY_SCOPE_AGENT);
        { unsigned spins = 0; while ((unsigned)__builtin_amdgcn_readfirstlane(__hip_atomic_load(pc, __ATOMIC_RELAXED, __HIP_MEMORY_SCOPE_AGENT)) < want) { __builtin_amdgcn_s_sleep(2); if (++spins > (1u << 22)) break; } }
        asm volatile("" ::: "memory");
        const f32x4 g00 = *(const f32x4*)(gf + col0), g01 = *(const f32x4*)(gf + col0 + 4), g10 = *(const f32x4*)(gf + col0 + HALF), g11 = *(const f32x4*)(gf + col0 + HALF + 4);
#pragma unroll
        for (int ai = 0; ai < 2; ++ai)
#pragma unroll
            for (int m = 0; m < 4; ++m) {
                const int row = row0 + ai * HALF + m * 16; const size_t off = (size_t)row * ldc + col0;
                const float rs = __builtin_amdgcn_rsqf(__hip_atomic_load(ss + row, __ATOMIC_RELAXED, __HIP_MEMORY_SCOPE_AGENT) * (1.0f / 1024.0f) + RMS_EPS);
                *(f32x4*)(out + off) = acc[ai][0][m][0] * rs * g00; *(f32x4*)(out + off + 4) = acc[ai][0][m][1] * rs * g01;
                *(f32x4*)(out + off + HALF) = acc[ai][1][m][0] * rs * g10; *(f32x4*)(out + off + HALF + 4) = acc[ai][1][m][1] * rs * g11;
            }
    }
};
template <class Epi, class Sched, bool ALIGN_EPI = false, bool SP2 = false>
__device__ __forceinline__ void gemm_phase(PG8_LAS unsigned char* lds, const Gemm g, const Sched& S, const Epi& E) {
    int tid_ = threadIdx.x; asm volatile("" : "+v"(tid_));
    const int tid = tid_, wid = __builtin_amdgcn_readfirstlane(tid >> 6), lane = tid & 63, wr = wid >> 2, wc = wid & 3, fr = lane & 15, fq = lane >> 4;
    const int K = g.K, nt = K / BK;
    unsigned voffA[2], voffB[2];
#pragma unroll
    for (int i = 0; i < 2; ++i) { int R, C; stage_rc(tid * 16 + i * 8192, R, C); const int Rb = Epi::PERM ? ((R & ~31) + perm32(R & 31)) : R;
        voffA[i] = (unsigned)(R * K + C) * 2u; voffB[i] = (unsigned)(Rb * K + C) * 2u; }
    const size_t kstep = (size_t)(BK * 2);
    const size_t hstep = (size_t)HALF * K * 2;
    const size_t tstep = 2 * hstep;
    const unsigned ldsw = (unsigned)wid * 1024u;
    const int aoff = lds_byte(wr * 64 + fr, fq * 8), boff = lds_byte(wc * 32 + fr, fq * 8);
#define PG8_SA(b, h) (((b) * 2 + (h)) * HTB)
#define PG8_SB(b, h) ((4 + (b) * 2 + (h)) * HTB)
#define PG8_STAGE(bufoff, gbase, voff) do { _Pragma("unroll") for (int _i = 0; _i < 2; ++_i) \
        __builtin_amdgcn_global_load_lds((const unsigned*)((const char*)(gbase) + (voff)[_i]), (PG8_LAS unsigned*)(lds + (bufoff) + ldsw + _i * 8192), 16, 0, 0); } while (0)
#define PG8_LDA(dst, b, h) do { _Pragma("unroll") for (int m = 0; m < 4; ++m) _Pragma("unroll") for (int k = 0; k < 2; ++k) dst[m][k] = *(const PG8_LAS bf16x8*)(lds + PG8_SA(b, h) + aoff + m * 2048 + k * 1024); } while (0)
#define PG8_LDB(dst, b, h) do { _Pragma("unroll") for (int n = 0; n < 2; ++n) _Pragma("unroll") for (int k = 0; k < 2; ++k) dst[n][k] = *(const PG8_LAS bf16x8*)(lds + PG8_SB(b, h) + boff + n * 2048 + k * 1024); } while (0)
#define PG8_MMA(ai, bj, At, Bt) do { __builtin_amdgcn_s_setprio(1); _Pragma("unroll") for (int m = 0; m < 4; ++m) _Pragma("unroll") for (int n = 0; n < 2; ++n) _Pragma("unroll") for (int k = 0; k < 2; ++k) \
        acc[ai][bj][m][n] = __builtin_amdgcn_mfma_f32_16x16x32_bf16(Bt[n][k], At[m][k], acc[ai][bj][m][n], 0, 0, 0); __builtin_amdgcn_s_setprio(0); } while (0)
#define PG8_WAIT_V(n) asm volatile("s_waitcnt vmcnt(" #n ")" ::: "memory")
#define PG8_WAIT_L(n) asm volatile("s_waitcnt lgkmcnt(" #n ")" ::: "memory")
#define PG8_BAR __builtin_amdgcn_s_barrier()
#define PG8_SCHED __builtin_amdgcn_sched_barrier(0)
    Unit cur, nxt; int ui = 0;
    if (!S.next(0, cur)) return;
    f32x4 acc[2][2][4][2];
#pragma unroll
    for (int a = 0; a < 2; ++a)
#pragma unroll
        for (int b = 0; b < 2; ++b)
#pragma unroll
            for (int m = 0; m < 4; ++m)
#pragma unroll
                for (int n = 0; n < 2; ++n) acc[a][b][m][n] = (f32x4){0.f, 0.f, 0.f, 0.f};
    bf16x8 At[4][2], B0[2][2], B1[2][2];
    const char* cA = (const char*)g.A + (size_t)cur.pm * tstep; const char* cB = (const char*)g.Bt + (size_t)cur.pn * tstep;
    S.a_ready(cur);
    if constexpr (SP2) {
        PG8_STAGE(PG8_SB(0, 0), cB, voffB); PG8_STAGE(PG8_SB(0, 1), cB + hstep, voffB); PG8_STAGE(PG8_SA(0, 0), cA, voffA); PG8_STAGE(PG8_SA(0, 1), cA + hstep, voffA);
        if (wr == 1) PG8_BAR;
        PG8_WAIT_V(2); PG8_BAR;
        PG8_STAGE(PG8_SB(1, 0), cB + kstep, voffB); PG8_STAGE(PG8_SA(1, 0), cA + kstep, voffA); PG8_STAGE(PG8_SB(1, 1), cB + hstep + kstep, voffB);
        PG8_WAIT_V(6); PG8_BAR;
    } else {
        PG8_STAGE(PG8_SB(0, 0), cB, voffB); PG8_STAGE(PG8_SA(0, 0), cA, voffA); PG8_STAGE(PG8_SB(0, 1), cB + hstep, voffB); PG8_STAGE(PG8_SA(0, 1), cA + hstep, voffA);
        if (wr == 1) PG8_BAR;
        PG8_WAIT_V(4); PG8_BAR;
        PG8_STAGE(PG8_SB(1, 0), cB + kstep, voffB); PG8_STAGE(PG8_SA(1, 0), cA + kstep, voffA); PG8_STAGE(PG8_SB(1, 1), cB + hstep + kstep, voffB);
        PG8_WAIT_V(6); PG8_BAR;
    }
    for (;;) {
        const bool has_next = S.next(ui + 1, nxt);
        const char* nA = has_next ? (const char*)g.A + (size_t)nxt.pm * tstep : cA; const char* nB = has_next ? (const char*)g.Bt + (size_t)nxt.pn * tstep : cB;
        for (int t = 0; t < nt; t += 2) {
            const bool last = (t == nt - 2);
            const char* a1 = cA + (size_t)(t + 1) * kstep;
            const char* a2 = last ? nA : cA + (size_t)(t + 2) * kstep; const char* b2 = last ? nB : cB + (size_t)(t + 2) * kstep;
            const char* a3 = a2 + kstep; const char* b3 = b2 + kstep;
            if (last && has_next) S.a_ready(nxt);
            if constexpr (SP2) {
            PG8_LDB(B0, 0, 0); PG8_LDB(B1, 0, 1); PG8_SCHED; PG8_LDA(At, 0, 0); PG8_STAGE(PG8_SA(1, 1), a1 + hstep, voffA);
            PG8_WAIT_V(8); PG8_WAIT_L(0); PG8_BAR; PG8_MMA(0, 0, At, B0); PG8_MMA(0, 1, At, B1); PG8_BAR; PG8_SCHED;
            PG8_LDA(At, 0, 1); PG8_STAGE(PG8_SB(0, 0), b2, voffB); PG8_STAGE(PG8_SB(0, 1), b2 + hstep, voffB); PG8_STAGE(PG8_SA(0, 0), a2, voffA);
            PG8_WAIT_V(8); PG8_WAIT_L(0); PG8_BAR; PG8_MMA(1, 0, At, B0); PG8_MMA(1, 1, At, B1); PG8_BAR; PG8_SCHED;
            PG8_LDB(B0, 1, 0); PG8_LDB(B1, 1, 1); PG8_SCHED; PG8_LDA(At, 1, 0); PG8_STAGE(PG8_SA(0, 1), a2 + hstep, voffA);
            PG8_WAIT_V(8); PG8_WAIT_L(0); PG8_BAR; PG8_MMA(0, 0, At, B0); PG8_MMA(0, 1, At, B1); PG8_BAR; PG8_SCHED;
            PG8_LDA(At, 1, 1); PG8_STAGE(PG8_SB(1, 0), b3, voffB); PG8_STAGE(PG8_SB(1, 1), b3 + hstep, voffB); PG8_STAGE(PG8_SA(1, 0), a3, voffA);
            PG8_WAIT_V(8); PG8_WAIT_L(0); PG8_BAR; PG8_MMA(1, 0, At, B0); PG8_MMA(1, 1, At, B1); PG8_BAR; PG8_SCHED;
            } else {
            PG8_LDB(B0, 0, 0); PG8_SCHED; PG8_LDA(At, 0, 0); PG8_STAGE(PG8_SA(1, 1), a1 + hstep, voffA);
            PG8_WAIT_L(8); PG8_BAR; PG8_WAIT_L(0); PG8_MMA(0, 0, At, B0); PG8_BAR; PG8_SCHED;
            PG8_LDB(B1, 0, 1); PG8_STAGE(PG8_SB(0, 0), b2, voffB);
            PG8_BAR; PG8_WAIT_L(0); PG8_MMA(0, 1, At, B1); PG8_BAR;
            PG8_LDA(At, 0, 1); PG8_STAGE(PG8_SA(0, 0), a2, voffA);
            PG8_BAR; PG8_WAIT_L(0); PG8_MMA(1, 0, At, B0); PG8_BAR; PG8_SCHED;
            PG8_STAGE(PG8_SB(0, 1), b2 + hstep, voffB);
            PG8_WAIT_V(6); PG8_BAR; PG8_MMA(1, 1, At, B1); PG8_BAR;
            PG8_LDB(B0, 1, 0); PG8_SCHED; PG8_LDA(At, 1, 0); PG8_STAGE(PG8_SA(0, 1), a2 + hstep, voffA);
            PG8_WAIT_L(8); PG8_BAR; PG8_WAIT_L(0); PG8_MMA(0, 0, At, B0); PG8_BAR; PG8_SCHED;
            PG8_LDB(B1, 1, 1); PG8_STAGE(PG8_SB(1, 0), b3, voffB);
            PG8_BAR; PG8_WAIT_L(0); PG8_MMA(0, 1, At, B1); PG8_BAR;
            PG8_LDA(At, 1, 1); PG8_STAGE(PG8_SA(1, 0), a3, voffA);
            PG8_BAR; PG8_WAIT_L(0); PG8_MMA(1, 0, At, B0); PG8_BAR; PG8_SCHED;
            PG8_STAGE(PG8_SB(1, 1), b3 + hstep, voffB);
            PG8_WAIT_V(6); PG8_BAR; PG8_MMA(1, 1, At, B1); PG8_BAR;
            }
        }
        if constexpr (ALIGN_EPI) { if (wr == 0) PG8_BAR; }
        if constexpr (!Epi::AFTER_DRAIN) { E(acc, cur, wr, wc, fr, fq); S.done(cur); }
        if (!has_next) break;
#pragma unroll
        for (int a = 0; a < 2; ++a)
#pragma unroll
            for (int b = 0; b < 2; ++b)
#pragma unroll
                for (int m = 0; m < 4; ++m)
#pragma unroll
                    for (int n = 0; n < 2; ++n) acc[a][b][m][n] = (f32x4){0.f, 0.f, 0.f, 0.f};
        cur = nxt; cA = nA; cB = nB; ++ui;
        if constexpr (ALIGN_EPI) { if (wr == 1) PG8_BAR; }
    }
    PG8_WAIT_V(0);
    if constexpr (!ALIGN_EPI) { if (wr == 0) PG8_BAR; }
    PG8_BAR;
    if constexpr (Epi::AFTER_DRAIN) { E.fused(acc, cur, wr, wc, fr, fq, lds, wid, lane); S.done(cur); }
#undef PG8_SA
#undef PG8_SB
#undef PG8_STAGE
#undef PG8_LDA
#undef PG8_LDB
#undef PG8_MMA
#undef PG8_WAIT_V
#undef PG8_WAIT_L
#undef PG8_BAR
#undef PG8_SCHED
}
}

#define LAS __attribute__((address_space(3)))
typedef unsigned short bf16;
typedef short bf16x8 __attribute__((ext_vector_type(8)));
typedef short s16x4 __attribute__((ext_vector_type(4)));
typedef float f32x4 __attribute__((ext_vector_type(4)));
typedef float f32x2 __attribute__((ext_vector_type(2)));
typedef unsigned u32x4 __attribute__((ext_vector_type(4)));
typedef unsigned u32x2 __attribute__((ext_vector_type(2)));
typedef __bf16 bf16x2_t __attribute__((ext_vector_type(2)));

#ifndef REP_MIX
#define REP_MIX 1
#endif
#ifndef REP_MIXC
#define REP_MIXC 1
#endif
#ifndef REP_UP
#define REP_UP 1
#endif
#ifndef REP_DN
#define REP_DN 1
#endif
#ifndef REP_OUT
#define REP_OUT 1
#endif
#ifndef REP_SYNC
#define REP_SYNC 1
#endif
#ifndef REP_P0
#define REP_P0 1
#endif
#ifndef REP_IN
#define REP_IN 1
#endif
#define GSYNC() do { for (int _r = 0; _r < REP_SYNC; ++_r) xcd_barrier(bar); } while (0)
constexpr int NWAVES = 8, NTHR = 512;
constexpr int SEQ = 8192, M = 16384, D = 1024, FF = 2816, NUP = 2 * FF  , NIN = 3072, DIN_SRC = 3088;
constexpr int LDG = 1792, LDA = 1536;
constexpr float EPS = 1e-6f;

constexpr size_t MiB = 1u << 20;
constexpr size_t WS_CTL = 0, CTL_ZERO_BYTES = 1 * MiB;
constexpr size_t WS_SS1 = 64 * 1024, WS_SS2 = 128 * 1024, WS_SS3 = 192 * 1024, WS_BAR = 256 * 1024, WS_PCNT = 512 * 1024;
constexpr size_t WS_SS0 = 1 * MiB;
constexpr size_t WS_CS = 1 * MiB + 256 * 1024;
constexpr size_t WS_DEC = 2 * MiB + 512 * 1024;
constexpr size_t WS_LSE = 3 * MiB;
constexpr size_t WS_WGA = 4 * MiB + 512 * 1024;
constexpr size_t WS_GA = 232 * MiB;
constexpr size_t WS_W13A = 5 * MiB, WS_W2A = 16 * MiB, WS_WIN = 22 * MiB, WS_WOUT = 29 * MiB, WS_W13B = 31 * MiB, WS_W2B = 42 * MiB;
constexpr size_t WS_ST = 5 * MiB;
constexpr size_t WS_XN = 48 * MiB;
constexpr size_t WS_UT = 48 * MiB;
constexpr size_t WS_PG = 80 * MiB;
constexpr size_t WS_PA = 136 * MiB;
constexpr size_t WS_OM = 136 * MiB;
constexpr size_t WS_OB = 184 * MiB;
constexpr size_t WS_H = 80 * MiB;
constexpr size_t WS_END = 233 * MiB;
static_assert(WS_W13A + (size_t)NUP * D * 2 <= WS_W2A && WS_W2A + (size_t)D * FF * 2 <= WS_WIN && WS_WIN + (size_t)NIN * D * 2 <= WS_WOUT && WS_WOUT + (size_t)D * D * 2 <= WS_W13B &&
              WS_W13B + (size_t)NUP * D * 2 <= WS_W2B && WS_W2B + (size_t)D * FF * 2 <= WS_XN && WS_ST + 16 * MiB <= WS_WIN && WS_PG + (size_t)M * LDG * 2 <= WS_PA &&
              WS_PA + (size_t)M * LDA * 2 <= WS_OB && WS_H + (size_t)M * FF * 2 <= WS_OB && WS_OB + (size_t)3 * M * 512 * 2 <= WS_END, "d_ws map");

constexpr int RING_BYTES = 131072, LDS_BYTES = 147456, MISC_OFF = RING_BYTES;

__device__ __forceinline__ float bf2f(unsigned short v) { return __uint_as_float(((unsigned)v) << 16); }
__device__ __forceinline__ unsigned pk2(float lo, float hi) { f32x2 v = {lo, hi}; bf16x2_t b = __builtin_convertvector(v, bf16x2_t); return __builtin_bit_cast(unsigned, b); }
__device__ __forceinline__ unsigned short f2bf(float x) { return (unsigned short)(pk2(x, 0.f) & 0xffffu); }
__device__ __forceinline__ float wave_sum(float v) {
#pragma unroll
    for (int o = 1; o < 64; o <<= 1) v += __shfl_xor(v, o);
    return v;
}
#define MFMA16(a, b, c) __builtin_amdgcn_mfma_f32_16x16x32_bf16((a), (b), (c), 0, 0, 0)

struct Args {
    const float* x; const int* pos; const float* g1; const float* w1a; const float* w3a; const float* w2a; const float* gm; const float* win; const float* wa2; const float* ba;
    const float* ggla; const float* gatt; const float* wout; const float* g2; const float* w1b; const float* w3b; const float* w2b; const float* gf;
    float* out; unsigned char* ws; int use_cg_sync; int pad;
};

__device__ __forceinline__ void tr_item(const float* W, int ldw, int col0, int k0, const float* gain, bf16* WT, int K, int drow0, LAS float* scr, int lane) {
    const float* src = W + (size_t)(k0 + (lane >> 5)) * ldw + col0 + (lane & 31);
    float v[32];
#pragma unroll
    for (int i = 0; i < 32; ++i) v[i] = src[(size_t)(2 * i) * ldw];
    const int c = lane & 7;
    f32x4 g0 = {1.f, 1.f, 1.f, 1.f}, g1 = g0;
    if (gain) { g0 = *(const f32x4*)(gain + k0 + 8 * c); g1 = *(const f32x4*)(gain + k0 + 8 * c + 4); }
#pragma unroll
    for (int i = 0; i < 32; ++i) scr[(2 * i + (lane >> 5)) * 33 + (lane & 31)] = v[i];
    asm volatile("s_waitcnt lgkmcnt(0)" ::: "memory");
#pragma unroll
    for (int j = 0; j < 4; ++j) { const int n = (lane >> 3) + 8 * j; const LAS float* s = scr + (8 * c) * 33 + n;
        u32x4 o; o.x = pk2(s[0 * 33] * g0[0], s[1 * 33] * g0[1]); o.y = pk2(s[2 * 33] * g0[2], s[3 * 33] * g0[3]); o.z = pk2(s[4 * 33] * g1[0], s[5 * 33] * g1[1]); o.w = pk2(s[6 * 33] * g1[2], s[7 * 33] * g1[3]);
        *(u32x4*)(WT + (size_t)(drow0 + n) * K + k0 + 8 * c) = o; }
    asm volatile("s_waitcnt lgkmcnt(0)" ::: "memory");
}
__device__ __forceinline__ void up_item(const float* w1, const float* w3, const float* g, bf16* WT, int r, LAS float* scr, int lane) {
    const int which = r / 1408, rr = r % 1408, kb = rr / 88, nb = rr % 88;
    tr_item(which ? w3 : w1, FF, 32 * nb, 64 * kb, g, WT, D, 256 * (nb >> 2) + 32 * (nb & 3) + 128 * which, scr, lane);
}
__device__ __forceinline__ void conv_items(const Args& a, LAS unsigned char* lds, int lo, int hi, int widx, int nw, int lane, int wave) {
    unsigned char* ws = a.ws;
    LAS float* scr = (LAS float*)(lds + wave * 16384);
    bf16* W13A = (bf16*)(ws + WS_W13A); bf16* W2A = (bf16*)(ws + WS_W2A); bf16* WIN = (bf16*)(ws + WS_WIN); bf16* WOUT = (bf16*)(ws + WS_WOUT); bf16* W13B = (bf16*)(ws + WS_W13B); bf16* W2B = (bf16*)(ws + WS_W2B);
    constexpr int I_UP = 2816, I_DN = 1408, I_IN = 1536, I_OUT = 512;
    for (int it = lo + widx; it < hi; it += nw) {
        int r = it;
        if (r < I_UP) { up_item(a.w1a, a.w3a, a.g1, W13A, r, scr, lane); continue; } r -= I_UP;
        if (r < I_DN) { tr_item(a.w2a, D, 32 * (r % 32), 64 * (r / 32), nullptr, W2A, FF, 32 * (r % 32), scr, lane); continue; } r -= I_DN;
        if (r < I_IN) { const int kb = r / 96, nb = r % 96; tr_item(a.win, DIN_SRC, nb < 48 ? 32 * nb : 32 * nb + 16, 64 * kb, a.gm, WIN, D, 32 * nb, scr, lane); continue; } r -= I_IN;
        if (r < I_OUT) { tr_item(a.wout, D, 32 * (r % 32), 64 * (r / 32), nullptr, WOUT, D, 32 * (r % 32), scr, lane); continue; } r -= I_OUT;
        if (r < I_UP) { up_item(a.w1b, a.w3b, a.g2, W13B, r, scr, lane); continue; } r -= I_UP;
        tr_item(a.w2b, D, 32 * (r % 32), 64 * (r / 32), nullptr, W2B, FF, 32 * (r % 32), scr, lane);
    }
}
constexpr int IT_W13A = 0, IT_W2A = 2816, IT_W13B = 6272, IT_W2B = 9088, IT_END = 10496;
__device__ __forceinline__ void gate_cols(const Args& a, int tidx, int nthr) {
    bf16* WGA = (bf16*)(a.ws + WS_WGA);
    for (int item = tidx; item < 16 * 128; item += nthr) {
        const int r = item & 15, kc = item >> 4; float o[8];
#pragma unroll
        for (int i = 0; i < 8; ++i) { const int k = 8 * kc + i; o[i] = a.win[(size_t)k * DIN_SRC + 1536 + r] * a.gm[k]; }
        u32x4 w; w.x = pk2(o[0], o[1]); w.y = pk2(o[2], o[3]); w.z = pk2(o[4], o[5]); w.w = pk2(o[6], o[7]);
        *(u32x4*)(WGA + (size_t)r * D + 8 * kc) = w;
    }
}
__device__ __forceinline__ void ga_job(LAS unsigned char* L, const bf16* XN, const bf16* WGA, const float* ss, float* GA, int tid, int G) {
    const int lane = tid & 63, w = tid >> 6, c = lane & 15, quad = lane >> 4, mt = w & 3, kh = w >> 2;
    for (int rb = blockIdx.x; rb < M / 64; rb += G) {
        const bf16* ap = XN + (size_t)(rb * 64 + 16 * mt + c) * D + kh * 512 + 8 * quad; const bf16* bp = WGA + (size_t)c * D + kh * 512 + 8 * quad;
        f32x4 acc = {0.f, 0.f, 0.f, 0.f};
#pragma unroll
        for (int half = 0; half < 2; ++half) {
            bf16x8 af[8], bfr[8];
#pragma unroll
            for (int ks = 0; ks < 8; ++ks) { af[ks] = *(const bf16x8*)(ap + (half * 8 + ks) * 32); bfr[ks] = *(const bf16x8*)(bp + (half * 8 + ks) * 32); }
#pragma unroll
            for (int ks = 0; ks < 8; ++ks) acc = MFMA16(af[ks], bfr[ks], acc);
        }
        LAS float* P = (LAS float*)L;
#pragma unroll
        for (int i = 0; i < 4; ++i) P[(kh * 64 + 16 * mt + 4 * quad + i) * 16 + c] = acc[i];
        __syncthreads();
        { const int row = tid >> 3, r2 = (tid & 7) * 2; const float rs = __builtin_amdgcn_rsqf(ss[rb * 64 + row] * (1.0f / 1024.0f) + EPS);
          f32x2 o; o.x = (P[row * 16 + r2] + P[(64 + row) * 16 + r2]) * rs; o.y = (P[row * 16 + r2 + 1] + P[(64 + row) * 16 + r2 + 1]) * rs;
          *(f32x2*)(GA + (size_t)(rb * 64 + row) * 16 + r2) = o; }
        __syncthreads();
    }
}
__device__ __forceinline__ void light_wg(int nunits, int G, int& idx, int& nlight) { const int rem = nunits % G; nlight = rem ? G - rem : G; idx = rem ? (int)blockIdx.x - rem : (int)blockIdx.x; }
__device__ __forceinline__ void p0_prologue(const Args& a, LAS unsigned char* lds, int tid, int lane, int wave) {
    unsigned char* ws = a.ws;
    const int gw = blockIdx.x * NWAVES + wave, NGW = gridDim.x * NWAVES;
    conv_items(a, lds, IT_W13A, IT_W2A, gw, NGW, lane, wave);
    bf16* XN = (bf16*)(ws + WS_XN); float* SS0 = (float*)(ws + WS_SS0);
    for (int m0 = gw * 4; m0 < M; m0 += NGW * 4) {
        f32x4 v[4][4];
#pragma unroll
        for (int r = 0; r < 4; ++r) { const f32x4* xr = (const f32x4*)(a.x + (size_t)(m0 + r) * D) + lane;
#pragma unroll
            for (int j = 0; j < 4; ++j) v[r][j] = xr[64 * j]; }
#pragma unroll
        for (int r = 0; r < 4; ++r) { unsigned long long* o8 = (unsigned long long*)(XN + (size_t)(m0 + r) * D) + lane; float s = 0.f;
#pragma unroll
            for (int j = 0; j < 4; ++j) { const f32x4 x4 = v[r][j]; s += (x4[0] * x4[0] + x4[1] * x4[1]) + (x4[2] * x4[2] + x4[3] * x4[3]);
                o8[64 * j] = (unsigned long long)pk2(x4[0], x4[1]) | ((unsigned long long)pk2(x4[2], x4[3]) << 32); }
            s = wave_sum(s); if (lane == 0) SS0[m0 + r] = s; }
    }
    float* CS = (float*)(ws + WS_CS);
    for (int e = blockIdx.x * NTHR + tid; e < M * 8; e += gridDim.x * NTHR) {
        const int tok = e >> 3, i = e & 7;
        const float inv = i == 0 ? 1.0f : i == 1 ? 0.1939227432012558f : i == 2 ? 0.03760603070259094f : i == 3 ? 0.007292664609849453f : i == 4 ? 0.0014142135623842478f : i == 5 ? 0.00027424818836152554f : i == 6 ? 5.318296098266728e-05f : 1.0313386155758053e-05f;
        const float ang = (float)a.pos[tok] * inv;
        const double ad = (double)ang, kq = __builtin_rint(ad * 0.15915494309189535), rd = ad - kq * 6.283185307179586;
        const float rr = (float)rd;
        CS[tok * 16 + i] = cosf(rr); CS[tok * 16 + 8 + i] = sinf(rr);
    }
}

constexpr int AT_QS = 0, AT_KS = 18432, AT_VS = 18432 + 36864, AT_BYTES = AT_VS + 36864;
static_assert(AT_BYTES <= RING_BYTES, "attention LDS");
typedef short v4i16_t __attribute__((ext_vector_type(4)));
__device__ __forceinline__ s16x4 tr16(const LAS unsigned char* p) { return __builtin_amdgcn_ds_read_tr16_b64_v4i16((LAS v4i16_t*)p); }
struct AttnRegs { u32x4 q[2], k[4], v[4]; };
struct AttnCoord { int br, dl, tokb, h, n; };
__device__ __forceinline__ AttnCoord attn_coord(int u) {
    AttnCoord c; c.br = u >> 10; const int rem = u & 1023, b = rem >> 9, idx = rem & 63; c.h = (rem >> 6) & 7; c.dl = 2 * c.br; const int nbl = 6 - c.dl;
    c.tokb = b * SEQ + (idx >> nbl); c.n = idx & ((1 << nbl) - 1); return c;
}
__device__ __forceinline__ void attn_load(AttnRegs& R, int u, const bf16* PA, int tid) {
    const AttnCoord c = attn_coord(u); const int ch = tid & 7, r0 = tid >> 3, jq0 = 128 * c.n, jk0 = jq0 - 128;
#pragma unroll
    for (int p = 0; p < 2; ++p) { const int tok = c.tokb + ((jq0 + r0 + 64 * p) << c.dl); R.q[p] = *(const u32x4*)(PA + (size_t)tok * LDA + c.h * 64 + ch * 8); }
#pragma unroll
    for (int p = 0; p < 4; ++p) { const int j = jk0 + r0 + 64 * p; const bool valid = j >= 0; const int tok = c.tokb + ((valid ? j : 0) << c.dl);
        const bf16* src = PA + (size_t)tok * LDA + 512 + c.h * 64 + ch * 8;
        R.k[p] = (u32x4){0u, 0u, 0u, 0u}; R.v[p] = (u32x4){0u, 0u, 0u, 0u};
        if (valid) { R.k[p] = *(const u32x4*)src; R.v[p] = *(const u32x4*)(src + 512); } }
}
__device__ __forceinline__ void attn_store(const AttnRegs& R, LAS unsigned char* L, int tid) {
    const int ch = tid & 7, r0 = tid >> 3;
#pragma unroll
    for (int p = 0; p < 2; ++p) *(LAS u32x4*)(L + AT_QS + (r0 + 64 * p) * 144 + ch * 16) = R.q[p];
#pragma unroll
    for (int p = 0; p < 4; ++p) { *(LAS u32x4*)(L + AT_KS + (r0 + 64 * p) * 144 + ch * 16) = R.k[p]; *(LAS u32x4*)(L + AT_VS + (r0 + 64 * p) * 144 + ch * 16) = R.v[p]; }
}
__device__ __forceinline__ void attn_compute(LAS unsigned char* L, int u, bf16* OB, float* LSE, int tid) {
    const AttnCoord cd = attn_coord(u); const int jq0 = 128 * cd.n, jk0 = jq0 - 128;
    const int lane = tid & 63, w = tid >> 6, c = lane & 15, quad = lane >> 4;
    const int kbase = 32 * (w >> 1), ql = 16 * w + c;
    bf16x8 qf[2];
#pragma unroll
    for (int ks = 0; ks < 2; ++ks) qf[ks] = *(const LAS bf16x8*)(L + AT_QS + ql * 144 + ks * 64 + quad * 16);
    f32x4 s[10];
#pragma unroll
    for (int t = 0; t < 10; ++t) { s[t] = (f32x4){0.f, 0.f, 0.f, 0.f};
#pragma unroll
        for (int ks = 0; ks < 2; ++ks) { const bf16x8 kf = *(const LAS bf16x8*)(L + AT_KS + (kbase + 16 * t + c) * 144 + ks * 64 + quad * 16); s[t] = MFMA16(kf, qf[ks], s[t]); } }
    float mx = -3.0e38f;
#pragma unroll
    for (int t = 0; t < 10; ++t)
#pragma unroll
        for (int i = 0; i < 4; ++i) { const int kl = kbase + 16 * t + 4 * quad + i; const bool ok = (kl >= ql) && (kl <= ql + 128) && (jk0 + kl >= 0); s[t][i] = ok ? s[t][i] : -3.0e38f; mx = fmaxf(mx, s[t][i]); }
    mx = fmaxf(mx, __shfl_xor(mx, 16)); mx = fmaxf(mx, __shfl_xor(mx, 32));
    float lsum = 0.f;
#pragma unroll
    for (int t = 0; t < 10; ++t)
#pragma unroll
        for (int i = 0; i < 4; ++i) { const float p = s[t][i] > -1.0e38f ? __expf(s[t][i] - mx) : 0.f; s[t][i] = p; lsum += p; }
    lsum += __shfl_xor(lsum, 16); lsum += __shfl_xor(lsum, 32);
    f32x4 o[4];
#pragma unroll
    for (int dt = 0; dt < 4; ++dt) o[dt] = (f32x4){0.f, 0.f, 0.f, 0.f};
    const LAS unsigned char* vb = L + AT_VS + (kbase + 4 * quad + (c >> 2)) * 144 + 8 * (c & 3);
#pragma unroll
    for (int kk = 0; kk < 5; ++kk) {
        u32x4 pw; pw.x = pk2(s[2 * kk][0], s[2 * kk][1]); pw.y = pk2(s[2 * kk][2], s[2 * kk][3]); pw.z = pk2(s[2 * kk + 1][0], s[2 * kk + 1][1]); pw.w = pk2(s[2 * kk + 1][2], s[2 * kk + 1][3]);
        const bf16x8 pf = __builtin_bit_cast(bf16x8, pw);
#pragma unroll
        for (int dt = 0; dt < 4; ++dt) {
            const s16x4 lo = tr16(vb + (32 * kk) * 144 + dt * 32), hi = tr16(vb + (32 * kk + 16) * 144 + dt * 32);
            const bf16x8 vf = {lo[0], lo[1], lo[2], lo[3], hi[0], hi[1], hi[2], hi[3]};
            o[dt] = MFMA16(vf, pf, o[dt]);
        }
    }
    const float inv = 1.0f / lsum; const int tok = cd.tokb + ((jq0 + ql) << cd.dl);
    bf16* orow = OB + ((size_t)cd.br * M + tok) * 512 + cd.h * 64 + 4 * quad;
#pragma unroll
    for (int dt = 0; dt < 4; ++dt) { u32x2 wv; wv.x = pk2(o[dt][0] * inv, o[dt][1] * inv); wv.y = pk2(o[dt][2] * inv, o[dt][3] * inv); *(u32x2*)(orow + 16 * dt) = wv; }
    if (quad == 0) LSE[((size_t)cd.br * M + tok) * 8 + cd.h] = mx + __logf(lsum);
}

constexpr int GL_TOT = 0, GL_KT = 2048, GL_V = GL_KT + 9216, GL_QD = GL_V + 64 * 272, GL_SSQ = GL_QD + 9216, GL_GA = GL_SSQ + 512;
__device__ __forceinline__ void gla_gate(LAS unsigned char* L, const u32x4 ga, const float (&w2)[17], int tid, float (&la)[8]) {
    const int seg = tid >> 6;
    if (tid < 256) *(LAS u32x4*)(L + GL_GA + tid * 16) = ga;
    __syncthreads();
#pragma unroll
    for (int i = 0; i < 8; ++i) { const LAS f32x4* gr = (const LAS f32x4*)(L + GL_GA + (8 * seg + i) * 64); float z = w2[16];
#pragma unroll
        for (int q = 0; q < 4; ++q) { const f32x4 g = gr[q]; z += g[0] * w2[4 * q] + g[1] * w2[4 * q + 1] + g[2] * w2[4 * q + 2] + g[3] * w2[4 * q + 3]; }
        la[i] = (fminf(z, 0.f) - __logf(1.0f + __expf(-fabsf(z)))) * (1.0f / 16.0f); }
}
__device__ __forceinline__ void gla_prefix(LAS unsigned char* L, const float (&la)[8], int tid, float (&bb)[8], float& blast) {
    const int seg = tid >> 6, d = tid & 63; float run = 0.f;
#pragma unroll
    for (int i = 0; i < 8; ++i) { run += la[i]; bb[i] = run; }
    LAS float* tot = (LAS float*)(L + GL_TOT);
    tot[seg * 64 + d] = run;
    __syncthreads();
    float off = 0.f, all = 0.f;
#pragma unroll
    for (int s = 0; s < 8; ++s) { const float v = tot[s * 64 + d]; all += v; off += (s < seg) ? v : 0.f; }
#pragma unroll
    for (int i = 0; i < 8; ++i) bb[i] += off;
    blast = all;
}
struct GlaURegs { unsigned short kr[8]; u32x4 vr[2]; u32x4 ga; float w2[17]; };
__device__ __forceinline__ void gla_u_load(GlaURegs& R, int unit, const bf16* PG, const float* GA, const float* wa2, const float* ba, int tid) {
    const int bh = unit >> 7, n = unit & 127, b = bh >> 2, h = bh & 3, tok0 = b * SEQ + 64 * n, seg = tid >> 6, d = tid & 63;
#pragma unroll
    for (int i = 0; i < 8; ++i) { const bf16* rp = PG + (size_t)(tok0 + 8 * seg + i) * LDG + h * 64 + d; R.kr[i] = rp[256]; }
#pragma unroll
    for (int p = 0; p < 2; ++p) { const int id = tid + 512 * p; R.vr[p] = *(const u32x4*)(PG + (size_t)(tok0 + (id >> 4)) * LDG + 512 + h * 128 + (id & 15) * 8); }
    R.ga = (u32x4){0u, 0u, 0u, 0u}; if (tid < 256) R.ga = *(const u32x4*)(GA + (size_t)tok0 * 16 + tid * 4);
#pragma unroll
    for (int r = 0; r < 16; ++r) R.w2[r] = wa2[r * 256 + h * 64 + d];
    R.w2[16] = ba[h * 64 + d];
}
__device__ __forceinline__ void gla_u_phase(LAS unsigned char* L, const bf16* PG, const float* GA, const float* wa2, const float* ba, float* UT, float* DEC, int tid, int G) {
    const int lane = tid & 63, w = tid >> 6, c = lane & 15, quad = lane >> 4, seg = tid >> 6, d = tid & 63;
    int unit = blockIdx.x;
    GlaURegs R;
    if (unit < 1024) gla_u_load(R, unit, PG, GA, wa2, ba, tid);
    while (unit < 1024) {
        float la[8]; gla_gate(L, R.ga, R.w2, tid, la);
        float bb[8], blast; gla_prefix(L, la, tid, bb, blast);
        { float kv[8];
#pragma unroll
          for (int i = 0; i < 8; ++i) kv[i] = bf2f(R.kr[i]) * __expf(blast - bb[i]);
          u32x4 wv; wv.x = pk2(kv[0], kv[1]); wv.y = pk2(kv[2], kv[3]); wv.z = pk2(kv[4], kv[5]); wv.w = pk2(kv[6], kv[7]);
          *(LAS u32x4*)(L + GL_KT + d * 144 + seg * 16) = wv;
          if (seg == 0) DEC[(size_t)unit * 64 + d] = __expf(blast); }
#pragma unroll
        for (int p = 0; p < 2; ++p) { const int id = tid + 512 * p; *(LAS u32x4*)(L + GL_V + (id >> 4) * 272 + (id & 15) * 16) = R.vr[p]; }
        __syncthreads();
        const int nu = unit + G;
        if (nu < 1024) gla_u_load(R, nu, PG, GA, wa2, ba, tid);
        f32x4 acc[4];
#pragma unroll
        for (int dt = 0; dt < 4; ++dt) acc[dt] = (f32x4){0.f, 0.f, 0.f, 0.f};
#pragma unroll
        for (int ks = 0; ks < 2; ++ks) {
            const LAS unsigned char* vp = L + GL_V + (32 * ks + 8 * quad + (c >> 2)) * 272 + (16 * w) * 2 + 8 * (c & 3);
            const s16x4 lo = tr16(vp), hi = tr16(vp + 4 * 272);
            const bf16x8 af = {lo[0], lo[1], lo[2], lo[3], hi[0], hi[1], hi[2], hi[3]};
#pragma unroll
            for (int dt = 0; dt < 4; ++dt) { const bf16x8 bfr = *(const LAS bf16x8*)(L + GL_KT + (16 * dt + c) * 144 + ks * 64 + quad * 16); acc[dt] = MFMA16(af, bfr, acc[dt]); } }
        float* up = UT + ((size_t)unit * 128 + 16 * w + 4 * quad) * 64 + c;
#pragma unroll
        for (int dt = 0; dt < 4; ++dt)
#pragma unroll
            for (int i = 0; i < 4; ++i) up[i * 64 + 16 * dt] = acc[dt][i];
        __syncthreads();
        unit = nu;
    }
}
struct GlaORegs { unsigned short qr[8], kr[8]; u32x4 vr[2]; u32x4 ga; float w2[17]; };
__device__ __forceinline__ void gla_o_load(GlaORegs& R, int unit, const bf16* PG, const float* GA, const float* wa2, const float* ba, int tid) {
    const int bh = unit >> 7, n = unit & 127, b = bh >> 2, h = bh & 3, tok0 = b * SEQ + 64 * n, seg = tid >> 6, d = tid & 63;
#pragma unroll
    for (int i = 0; i < 8; ++i) { const bf16* rp = PG + (size_t)(tok0 + 8 * seg + i) * LDG + h * 64 + d; R.qr[i] = rp[0]; R.kr[i] = rp[256]; }
#pragma unroll
    for (int p = 0; p < 2; ++p) { const int id = tid + 512 * p; R.vr[p] = *(const u32x4*)(PG + (size_t)(tok0 + (id >> 4)) * LDG + 512 + h * 128 + (id & 15) * 8); }
    R.ga = (u32x4){0u, 0u, 0u, 0u}; if (tid < 256) R.ga = *(const u32x4*)(GA + (size_t)tok0 * 16 + tid * 4);
#pragma unroll
    for (int r = 0; r < 16; ++r) R.w2[r] = wa2[r * 256 + h * 64 + d];
    R.w2[16] = ba[h * 64 + d];
}
__device__ __forceinline__ void gla_o_phase(LAS unsigned char* L, const bf16* PG, const float* GA, const float* wa2, const float* ba, const bf16* ST, const float* ggla, bf16* OM, int tid, int G) {
    const int lane = tid & 63, w = tid >> 6, c = lane & 15, quad = lane >> 4, seg = tid >> 6, d = tid & 63;
    const int it = w & 3, eh = w >> 2, itok = 16 * it + c;
    int unit = blockIdx.x;
    GlaORegs R;
    if (unit < 1024) gla_o_load(R, unit, PG, GA, wa2, ba, tid);
    while (unit < 1024) {
        const int bh = unit >> 7, n = unit & 127, b = bh >> 2, h = bh & 3, tok0 = b * SEQ + 64 * n;
        const size_t trow = (size_t)(tok0 + itok);
        bf16x8 sf[4][2]; u32x2 rv[4]; f32x4 gg[4];
#pragma unroll
        for (int e4 = 0; e4 < 4; ++e4) { const int et = 4 * eh + e4;
#pragma unroll
            for (int ks = 0; ks < 2; ++ks) sf[e4][ks] = *(const bf16x8*)(ST + ((size_t)unit * 128 + 16 * et + c) * 64 + 32 * ks + 8 * quad);
            rv[e4] = *(const u32x2*)(PG + trow * LDG + 1024 + h * 128 + 16 * et + 4 * quad); gg[e4] = *(const f32x4*)(ggla + h * 128 + 16 * et + 4 * quad); }
        float la[8]; gla_gate(L, R.ga, R.w2, tid, la);
        float bb[8], blast; gla_prefix(L, la, tid, bb, blast);
#pragma unroll
        for (int i = 0; i < 8; ++i) { const int t = 8 * seg + i;
            const float qv = bf2f(R.qr[i]) * 0.125f * __expf(bb[i]), kv = bf2f(R.kr[i]) * __expf(-bb[i]);
            *(LAS unsigned short*)(L + GL_QD + t * 144 + d * 2) = f2bf(qv); *(LAS unsigned short*)(L + GL_KT + t * 144 + d * 2) = f2bf(kv); }
#pragma unroll
        for (int p = 0; p < 2; ++p) { const int id = tid + 512 * p; *(LAS u32x4*)(L + GL_V + (id >> 4) * 272 + (id & 15) * 16) = R.vr[p]; }
        __syncthreads();
        const int nu = unit + G;
        if (nu < 1024) gla_o_load(R, nu, PG, GA, wa2, ba, tid);
        bf16x8 qf[2];
#pragma unroll
        for (int ks = 0; ks < 2; ++ks) qf[ks] = *(const LAS bf16x8*)(L + GL_QD + itok * 144 + ks * 64 + quad * 16);
        f32x4 at[4];
#pragma unroll
        for (int jt = 0; jt < 4; ++jt) { at[jt] = (f32x4){0.f, 0.f, 0.f, 0.f};
#pragma unroll
            for (int ks = 0; ks < 2; ++ks) { const bf16x8 kf = *(const LAS bf16x8*)(L + GL_KT + (16 * jt + c) * 144 + ks * 64 + quad * 16); at[jt] = MFMA16(kf, qf[ks], at[jt]); }
#pragma unroll
            for (int i = 0; i < 4; ++i) at[jt][i] = (16 * jt + 4 * quad + i <= itok) ? at[jt][i] : 0.f; }
        bf16x8 pf[2];
#pragma unroll
        for (int kk = 0; kk < 2; ++kk) { u32x4 pw; pw.x = pk2(at[2 * kk][0], at[2 * kk][1]); pw.y = pk2(at[2 * kk][2], at[2 * kk][3]); pw.z = pk2(at[2 * kk + 1][0], at[2 * kk + 1][1]); pw.w = pk2(at[2 * kk + 1][2], at[2 * kk + 1][3]);
            pf[kk] = __builtin_bit_cast(bf16x8, pw); }
        f32x4 o[4]; float ssq = 0.f;
        const LAS unsigned char* vb = L + GL_V + (4 * quad + (c >> 2)) * 272 + 8 * (c & 3);
#pragma unroll
        for (int e4 = 0; e4 < 4; ++e4) { const int et = 4 * eh + e4; f32x4 acc = {0.f, 0.f, 0.f, 0.f};
#pragma unroll
            for (int kk = 0; kk < 2; ++kk) { const s16x4 lo = tr16(vb + (32 * kk) * 272 + et * 32), hi = tr16(vb + (32 * kk + 16) * 272 + et * 32);
                const bf16x8 vf = {lo[0], lo[1], lo[2], lo[3], hi[0], hi[1], hi[2], hi[3]};
                acc = MFMA16(vf, pf[kk], acc); }
#pragma unroll
            for (int ks = 0; ks < 2; ++ks) acc = MFMA16(sf[e4][ks], qf[ks], acc);
            o[e4] = acc; ssq += (acc[0] * acc[0] + acc[1] * acc[1]) + (acc[2] * acc[2] + acc[3] * acc[3]); }
        ssq += __shfl_xor(ssq, 16); ssq += __shfl_xor(ssq, 32);
        LAS float* SSQ = (LAS float*)(L + GL_SSQ);
        if (quad == 0) SSQ[eh * 64 + itok] = ssq;
        __syncthreads();
        const float rstd = __builtin_amdgcn_rsqf((SSQ[itok] + SSQ[64 + itok]) * (1.0f / 128.0f) + EPS);
#pragma unroll
        for (int e4 = 0; e4 < 4; ++e4) { const int e = 16 * (4 * eh + e4) + 4 * quad; const f32x4 g = gg[e4];
            const float r0 = __uint_as_float(rv[e4].x << 16), r1 = __uint_as_float(rv[e4].x & 0xffff0000u), r2 = __uint_as_float(rv[e4].y << 16), r3 = __uint_as_float(rv[e4].y & 0xffff0000u);
            u32x2 wv; wv.x = pk2(o[e4][0] * rstd * g[0] * pg8::silu_f(r0), o[e4][1] * rstd * g[1] * pg8::silu_f(r1)); wv.y = pk2(o[e4][2] * rstd * g[2] * pg8::silu_f(r2), o[e4][3] * rstd * g[3] * pg8::silu_f(r3));
            *(u32x2*)(OM + trow * D + h * 128 + e) = wv; }
        __syncthreads();
        unit = nu;
    }
}

#define XB_TMO      128
#define XB_XCNT(j)  (256  + 64 * (j))
#define XB_XSUB(j)  (1280 + 64 * (j))
#define XB_XGEN(j)  (2304 + 64 * (j))
#define XB_TOP      3328
#define XB_TOPGEN   3392
#define XCD_BAR_WORDS 3456
#define XB_SPIN_CAP (1u << 18)

__device__ __forceinline__ unsigned xb_ld(unsigned* p)              { return __hip_atomic_load(p, __ATOMIC_RELAXED, __HIP_MEMORY_SCOPE_AGENT); }
__device__ __forceinline__ unsigned xb_add(unsigned* p, unsigned v) { return __hip_atomic_fetch_add(p, v, __ATOMIC_RELAXED, __HIP_MEMORY_SCOPE_AGENT); }
__device__ __forceinline__ unsigned xb_xcc_id() { return (unsigned)__builtin_amdgcn_s_getreg((3 << 11) | 20) & 0xFu; }
#define XB_SPIN(cond, bar) do { unsigned _sp = 0; while (cond) { __builtin_amdgcn_s_sleep(1); \
    if ((++_sp & 255u) == 0u) { if (xb_ld(&(bar)[XB_TMO])) break; if (_sp > XB_SPIN_CAP) { atomicAdd(&(bar)[XB_TMO], 1u); break; } } } } while (0)

struct XcdBarrier {
    unsigned* bar; unsigned x;
    volatile LAS unsigned* st;
};

__device__ __forceinline__ XcdBarrier xcd_barrier_post(unsigned* bar, volatile LAS unsigned* st) {
    XcdBarrier b; b.bar = bar; b.x = xb_xcc_id(); b.st = st;
    if (threadIdx.x == 0) (void)xb_add(&bar[XB_XCNT(b.x)], 1u);
    return b;
}
__device__ __forceinline__ void xcd_barrier_complete(unsigned* bar, unsigned x, unsigned& nloc, unsigned& nx) {
    const unsigned G = gridDim.x * gridDim.y * gridDim.z;
    unsigned sum, cnt, mine, sp = 0u;
    for (;;) {
        sum = 0u; cnt = 0u; mine = 0u;
#pragma unroll
        for (unsigned j = 0; j < 16; ++j) { const unsigned c = xb_ld(&bar[XB_XCNT(j)]); sum += c; cnt += (c > 0u) ? 1u : 0u; mine = (j == x) ? c : mine; }
        if (sum == G) break;
        __builtin_amdgcn_s_sleep(1);
        if ((++sp & 255u) == 0u) { if (xb_ld(&bar[XB_TMO])) break; if (sp > XB_SPIN_CAP) { atomicAdd(&bar[XB_TMO], 1u); break; } }
    }
    nloc = mine > 0u ? mine : 1u; nx = cnt > 0u ? cnt : 1u;
}

__device__ __forceinline__ void xcd_barrier(const XcdBarrier& b) {
    asm volatile("s_waitcnt vmcnt(0)" ::: "memory");
    __syncthreads();
    if (threadIdx.x == 0) {
        unsigned* bar = b.bar;
        __builtin_amdgcn_s_waitcnt(0);
        unsigned nloc = b.st[0], nx = b.st[1];
        if (nloc == 0u) { xcd_barrier_complete(bar, b.x, nloc, nx); b.st[0] = nloc; b.st[1] = nx; }
        const unsigned old = xb_add(&bar[XB_XSUB(b.x)], 1u);
        const unsigned gen = old / nloc;
        if (old + 1u == (gen + 1u) * nloc) {
            __builtin_amdgcn_fence(__ATOMIC_RELEASE, "agent");
            asm volatile("s_waitcnt vmcnt(0)" ::: "memory");
            const unsigned og = xb_add(&bar[XB_TOP], 1u);
            const unsigned tg = og / nx;
            if (og + 1u == (tg + 1u) * nx) xb_add(&bar[XB_TOPGEN], 1u);
            else XB_SPIN(xb_ld(&bar[XB_TOPGEN]) == tg, bar);
            __builtin_amdgcn_fence(__ATOMIC_ACQUIRE, "agent");
            xb_add(&bar[XB_XGEN(b.x)], 1u);
            asm volatile("s_waitcnt vmcnt(0)" ::: "memory");
        } else {
            XB_SPIN(xb_ld(&bar[XB_XGEN(b.x)]) == gen, bar);
            __builtin_amdgcn_fence(__ATOMIC_ACQUIRE, "agent");
            asm volatile("s_waitcnt vmcnt(0)" ::: "memory");
        }
    }
    __syncthreads();
}

__global__ void __launch_bounds__(NTHR, 2) layer_fwd(Args a) {
    extern __shared__ __attribute__((aligned(16))) unsigned char lds_raw[];
    cg::grid_group grid = cg::this_grid();
    LAS unsigned char* lds = (LAS unsigned char*)lds_raw;
    const int tid = threadIdx.x, lane = tid & 63, wave = __builtin_amdgcn_readfirstlane(tid >> 6);
    const int G = gridDim.x;
    unsigned char* ws = a.ws;
    bf16* XN = (bf16*)(ws + WS_XN); bf16* HB = (bf16*)(ws + WS_H); bf16* PG = (bf16*)(ws + WS_PG); bf16* PA = (bf16*)(ws + WS_PA); bf16* OM = (bf16*)(ws + WS_OM); bf16* OB = (bf16*)(ws + WS_OB);
    bf16* ST = (bf16*)(ws + WS_ST); float* UT = a.out;     float* DEC = (float*)(ws + WS_DEC); float* LSE = (float*)(ws + WS_LSE); float* CS = (float*)(ws + WS_CS);
    float* GA = (float*)(ws + WS_GA); float* SS0 = (float*)(ws + WS_SS0); float* SS1 = (float*)(ws + WS_SS1); float* SS2 = (float*)(ws + WS_SS2);
    unsigned* CTR = (unsigned*)(ws + WS_CTL);
    if (tid < 32) ((LAS unsigned*)(lds + MISC_OFF))[tid] = 0u;
    __syncthreads();
    if (a.use_cg_sync) grid.sync();
    const XcdBarrier bar = xcd_barrier_post((unsigned*)(ws + WS_BAR), (volatile LAS unsigned*)(lds + MISC_OFF) + 8);

    for (int rp = 0; rp < REP_P0; ++rp) p0_prologue(a, lds, tid, lane, wave);
    GSYNC();
    { pg8::Gemm g{XN, (const bf16*)(ws + WS_W13A), M, NUP, D}; pg8::StaticOrder S; S.init(M, NUP, G, (int)blockIdx.x);
      pg8::EpiSwiglu E{HB, FF, SS0};
      for (int rp = 0; rp < REP_UP; ++rp) pg8::gemm_phase<pg8::EpiSwiglu, pg8::StaticOrder, true, true>(lds, g, S, E); }
    { int li, nl; light_wg((M / 256) * (NUP / 256), G, li, nl);
      if (li >= 0) { conv_items(a, lds, IT_W2A, IT_W2B, li * NWAVES + wave, nl * NWAVES, lane, wave); gate_cols(a, li * NTHR + tid, nl * NTHR); } }
    GSYNC();
    { pg8::Gemm g{HB, (const bf16*)(ws + WS_W2A), M, D, FF}; pg8::StaticOrder S; S.init(M, D, G, (int)blockIdx.x);
      pg8::EpiResidB<false> E{a.x, XN, SS1, 0.5f, D};
      pg8::gemm_phase<pg8::EpiResidB<false>, pg8::StaticOrder, true, true>(lds, g, S, E); }
    GSYNC();
    { pg8::Gemm g{XN, (const bf16*)(ws + WS_WIN), M, NIN, D}; pg8::StaticOrder S; S.init(M, NIN, G, (int)blockIdx.x);
      pg8::EpiProj E{PG, PA, SS1, CS};
      ga_job(lds, XN, (const bf16*)(ws + WS_WGA), SS1, GA, tid, G);
      for (int rp = 0; rp < REP_IN; ++rp) pg8::gemm_phase<pg8::EpiProj, pg8::StaticOrder, true, true>(lds, g, S, E); }
    GSYNC();
    for (int rp = 0; rp < REP_MIX; ++rp) {
    gla_u_phase(lds, PG, GA, a.wa2, a.ba, UT, DEC, tid, G);
    GSYNC();
    for (int set = blockIdx.x; set < 512; set += G) {
        const int sg = tid >> 7, gcol = set * 128 + (tid & 127), bh = gcol >> 13, ed = gcol & 8191, d = ed & 63;
        const float* up = UT + ((size_t)bh * 128 + 32 * sg) * 8192 + ed; const float* dp = DEC + ((size_t)bh * 128 + 32 * sg) * 64 + d; bf16* sp = ST + ((size_t)bh * 128 + 32 * sg) * 8192 + ed;
        float uu[32], dd[32];
#pragma unroll
        for (int k = 0; k < 32; ++k) { uu[k] = up[(size_t)k * 8192]; dd[k] = dp[k * 64]; }
        float S = 0.f, P = 1.f;
#pragma unroll
        for (int k = 0; k < 32; ++k) { S = dd[k] * S + uu[k]; P *= dd[k]; }
        LAS f32x2* agg = (LAS f32x2*)lds;
        agg[sg * 128 + (tid & 127)] = (f32x2){P, S};
        __syncthreads();
        float st = 0.f;
#pragma unroll
        for (int q = 0; q < 3; ++q) { const f32x2 ag = agg[q * 128 + (tid & 127)]; if (q < sg) st = ag.x * st + ag.y; }
#pragma unroll
        for (int k = 0; k < 32; ++k) { sp[(size_t)k * 8192] = f2bf(st); st = dd[k] * st + uu[k]; }
        __syncthreads();
    }
    {
        volatile LAS unsigned* nxt = (volatile LAS unsigned*)(lds + MISC_OFF);
        if (tid == 0) nxt[0] = atomicAdd(CTR + 64 * rp, 1u);
        __syncthreads();
        unsigned u = nxt[0];
        AttnRegs R;
        if (u < 3072u) attn_load(R, (int)u, PA, tid);
        while (u < 3072u) {
            attn_store(R, lds, tid);
            if (tid == 0) nxt[1] = atomicAdd(CTR + 64 * rp, 1u);
            __syncthreads();
            const unsigned un = nxt[1];
            if (un < 3072u) attn_load(R, (int)un, PA, tid);
            attn_compute(lds, (int)u, OB, LSE, tid);
            __syncthreads();
            u = un;
        }
    }
    GSYNC();
    }
    for (int rp = 0; rp < REP_MIXC; ++rp) {
    gla_o_phase(lds, PG, GA, a.wa2, a.ba, ST, a.ggla, OM, tid, G);
    {
        const f32x4 g0 = *(const f32x4*)(a.gatt + 8 * lane), g1 = *(const f32x4*)(a.gatt + 8 * lane + 4);
        const int hh = lane >> 3;
        for (int tk0 = (blockIdx.x * NWAVES + wave) * 4; tk0 < M; tk0 += G * NWAVES * 4) {
            float ls[4][3]; u32x4 vv[4][3];
#pragma unroll
            for (int q = 0; q < 4; ++q)
#pragma unroll
                for (int r = 0; r < 3; ++r) { ls[q][r] = LSE[((size_t)r * M + tk0 + q) * 8 + hh]; vv[q][r] = *(const u32x4*)(OB + ((size_t)r * M + tk0 + q) * 512 + 8 * lane); }
#pragma unroll
            for (int q = 0; q < 4; ++q) {
                const float mx = fmaxf(ls[q][0], fmaxf(ls[q][1], ls[q][2])); float w0 = __expf(ls[q][0] - mx), w1 = __expf(ls[q][1] - mx), w2 = __expf(ls[q][2] - mx); const float iw = 1.0f / (w0 + w1 + w2); w0 *= iw; w1 *= iw; w2 *= iw;
                float o[8]; float ssq = 0.f;
#pragma unroll
                for (int i = 0; i < 4; ++i) {
                    o[2 * i] = w0 * __uint_as_float(vv[q][0][i] << 16) + w1 * __uint_as_float(vv[q][1][i] << 16) + w2 * __uint_as_float(vv[q][2][i] << 16);
                    o[2 * i + 1] = w0 * __uint_as_float(vv[q][0][i] & 0xffff0000u) + w1 * __uint_as_float(vv[q][1][i] & 0xffff0000u) + w2 * __uint_as_float(vv[q][2][i] & 0xffff0000u);
                    ssq += o[2 * i] * o[2 * i] + o[2 * i + 1] * o[2 * i + 1]; }
                ssq = wave_sum(ssq);
                const float rstd = __builtin_amdgcn_rsqf(ssq * (1.0f / 512.0f) + EPS);
                u32x4 wv; wv.x = pk2(o[0] * rstd * g0[0], o[1] * rstd * g0[1]); wv.y = pk2(o[2] * rstd * g0[2], o[3] * rstd * g0[3]); wv.z = pk2(o[4] * rstd * g1[0], o[5] * rstd * g1[1]); wv.w = pk2(o[6] * rstd * g1[2], o[7] * rstd * g1[3]);
                *(u32x4*)(OM + (size_t)(tk0 + q) * D + 512 + 8 * lane) = wv;
            }
        }
    }
    GSYNC();
    }
    { pg8::Gemm g{OM, (const bf16*)(ws + WS_WOUT), M, D, D}; pg8::StaticOrder S; S.init(M, D, G, (int)blockIdx.x);
      pg8::EpiResidB<true> E{XN, XN, SS2, 1.0f, D};
      pg8::gemm_phase<pg8::EpiResidB<true>, pg8::StaticOrder, true, true>(lds, g, S, E); }
    GSYNC();
    { pg8::Gemm g{XN, (const bf16*)(ws + WS_W13B), M, NUP, D}; pg8::StaticOrder S; S.init(M, NUP, G, (int)blockIdx.x);
      pg8::EpiSwiglu E{HB, FF, SS2};
      pg8::gemm_phase<pg8::EpiSwiglu, pg8::StaticOrder, true, true>(lds, g, S, E); }
    { int li, nl; light_wg((M / 256) * (NUP / 256), G, li, nl);
      if (li >= 0) conv_items(a, lds, IT_W2B, IT_END, li * NWAVES + wave, nl * NWAVES, lane, wave); }
    GSYNC();
    if (G == (M / 256) * (D / 256)) {
        pg8::Gemm g{HB, (const bf16*)(ws + WS_W2B), M, D, FF}; pg8::StaticOrder S; S.init(M, D, G, (int)blockIdx.x);
        pg8::EpiFinal E{XN, a.out, (float*)(ws + WS_SS3), (unsigned*)(ws + WS_PCNT), a.gf, 0.5f, D, 32u};
        pg8::gemm_phase<pg8::EpiFinal, pg8::StaticOrder, true, true>(lds, g, S, E);
    } else {
        { pg8::Gemm g{HB, (const bf16*)(ws + WS_W2B), M, D, FF}; pg8::StaticOrder S; S.init(M, D, G, (int)blockIdx.x);
          pg8::EpiResidF E{XN, a.out, 0.5f, D};
          pg8::gemm_phase<pg8::EpiResidF, pg8::StaticOrder, true, true>(lds, g, S, E); }
        GSYNC();
        for (int m = blockIdx.x * NWAVES + wave; m < M; m += G * NWAVES) {
            f32x4* xr = (f32x4*)(a.out + (size_t)m * D) + lane; f32x4 v[4]; float s = 0.f;
#pragma unroll
            for (int j = 0; j < 4; ++j) { v[j] = xr[64 * j]; s += (v[j][0] * v[j][0] + v[j][1] * v[j][1]) + (v[j][2] * v[j][2] + v[j][3] * v[j][3]); }
            const float rstd = __builtin_amdgcn_rsqf(wave_sum(s) * (1.0f / 1024.0f) + EPS);
#pragma unroll
            for (int j = 0; j < 4; ++j) { const f32x4 g = *((const f32x4*)a.gf + lane + 64 * j); xr[64 * j] = v[j] * rstd * g; }
        }
    }
}

extern "C" void kernel_launch(void* const* d_in, const int* in_sizes, int n_in, void* d_out, int out_size, void* d_ws, size_t ws_size, hipStream_t stream) {
    static int grid = 0;
    if (grid == 0) {
        if (n_in != 18 || in_sizes[0] != M * D || out_size != M * D || ws_size < WS_END) { fprintf(stderr, "kernel_launch: unexpected shapes (n_in %d, in0 %d, out %d, ws %zu)\n", n_in, n_in > 0 ? in_sizes[0] : -1, out_size, ws_size); grid = -1; return; }
        int dev = 0, cus = 0, per_cu = 0;
        if (hipGetDevice(&dev) != hipSuccess || hipDeviceGetAttribute(&cus, hipDeviceAttributeMultiprocessorCount, dev) != hipSuccess) { grid = -1; return; }
        if (hipFuncSetAttribute((const void*)layer_fwd, hipFuncAttributeMaxDynamicSharedMemorySize, LDS_BYTES) != hipSuccess) { fprintf(stderr, "kernel_launch: hipFuncSetAttribute failed\n"); grid = -1; return; }
        if (hipOccupancyMaxActiveBlocksPerMultiprocessor(&per_cu, (const void*)layer_fwd, NTHR, LDS_BYTES) != hipSuccess || per_cu < 1) { fprintf(stderr, "kernel_launch: occupancy query gave %d\n", per_cu); per_cu = 1; }
        (void)hipGetLastError();
        grid = cus * per_cu;
    }
    if (grid < 0) return;
    (void)hipMemsetAsync((char*)d_ws + WS_CTL, 0, CTL_ZERO_BYTES, stream);
    Args a{};
    a.x = (const float*)d_in[0]; a.pos = (const int*)d_in[1]; a.g1 = (const float*)d_in[2]; a.w1a = (const float*)d_in[3]; a.w3a = (const float*)d_in[4]; a.w2a = (const float*)d_in[5];
    a.gm = (const float*)d_in[6]; a.win = (const float*)d_in[7]; a.wa2 = (const float*)d_in[8]; a.ba = (const float*)d_in[9]; a.ggla = (const float*)d_in[10]; a.gatt = (const float*)d_in[11];
    a.wout = (const float*)d_in[12]; a.g2 = (const float*)d_in[13]; a.w1b = (const float*)d_in[14]; a.w3b = (const float*)d_in[15]; a.w2b = (const float*)d_in[16]; a.gf = (const float*)d_in[17];
    a.out = (float*)d_out; a.ws = (unsigned char*)d_ws;
    void* args[] = {&a};
    const hipError_t e = hipLaunchCooperativeKernel((const void*)layer_fwd, dim3(grid), dim3(NTHR), args, LDS_BYTES, stream);
    if (e != hipSuccess) fprintf(stderr, "kernel_launch: cooperative launch failed: %s (grid %d)\n", hipGetErrorString(e), grid);
}
```

```cpp
#include <hip/hip_runtime.h>
#include <hip/hip_cooperative_groups.h>
#include <cstdio>
#include <cstdint>
namespace cg = cooperative_groups;
namespace pg8 {
#define PG8_LAS __attribute__((address_space(3)))
typedef unsigned short bf16_t;
typedef short bf16x8 __attribute__((ext_vector_type(8)));
typedef float f32x4 __attribute__((ext_vector_type(4)));
typedef unsigned u32x4 __attribute__((ext_vector_type(4)));
constexpr int BM = 256, BK = 64, HALF = 128, HTB = HALF * BK * 2  , STAGE_BYTES = 8 * HTB, NXCD = 8, WGM = 8;

__host__ __device__ __forceinline__ int lds_byte(int r, int c) { const int st = (r >> 4) * 2 + (c >> 5), rr = r & 15, cc = c & 31, ob = rr * 64 + cc * 2; return st * 1024 + (ob ^ (((ob >> 9) & 1) << 5)); }
__host__ __device__ __forceinline__ void stage_rc(int b, int& R, int& C) { const int st = b / 1024, sb = b % 1024, swz = sb ^ (((sb >> 9) & 1) << 5); R = (st >> 1) * 16 + swz / 64; C = (st & 1) * 32 + (swz % 64) / 2; }
__host__ __device__ __forceinline__ int perm32(int rho) { const int n = rho >> 4, i = rho & 15; return 8 * (i >> 2) + 4 * n + (i & 3); }

struct Unit { int pm, pn; };
struct Gemm { const bf16_t* A; const bf16_t* Bt; int M, N, K; };

struct StaticOrder {
    int nM, nN, nwg, G, c;
    __host__ __device__ void init(int M, int N, int G_, int c_) { nM = M / BM; nN = N / BM; nwg = nM * nN; G = G_; c = c_; }
    __host__ __device__ bool next(int i, Unit& u) const {
        const long L = (long)i * G + c; if (L >= nwg) return false;
        int wgid = (int)L; { const int q = nwg / NXCD, r = nwg % NXCD, xcd = wgid % NXCD, off = wgid / NXCD; wgid = (xcd < r ? xcd * (q + 1) : r * (q + 1) + (xcd - r) * q) + off; }
        const int nig = WGM * nN, gid = wgid / nig, fm = gid * WGM, gsz = (nM - fm) < WGM ? (nM - fm) : WGM;
        u.pm = fm + ((wgid % nig) % gsz); u.pn = (wgid % nig) / gsz; return true;
    }
    __device__ __forceinline__ void a_ready(const Unit&) const {}
    __device__ __forceinline__ void done(const Unit&) const {}
};

__device__ __forceinline__ unsigned cvt_pk_bf16(float lo, float hi) { unsigned r; asm volatile("v_cvt_pk_bf16_f32 %0, %1, %2" : "=v"(r) : "v"(lo), "v"(hi)); return r; }
constexpr float RMS_EPS = 1e-6f;
__device__ __forceinline__ float silu_f(float x) { return x * __builtin_amdgcn_rcpf(1.0f + __expf(-x)); }
struct EpiSwiglu {
    static constexpr bool PERM = true, AFTER_DRAIN = false;
    bf16_t* O; int ldc; const float* ss;
    __device__ __forceinline__ void operator()(const f32x4 (&acc)[2][2][4][2], const Unit& u, int wr, int wc, int fr, int fq) const {
        const int row0 = u.pm * BM + wr * 64 + fr, col0 = u.pn * HALF + wc * 32 + 8 * fq;
#pragma unroll
        for (int ai = 0; ai < 2; ++ai)
#pragma unroll
            for (int m = 0; m < 4; ++m) {
                const int row = row0 + ai * HALF + m * 16;
                const float rs = __builtin_amdgcn_rsqf(ss[row] * (1.0f / 1024.0f) + RMS_EPS);
                const f32x4 a0 = acc[ai][0][m][0] * rs, a1 = acc[ai][0][m][1] * rs, b0 = acc[ai][1][m][0] * rs, b1 = acc[ai][1][m][1] * rs;
                u32x4 w;
                w.x = cvt_pk_bf16(silu_f(a0[0]) * b0[0], silu_f(a0[1]) * b0[1]); w.y = cvt_pk_bf16(silu_f(a0[2]) * b0[2], silu_f(a0[3]) * b0[3]);
                w.z = cvt_pk_bf16(silu_f(a1[0]) * b1[0], silu_f(a1[1]) * b1[1]); w.w = cvt_pk_bf16(silu_f(a1[2]) * b1[2], silu_f(a1[3]) * b1[3]);
                *(u32x4*)(O + (size_t)row * ldc + col0) = w;
            }
    }
};
struct EpiProj {
    static constexpr bool PERM = true, AFTER_DRAIN = false;
    bf16_t* PG; bf16_t* PA; const float* ss; const float* cs;
    __device__ __forceinline__ void operator()(const f32x4 (&acc)[2][2][4][2], const Unit& u, int wr, int wc, int fr, int fq) const {
        const int row0 = u.pm * BM + wr * 64 + fr;
        bf16_t* base; int ldc;
        if (u.pn < 6) { base = PG + u.pn * BM; ldc = 1792; } else { base = PA + (u.pn - 6) * BM; ldc = 1536; }
        base += wc * 32 + 8 * fq;
        const bool rot = (u.pn >= 6) && (u.pn < 10) && ((wc & 1) == 0);
        const float qs = (u.pn == 6 || u.pn == 7) ? 0.125f : 1.0f;
#pragma unroll
        for (int ai = 0; ai < 2; ++ai)
#pragma unroll
            for (int m = 0; m < 4; ++m) {
                const int row = row0 + ai * HALF + m * 16;
                const float rs = __builtin_amdgcn_rsqf(ss[row] * (1.0f / 1024.0f) + RMS_EPS);
                f32x4 c0 = {1.f, 1.f, 1.f, 1.f}, c1 = c0, s0 = {0.f, 0.f, 0.f, 0.f}, s1 = s0;
                if (rot && fq < 2) { const float* cr = cs + (size_t)row * 16; c0 = *(const f32x4*)cr; c1 = *(const f32x4*)(cr + 4); s0 = *(const f32x4*)(cr + 8); s1 = *(const f32x4*)(cr + 12);
                    if (fq == 0) { s0 = -s0; s1 = -s1; } }
#pragma unroll
                for (int bj = 0; bj < 2; ++bj) {
                    f32x4 v0 = acc[ai][bj][m][0] * rs, v1 = acc[ai][bj][m][1] * rs;
                    if (rot) {
                        f32x4 p0, p1;
#pragma unroll
                        for (int j = 0; j < 4; ++j) { p0[j] = __shfl_xor(v0[j], 16); p1[j] = __shfl_xor(v1[j], 16); }
                        v0 = v0 * c0 + p0 * s0; v1 = v1 * c1 + p1 * s1;
                    }
                    v0 = v0 * qs; v1 = v1 * qs;
                    u32x4 w; w.x = cvt_pk_bf16(v0[0], v0[1]); w.y = cvt_pk_bf16(v0[2], v0[3]); w.z = cvt_pk_bf16(v1[0], v1[1]); w.w = cvt_pk_bf16(v1[2], v1[3]);
                    *(u32x4*)(base + (size_t)row * ldc + bj * HALF) = w;
                }
            }
    }
};
struct EpiResidF {
    static constexpr bool PERM = true, AFTER_DRAIN = false;
    const bf16_t* base; float* out; float alpha; int ldc;
    __device__ __forceinline__ void operator()(const f32x4 (&acc)[2][2][4][2], const Unit& u, int wr, int wc, int fr, int fq) const {
        const int row0 = u.pm * BM + wr * 64 + fr, col0 = u.pn * BM + wc * 32 + 8 * fq;
#pragma unroll
        for (int ai = 0; ai < 2; ++ai)
#pragma unroll
            for (int m = 0; m < 4; ++m) {
                const size_t off = (size_t)(row0 + ai * HALF + m * 16) * ldc + col0;
#pragma unroll
                for (int bj = 0; bj < 2; ++bj) {
                    const u32x4 w = *(const u32x4*)(base + off + bj * HALF);
                    const f32x4 r0 = {__uint_as_float(w.x << 16), __uint_as_float(w.x & 0xffff0000u), __uint_as_float(w.y << 16), __uint_as_float(w.y & 0xffff0000u)};
                    const f32x4 r1 = {__uint_as_float(w.z << 16), __uint_as_float(w.z & 0xffff0000u), __uint_as_float(w.w << 16), __uint_as_float(w.w & 0xffff0000u)};
                    *(f32x4*)(out + off + bj * HALF) = r0 + acc[ai][bj][m][0] * alpha; *(f32x4*)(out + off + bj * HALF + 4) = r1 + acc[ai][bj][m][1] * alpha;
                }
            }
    }
};
__device__ __forceinline__ void unpack8(const u32x4 w, f32x4& a, f32x4& b) {
    a = (f32x4){__uint_as_float(w.x << 16), __uint_as_float(w.x & 0xffff0000u), __uint_as_float(w.y << 16), __uint_as_float(w.y & 0xffff0000u)};
    b = (f32x4){__uint_as_float(w.z << 16), __uint_as_float(w.z & 0xffff0000u), __uint_as_float(w.w << 16), __uint_as_float(w.w & 0xffff0000u)};
}
template <bool BASE_BF16> struct EpiResidB {
    static constexpr bool PERM = true, AFTER_DRAIN = false;
    const void* base; bf16_t* xn; float* ss; float alpha; int ldc;
    __device__ __forceinline__ void operator()(const f32x4 (&acc)[2][2][4][2], const Unit& u, int wr, int wc, int fr, int fq) const {
        const int row0 = u.pm * BM + wr * 64 + fr, col0 = u.pn * BM + wc * 32 + 8 * fq;
#pragma unroll
        for (int ai = 0; ai < 2; ++ai)
#pragma unroll
            for (int m = 0; m < 4; ++m) {
                const int row = row0 + ai * HALF + m * 16; const size_t off = (size_t)row * ldc + col0; float s = 0.f;
#pragma unroll
                for (int bj = 0; bj < 2; ++bj) {
                    f32x4 r0, r1;
                    if constexpr (BASE_BF16) unpack8(*(const u32x4*)((const bf16_t*)base + off + bj * HALF), r0, r1);
                    else { r0 = *(const f32x4*)((const float*)base + off + bj * HALF); r1 = *(const f32x4*)((const float*)base + off + bj * HALF + 4); }
                    const f32x4 o0 = r0 + acc[ai][bj][m][0] * alpha, o1 = r1 + acc[ai][bj][m][1] * alpha;
                    u32x4 w; w.x = cvt_pk_bf16(o0[0], o0[1]); w.y = cvt_pk_bf16(o0[2], o0[3]); w.z = cvt_pk_bf16(o1[0], o1[1]); w.w = cvt_pk_bf16(o1[2], o1[3]);
                    *(u32x4*)(xn + off + bj * HALF) = w;
                    s += (o0[0] * o0[0] + o0[1] * o0[1]) + (o0[2] * o0[2] + o0[3] * o0[3]) + (o1[0] * o1[0] + o1[1] * o1[1]) + (o1[2] * o1[2] + o1[3] * o1[3]);
                }
                s += __shfl_xor(s, 16); s += __shfl_xor(s, 32); if (fq == 0) atomicAdd(ss + row, s);
            }
    }
};
struct EpiFinal {
    static constexpr bool PERM = true, AFTER_DRAIN = false;
    const bf16_t* base; float* out; float* ss; unsigned* cnt; const float* gf; float alpha; int ldc; unsigned want;
    __device__ __forceinline__ void operator()(f32x4 (&acc)[2][2][4][2], const Unit& u, int wr, int wc, int fr, int fq) const {
        const int row0 = u.pm * BM + wr * 64 + fr, col0 = u.pn * BM + wc * 32 + 8 * fq;
#pragma unroll
        for (int ai = 0; ai < 2; ++ai)
#pragma unroll
            for (int m = 0; m < 4; ++m) {
                const int row = row0 + ai * HALF + m * 16; const size_t off = (size_t)row * ldc + col0; float s = 0.f;
#pragma unroll
                for (int bj = 0; bj < 2; ++bj) {
                    f32x4 r0, r1; unpack8(*(const u32x4*)(base + off + bj * HALF), r0, r1);
                    const f32x4 o0 = r0 + acc[ai][bj][m][0] * alpha, o1 = r1 + acc[ai][bj][m][1] * alpha;
                    acc[ai][bj][m][0] = o0; acc[ai][bj][m][1] = o1;
                    s += (o0[0] * o0[0] + o0[1] * o0[1]) + (o0[2] * o0[2] + o0[3] * o0[3]) + (o1[0] * o1[0] + o1[1] * o1[1]) + (o1[2] * o1[2] + o1[3] * o1[3]);
                }
                s += __shfl_xor(s, 16); s += __shfl_xor(s, 32);
                if (fq == 0) { const float old = __hip_atomic_fetch_add(ss + row, s, __ATOMIC_RELAXED, __HIP_MEMORY_SCOPE_AGENT); asm volatile("" :: "v"(old)); }
            }
        asm volatile("s_waitcnt vmcnt(0)" ::: "memory");
        unsigned* pc = cnt + 64 * u.pm;
        if ((threadIdx.x & 63) == 0) __hip_atomic_fetch_add(pc, 1u, __ATOMIC_RELAXED, __HIP_MEMORY_SCOPE_AGENT);
        { unsigned spins = 0; while ((unsigned)__builtin_amdgcn_readfirstlane(__hip_atomic_load(pc, __ATOMIC_RELAXED, __HIP_MEMORY_SCOPE_AGENT)) < want) { __builtin_amdgcn_s_sleep(2); if (++spins > (1u << 22)) break; } }
        asm volatile("" ::: "memory");
        const f32x4 g00 = *(const f32x4*)(gf + col0), g01 = *(const f32x4*)(gf + col0 + 4), g10 = *(const f32x4*)(gf + col0 + HALF), g11 = *(const f32x4*)(gf + col0 + HALF + 4);
#pragma unroll
        for (int ai = 0; ai < 2; ++ai)
#pragma unroll
            for (int m = 0; m < 4; ++m) {
                const int row = row0 + ai * HALF + m * 16; const size_t off = (size_t)row * ldc + col0;
                const float rs = __builtin_amdgcn_rsqf(__hip_atomic_load(ss + row, __ATOMIC_RELAXED, __HIP_MEMORY_SCOPE_AGENT) * (1.0f / 1024.0f) + RMS_EPS);
                *(f32x4*)(out + off) = acc[ai][0][m][0] * rs * g00; *(f32x4*)(out + off + 4) = acc[ai][0][m][1] * rs * g01;
                *(f32x4*)(out + off + HALF) = acc[ai][1][m][0] * rs * g10; *(f32x4*)(out + off + HALF + 4) = acc[ai][1][m][1] * rs * g11;
            }
    }
};
template <class Epi, class Sched, bool ALIGN_EPI = false, bool SP2 = false>
__device__ __forceinline__ void gemm_phase(PG8_LAS unsigned char* lds, const Gemm g, const Sched& S, const Epi& E) {
    int tid_ = threadIdx.x; asm volatile("" : "+v"(tid_));
    const int tid = tid_, wid = __builtin_amdgcn_readfirstlane(tid >> 6), lane = tid & 63, wr = wid >> 2, wc = wid & 3, fr = lane & 15, fq = lane >> 4;
    const int K = g.K, nt = K / BK;
    unsigned voffA[2], voffB[2];
#pragma unroll
    for (int i = 0; i < 2; ++i) { int R, C; stage_rc(tid * 16 + i * 8192, R, C); const int Rb = Epi::PERM ? ((R & ~31) + perm32(R & 31)) : R;
        voffA[i] = (unsigned)(R * K + C) * 2u; voffB[i] = (unsigned)(Rb * K + C) * 2u; }
    const size_t kstep = (size_t)(BK * 2);
    const size_t hstep = (size_t)HALF * K * 2;
    const size_t tstep = 2 * hstep;
    const unsigned ldsw = (unsigned)wid * 1024u;
    const int aoff = lds_byte(wr * 64 + fr, fq * 8), boff = lds_byte(wc * 32 + fr, fq * 8);
#define PG8_SA(b, h) (((b) * 2 + (h)) * HTB)
#define PG8_SB(b, h) ((4 + (b) * 2 + (h)) * HTB)
#define PG8_STAGE(bufoff, gbase, voff) do { _Pragma("unroll") for (int _i = 0; _i < 2; ++_i) \
        __builtin_amdgcn_global_load_lds((const unsigned*)((const char*)(gbase) + (voff)[_i]), (PG8_LAS unsigned*)(lds + (bufoff) + ldsw + _i * 8192), 16, 0, 0); } while (0)
#define PG8_LDA(dst, b, h) do { _Pragma("unroll") for (int m = 0; m < 4; ++m) _Pragma("unroll") for (int k = 0; k < 2; ++k) dst[m][k] = *(const PG8_LAS bf16x8*)(lds + PG8_SA(b, h) + aoff + m * 2048 + k * 1024); } while (0)
#define PG8_LDB(dst, b, h) do { _Pragma("unroll") for (int n = 0; n < 2; ++n) _Pragma("unroll") for (int k = 0; k < 2; ++k) dst[n][k] = *(const PG8_LAS bf16x8*)(lds + PG8_SB(b, h) + boff + n * 2048 + k * 1024); } while (0)
#define PG8_MMA(ai, bj, At, Bt) do { __builtin_amdgcn_s_setprio(1); _Pragma("unroll") for (int m = 0; m < 4; ++m) _Pragma("unroll") for (int n = 0; n < 2; ++n) _Pragma("unroll") for (int k = 0; k < 2; ++k) \
        acc[ai][bj][m][n] = __builtin_amdgcn_mfma_f32_16x16x32_bf16(Bt[n][k], At[m][k], acc[ai][bj][m][n], 0, 0, 0); __builtin_amdgcn_s_setprio(0); } while (0)
#define PG8_WAIT_V(n) asm volatile("s_waitcnt vmcnt(" #n ")" ::: "memory")
#define PG8_WAIT_L(n) asm volatile("s_waitcnt lgkmcnt(" #n ")" ::: "memory")
#define PG8_BAR __builtin_amdgcn_s_barrier()
#define PG8_SCHED __builtin_amdgcn_sched_barrier(0)
    Unit cur, nxt; int ui = 0;
    if (!S.next(0, cur)) return;
    f32x4 acc[2][2][4][2];
#pragma unroll
    for (int a = 0; a < 2; ++a)
#pragma unroll
        for (int b = 0; b < 2; ++b)
#pragma unroll
            for (int m = 0; m < 4; ++m)
#pragma unroll
                for (int n = 0; n < 2; ++n) acc[a][b][m][n] = (f32x4){0.f, 0.f, 0.f, 0.f};
    bf16x8 At[4][2], B0[2][2], B1[2][2];
    const char* cA = (const char*)g.A + (size_t)cur.pm * tstep; const char* cB = (const char*)g.Bt + (size_t)cur.pn * tstep;
    S.a_ready(cur);
    if constexpr (SP2) {
        PG8_STAGE(PG8_SB(0, 0), cB, voffB); PG8_STAGE(PG8_SB(0, 1), cB + hstep, voffB); PG8_STAGE(PG8_SA(0, 0), cA, voffA); PG8_STAGE(PG8_SA(0, 1), cA + hstep, voffA);
        if (wr == 1) PG8_BAR;
        PG8_WAIT_V(2); PG8_BAR;
        PG8_STAGE(PG8_SB(1, 0), cB + kstep, voffB); PG8_STAGE(PG8_SA(1, 0), cA + kstep, voffA); PG8_STAGE(PG8_SB(1, 1), cB + hstep + kstep, voffB);
        PG8_WAIT_V(6); PG8_BAR;
    } else {
        PG8_STAGE(PG8_SB(0, 0), cB, voffB); PG8_STAGE(PG8_SA(0, 0), cA, voffA); PG8_STAGE(PG8_SB(0, 1), cB + hstep, voffB); PG8_STAGE(PG8_SA(0, 1), cA + hstep, voffA);
        if (wr == 1) PG8_BAR;
        PG8_WAIT_V(4); PG8_BAR;
        PG8_STAGE(PG8_SB(1, 0), cB + kstep, voffB); PG8_STAGE(PG8_SA(1, 0), cA + kstep, voffA); PG8_STAGE(PG8_SB(1, 1), cB + hstep + kstep, voffB);
        PG8_WAIT_V(6); PG8_BAR;
    }
    for (;;) {
        const bool has_next = S.next(ui + 1, nxt);
        const char* nA = has_next ? (const char*)g.A + (size_t)nxt.pm * tstep : cA; const char* nB = has_next ? (const char*)g.Bt + (size_t)nxt.pn * tstep : cB;
        for (int t = 0; t < nt; t += 2) {
            const bool last = (t == nt - 2);
            const char* a1 = cA + (size_t)(t + 1) * kstep;
            const char* a2 = last ? nA : cA + (size_t)(t + 2) * kstep; const char* b2 = last ? nB : cB + (size_t)(t + 2) * kstep;
            const char* a3 = a2 + kstep; const char* b3 = b2 + kstep;
            if (last && has_next) S.a_ready(nxt);
            if constexpr (SP2) {
            PG8_LDB(B0, 0, 0); PG8_LDB(B1, 0, 1); PG8_SCHED; PG8_LDA(At, 0, 0); PG8_STAGE(PG8_SA(1, 1), a1 + hstep, voffA);
            PG8_WAIT_V(8); PG8_WAIT_L(0); PG8_BAR; PG8_MMA(0, 0, At, B0); PG8_MMA(0, 1, At, B1); PG8_BAR; PG8_SCHED;
            PG8_LDA(At, 0, 1); PG8_STAGE(PG8_SB(0, 0), b2, voffB); PG8_STAGE(PG8_SB(0, 1), b2 + hstep, voffB); PG8_STAGE(PG8_SA(0, 0), a2, voffA);
            PG8_WAIT_V(8); PG8_WAIT_L(0); PG8_BAR; PG8_MMA(1, 0, At, B0); PG8_MMA(1, 1, At, B1); PG8_BAR; PG8_SCHED;
            PG8_LDB(B0, 1, 0); PG8_LDB(B1, 1, 1); PG8_SCHED; PG8_LDA(At, 1, 0); PG8_STAGE(PG8_SA(0, 1), a2 + hstep, voffA);
            PG8_WAIT_V(8); PG8_WAIT_L(0); PG8_BAR; PG8_MMA(0, 0, At, B0); PG8_MMA(0, 1, At, B1); PG8_BAR; PG8_SCHED;
            PG8_LDA(At, 1, 1); PG8_STAGE(PG8_SB(1, 0), b3, voffB); PG8_STAGE(PG8_SB(1, 1), b3 + hstep, voffB); PG8_STAGE(PG8_SA(1, 0), a3, voffA);
            PG8_WAIT_V(8); PG8_WAIT_L(0); PG8_BAR; PG8_MMA(1, 0, At, B0); PG8_MMA(1, 1, At, B1); PG8_BAR; PG8_SCHED;
            } else {
            PG8_LDB(B0, 0, 0); PG8_SCHED; PG8_LDA(At, 0, 0); PG8_STAGE(PG8_SA(1, 1), a1 + hstep, voffA);
            PG8_WAIT_L(8); PG8_BAR; PG8_WAIT_L(0); PG8_MMA(0, 0, At, B0); PG8_BAR; PG8_SCHED;
            PG8_LDB(B1, 0, 1); PG8_STAGE(PG8_SB(0, 0), b2, voffB);
            PG8_BAR; PG8_WAIT_L(0); PG8_MMA(0, 1, At, B1); PG8_BAR;
            PG8_LDA(At, 0, 1); PG8_STAGE(PG8_SA(0, 0), a2, voffA);
            PG8_BAR; PG8_WAIT_L(0); PG8_MMA(1, 0, At, B0); PG8_BAR; PG8_SCHED;
            PG8_STAGE(PG8_SB(0, 1), b2 + hstep, voffB);
            PG8_WAIT_V(6); PG8_BAR; PG8_MMA(1, 1, At, B1); PG8_BAR;
            PG8_LDB(B0, 1, 0); PG8_SCHED; PG8_LDA(At, 1, 0); PG8_STAGE(PG8_SA(0, 1), a2 + hstep, voffA);
            PG8_WAIT_L(8); PG8_BAR; PG8_WAIT_L(0); PG8_MMA(0, 0, At, B0); PG8_BAR; PG8_SCHED;
            PG8_LDB(B1, 1, 1); PG8_STAGE(PG8_SB(1, 0), b3, voffB);
            PG8_BAR; PG8_WAIT_L(0); PG8_MMA(0, 1, At, B1); PG8_BAR;
            PG8_LDA(At, 1, 1); PG8_STAGE(PG8_SA(1, 0), a3, voffA);
            PG8_BAR; PG8_WAIT_L(0); PG8_MMA(1, 0, At, B0); PG8_BAR; PG8_SCHED;
            PG8_STAGE(PG8_SB(1, 1), b3 + hstep, voffB);
            PG8_WAIT_V(6); PG8_BAR; PG8_MMA(1, 1, At, B1); PG8_BAR;
            }
        }
        if constexpr (ALIGN_EPI) { if (wr == 0) PG8_BAR; }
        if constexpr (!Epi::AFTER_DRAIN) { E(acc, cur, wr, wc, fr, fq); S.done(cur); }
        if (!has_next) break;
#pragma unroll
        for (int a = 0; a < 2; ++a)
#pragma unroll
            for (int b = 0; b < 2; ++b)
#pragma unroll
                for (int m = 0; m < 4; ++m)
#pragma unroll
                    for (int n = 0; n < 2; ++n) acc[a][b][m][n] = (f32x4){0.f, 0.f, 0.f, 0.f};
        cur = nxt; cA = nA; cB = nB; ++ui;
        if constexpr (ALIGN_EPI) { if (wr == 1) PG8_BAR; }
    }
    PG8_WAIT_V(0);
    if constexpr (!ALIGN_EPI) { if (wr == 0) PG8_BAR; }
    PG8_BAR;
    if constexpr (Epi::AFTER_DRAIN) { E.fused(acc, cur, wr, wc, fr, fq, lds, wid, lane); S.done(cur); }
#undef PG8_SA
#undef PG8_SB
#undef PG8_STAGE
#undef PG8_LDA
#undef PG8_LDB
#undef PG8_MMA
#undef PG8_WAIT_V
#undef PG8_WAIT_L
#undef PG8_BAR
#undef PG8_SCHED
}
}

#define LAS __attribute__((address_space(3)))
typedef unsigned short bf16;
typedef short bf16x8 __attribute__((ext_vector_type(8)));
typedef short s16x4 __attribute__((ext_vector_type(4)));
typedef float f32x4 __attribute__((ext_vector_type(4)));
typedef float f32x2 __attribute__((ext_vector_type(2)));
typedef unsigned u32x4 __attribute__((ext_vector_type(4)));
typedef unsigned u32x2 __attribute__((ext_vector_type(2)));
typedef __bf16 bf16x2_t __attribute__((ext_vector_type(2)));

#ifndef REP_MIX
#define REP_MIX 1
#endif
#ifndef REP_MIXC
#define REP_MIXC 1
#endif
#ifndef REP_UP
#define REP_UP 1
#endif
#ifndef REP_DN
#define REP_DN 1
#endif
#ifndef REP_OUT
#define REP_OUT 1
#endif
#ifndef REP_SYNC
#define REP_SYNC 1
#endif
#ifndef REP_P0
#define REP_P0 1
#endif
#ifndef REP_IN
#define REP_IN 1
#endif
#define GSYNC() do { for (int _r = 0; _r < REP_SYNC; ++_r) xcd_barrier(bar); } while (0)
constexpr int NWAVES = 8, NTHR = 512;
constexpr int SEQ = 8192, M = 16384, D = 1024, FF = 2816, NUP = 2 * FF  , NIN = 3072, DIN_SRC = 3088;
constexpr int LDG = 1792, LDA = 1536;
constexpr float EPS = 1e-6f;

constexpr size_t MiB = 1u << 20;
constexpr size_t WS_CTL = 0, CTL_ZERO_BYTES = 1 * MiB;
constexpr size_t WS_SS1 = 64 * 1024, WS_SS2 = 128 * 1024, WS_SS3 = 192 * 1024, WS_BAR = 256 * 1024, WS_PCNT = 512 * 1024;
constexpr size_t WS_SS0 = 1 * MiB;
constexpr size_t WS_CS = 1 * MiB + 256 * 1024;
constexpr size_t WS_DEC = 2 * MiB + 512 * 1024;
constexpr size_t WS_LSE = 3 * MiB;
constexpr size_t WS_WGA = 4 * MiB + 512 * 1024;
constexpr size_t WS_GA = 232 * MiB;
constexpr size_t WS_W13A = 5 * MiB, WS_W2A = 16 * MiB, WS_WIN = 22 * MiB, WS_WOUT = 29 * MiB, WS_W13B = 31 * MiB, WS_W2B = 42 * MiB;
constexpr size_t WS_ST = 5 * MiB;
constexpr size_t WS_XN = 48 * MiB;
constexpr size_t WS_UT = 48 * MiB;
constexpr size_t WS_PG = 80 * MiB;
constexpr size_t WS_PA = 136 * MiB;
constexpr size_t WS_OM = 136 * MiB;
constexpr size_t WS_OB = 184 * MiB;
constexpr size_t WS_H = 80 * MiB;
constexpr size_t WS_END = 233 * MiB;
static_assert(WS_W13A + (size_t)NUP * D * 2 <= WS_W2A && WS_W2A + (size_t)D * FF * 2 <= WS_WIN && WS_WIN + (size_t)NIN * D * 2 <= WS_WOUT && WS_WOUT + (size_t)D * D * 2 <= WS_W13B &&
              WS_W13B + (size_t)NUP * D * 2 <= WS_W2B && WS_W2B + (size_t)D * FF * 2 <= WS_XN && WS_ST + 16 * MiB <= WS_WIN && WS_PG + (size_t)M * LDG * 2 <= WS_PA &&
              WS_PA + (size_t)M * LDA * 2 <= WS_OB && WS_H + (size_t)M * FF * 2 <= WS_OB && WS_OB + (size_t)3 * M * 512 * 2 <= WS_END, "d_ws map");

constexpr int RING_BYTES = 131072, LDS_BYTES = 147456, MISC_OFF = RING_BYTES;

__device__ __forceinline__ float bf2f(unsigned short v) { return __uint_as_float(((unsigned)v) << 16); }
__device__ __forceinline__ unsigned pk2(float lo, float hi) { f32x2 v = {lo, hi}; bf16x2_t b = __builtin_convertvector(v, bf16x2_t); return __builtin_bit_cast(unsigned, b); }
__device__ __forceinline__ unsigned short f2bf(float x) { return (unsigned short)(pk2(x, 0.f) & 0xffffu); }
__device__ __forceinline__ float wave_sum(float v) {
#pragma unroll
    for (int o = 1; o < 64; o <<= 1) v += __shfl_xor(v, o);
    return v;
}
#define MFMA16(a, b, c) __builtin_amdgcn_mfma_f32_16x16x32_bf16((a), (b), (c), 0, 0, 0)

struct Args {
    const float* x; const int* pos; const float* g1; const float* w1a; const float* w3a; const float* w2a; const float* gm; const float* win; const float* wa2; const float* ba;
    const float* ggla; const float* gatt; const float* wout; const float* g2; const float* w1b; const float* w3b; const float* w2b; const float* gf;
    float* out; unsigned char* ws; int use_cg_sync; int pad;
};

__device__ __forceinline__ void tr_item(const float* W, int ldw, int col0, int k0, const float* gain, bf16* WT, int K, int drow0, LAS float* scr, int lane) {
    const float* src = W + (size_t)(k0 + (lane >> 5)) * ldw + col0 + (lane & 31);
    float v[32];
#pragma unroll
    for (int i = 0; i < 32; ++i) v[i] = src[(size_t)(2 * i) * ldw];
    const int c = lane & 7;
    f32x4 g0 = {1.f, 1.f, 1.f, 1.f}, g1 = g0;
    if (gain) { g0 = *(const f32x4*)(gain + k0 + 8 * c); g1 = *(const f32x4*)(gain + k0 + 8 * c + 4); }
#pragma unroll
    for (int i = 0; i < 32; ++i) scr[(2 * i + (lane >> 5)) * 33 + (lane & 31)] = v[i];
    asm volatile("s_waitcnt lgkmcnt(0)" ::: "memory");
#pragma unroll
    for (int j = 0; j < 4; ++j) { const int n = (lane >> 3) + 8 * j; const LAS float* s = scr + (8 * c) * 33 + n;
        u32x4 o; o.x = pk2(s[0 * 33] * g0[0], s[1 * 33] * g0[1]); o.y = pk2(s[2 * 33] * g0[2], s[3 * 33] * g0[3]); o.z = pk2(s[4 * 33] * g1[0], s[5 * 33] * g1[1]); o.w = pk2(s[6 * 33] * g1[2], s[7 * 33] * g1[3]);
        *(u32x4*)(WT + (size_t)(drow0 + n) * K + k0 + 8 * c) = o; }
    asm volatile("s_waitcnt lgkmcnt(0)" ::: "memory");
}
__device__ __forceinline__ void up_item(const float* w1, const float* w3, const float* g, bf16* WT, int r, LAS float* scr, int lane) {
    const int which = r / 1408, rr = r % 1408, kb = rr / 88, nb = rr % 88;
    tr_item(which ? w3 : w1, FF, 32 * nb, 64 * kb, g, WT, D, 256 * (nb >> 2) + 32 * (nb & 3) + 128 * which, scr, lane);
}
__device__ __forceinline__ void conv_items(const Args& a, LAS unsigned char* lds, int lo, int hi, int widx, int nw, int lane_in, int wave) {
    int lane = lane_in; asm volatile("" : "+v"(lane));
    unsigned char* ws = a.ws;
    LAS float* scr = (LAS float*)(lds + wave * 16384);
    bf16* W13A = (bf16*)(ws + WS_W13A); bf16* W2A = (bf16*)(ws + WS_W2A); bf16* WIN = (bf16*)(ws + WS_WIN); bf16* WOUT = (bf16*)(ws + WS_WOUT); bf16* W13B = (bf16*)(ws + WS_W13B); bf16* W2B = (bf16*)(ws + WS_W2B);
    constexpr int I_UP = 2816, I_DN = 1408, I_IN = 1536, I_OUT = 512;
    for (int it = lo + widx; it < hi; it += nw) {
        int r = it;
        if (r < I_UP) { up_item(a.w1a, a.w3a, a.g1, W13A, r, scr, lane); continue; } r -= I_UP;
        if (r < I_DN) { tr_item(a.w2a, D, 32 * (r % 32), 64 * (r / 32), nullptr, W2A, FF, 32 * (r % 32), scr, lane); continue; } r -= I_DN;
        if (r < I_IN) { const int kb = r / 96, nb = r % 96; tr_item(a.win, DIN_SRC, nb < 48 ? 32 * nb : 32 * nb + 16, 64 * kb, a.gm, WIN, D, 32 * nb, scr, lane); continue; } r -= I_IN;
        if (r < I_OUT) { tr_item(a.wout, D, 32 * (r % 32), 64 * (r / 32), nullptr, WOUT, D, 32 * (r % 32), scr, lane); continue; } r -= I_OUT;
        if (r < I_UP) { up_item(a.w1b, a.w3b, a.g2, W13B, r, scr, lane); continue; } r -= I_UP;
        tr_item(a.w2b, D, 32 * (r % 32), 64 * (r / 32), nullptr, W2B, FF, 32 * (r % 32), scr, lane);
    }
}
constexpr int IT_W13A = 0, IT_W2A = 2816, IT_W13B = 6272, IT_W2B = 9088, IT_END = 10496;
__device__ __forceinline__ void gate_cols(const Args& a, int tidx, int nthr) {
    bf16* WGA = (bf16*)(a.ws + WS_WGA);
    for (int item = tidx; item < 16 * 128; item += nthr) {
        const int r = item & 15, kc = item >> 4; float o[8];
#pragma unroll
        for (int i = 0; i < 8; ++i) { const int k = 8 * kc + i; o[i] = a.win[(size_t)k * DIN_SRC + 1536 + r] * a.gm[k]; }
        u32x4 w; w.x = pk2(o[0], o[1]); w.y = pk2(o[2], o[3]); w.z = pk2(o[4], o[5]); w.w = pk2(o[6], o[7]);
        *(u32x4*)(WGA + (size_t)r * D + 8 * kc) = w;
    }
}
__device__ __forceinline__ void ga_job(LAS unsigned char* L, const bf16* XN, const bf16* WGA, const float* ss, float* GA, int tid, int G) {
    const int lane = tid & 63, w = tid >> 6, c = lane & 15, quad = lane >> 4, mt = w & 3, kh = w >> 2;
    for (int rb = blockIdx.x; rb < M / 64; rb += G) {
        const bf16* ap = XN + (size_t)(rb * 64 + 16 * mt + c) * D + kh * 512 + 8 * quad; const bf16* bp = WGA + (size_t)c * D + kh * 512 + 8 * quad;
        f32x4 acc = {0.f, 0.f, 0.f, 0.f};
#pragma unroll
        for (int half = 0; half < 2; ++half) {
            bf16x8 af[8], bfr[8];
#pragma unroll
            for (int ks = 0; ks < 8; ++ks) { af[ks] = *(const bf16x8*)(ap + (half * 8 + ks) * 32); bfr[ks] = *(const bf16x8*)(bp + (half * 8 + ks) * 32); }
#pragma unroll
            for (int ks = 0; ks < 8; ++ks) acc = MFMA16(af[ks], bfr[ks], acc);
        }
        LAS float* P = (LAS float*)L;
#pragma unroll
        for (int i = 0; i < 4; ++i) P[(kh * 64 + 16 * mt + 4 * quad + i) * 16 + c] = acc[i];
        __syncthreads();
        { const int row = tid >> 3, r2 = (tid & 7) * 2; const float rs = __builtin_amdgcn_rsqf(ss[rb * 64 + row] * (1.0f / 1024.0f) + EPS);
          f32x2 o; o.x = (P[row * 16 + r2] + P[(64 + row) * 16 + r2]) * rs; o.y = (P[row * 16 + r2 + 1] + P[(64 + row) * 16 + r2 + 1]) * rs;
          *(f32x2*)(GA + (size_t)(rb * 64 + row) * 16 + r2) = o; }
        __syncthreads();
    }
}
__device__ __forceinline__ void light_wg(int nunits, int G, int& idx, int& nlight) { const int rem = nunits % G; nlight = rem ? G - rem : G; idx = rem ? (int)blockIdx.x - rem : (int)blockIdx.x; }
__device__ __forceinline__ void p0_prologue(const Args& a, LAS unsigned char* lds, int tid, int lane, int wave) {
    unsigned char* ws = a.ws;
    const int gw = blockIdx.x * NWAVES + wave, NGW = gridDim.x * NWAVES;
    conv_items(a, lds, IT_W13A, IT_W2A, gw, NGW, lane, wave);
    bf16* XN = (bf16*)(ws + WS_XN); float* SS0 = (float*)(ws + WS_SS0);
    for (int m0 = gw * 4; m0 < M; m0 += NGW * 4) {
        f32x4 v[4][4];
#pragma unroll
        for (int r = 0; r < 4; ++r) { const f32x4* xr = (const f32x4*)(a.x + (size_t)(m0 + r) * D) + lane;
#pragma unroll
            for (int j = 0; j < 4; ++j) v[r][j] = xr[64 * j]; }
#pragma unroll
        for (int r = 0; r < 4; ++r) { unsigned long long* o8 = (unsigned long long*)(XN + (size_t)(m0 + r) * D) + lane; float s = 0.f;
#pragma unroll
            for (int j = 0; j < 4; ++j) { const f32x4 x4 = v[r][j]; s += (x4[0] * x4[0] + x4[1] * x4[1]) + (x4[2] * x4[2] + x4[3] * x4[3]);
                o8[64 * j] = (unsigned long long)pk2(x4[0], x4[1]) | ((unsigned long long)pk2(x4[2], x4[3]) << 32); }
            s = wave_sum(s); if (lane == 0) SS0[m0 + r] = s; }
    }
    float* CS = (float*)(ws + WS_CS);
    for (int e = blockIdx.x * NTHR + tid; e < M * 8; e += gridDim.x * NTHR) {
        const int tok = e >> 3, i = e & 7;
        const float inv = i == 0 ? 1.0f : i == 1 ? 0.1939227432012558f : i == 2 ? 0.03760603070259094f : i == 3 ? 0.007292664609849453f : i == 4 ? 0.0014142135623842478f : i == 5 ? 0.00027424818836152554f : i == 6 ? 5.318296098266728e-05f : 1.0313386155758053e-05f;
        const float ang = (float)a.pos[tok] * inv;
        const double ad = (double)ang, kq = __builtin_rint(ad * 0.15915494309189535), rd = ad - kq * 6.283185307179586;
        const float rr = (float)rd;
        CS[tok * 16 + i] = cosf(rr); CS[tok * 16 + 8 + i] = sinf(rr);
    }
}

constexpr int AT_QS = 0, AT_KS = 18432, AT_VS = 18432 + 36864, AT_BYTES = AT_VS + 36864;
static_assert(AT_BYTES <= RING_BYTES, "attention LDS");
typedef short v4i16_t __attribute__((ext_vector_type(4)));
__device__ __forceinline__ s16x4 tr16(const LAS unsigned char* p) { return __builtin_amdgcn_ds_read_tr16_b64_v4i16((LAS v4i16_t*)p); }
struct AttnRegs { u32x4 q[2], k[4], v[4]; };
struct AttnCoord { int br, dl, tokb, h, n; };
__device__ __forceinline__ AttnCoord attn_coord(int u) {
    AttnCoord c; c.br = u >> 10; const int rem = u & 1023, b = rem >> 9, idx = rem & 63; c.h = (rem >> 6) & 7; c.dl = 2 * c.br; const int nbl = 6 - c.dl;
    c.tokb = b * SEQ + (idx >> nbl); c.n = idx & ((1 << nbl) - 1); return c;
}
__device__ __forceinline__ void attn_load(AttnRegs& R, int u, const bf16* PA, int tid) {
    const AttnCoord c = attn_coord(u); const int ch = tid & 7, r0 = tid >> 3, jq0 = 128 * c.n, jk0 = jq0 - 128;
#pragma unroll
    for (int p = 0; p < 2; ++p) { const int tok = c.tokb + ((jq0 + r0 + 64 * p) << c.dl); R.q[p] = *(const u32x4*)(PA + (size_t)tok * LDA + c.h * 64 + ch * 8); }
#pragma unroll
    for (int p = 0; p < 4; ++p) { const int j = jk0 + r0 + 64 * p; const bool valid = j >= 0; const int tok = c.tokb + ((valid ? j : 0) << c.dl);
        const bf16* src = PA + (size_t)tok * LDA + 512 + c.h * 64 + ch * 8;
        R.k[p] = (u32x4){0u, 0u, 0u, 0u}; R.v[p] = (u32x4){0u, 0u, 0u, 0u};
        if (valid) { R.k[p] = *(const u32x4*)src; R.v[p] = *(const u32x4*)(src + 512); } }
}
__device__ __forceinline__ void attn_store(const AttnRegs& R, LAS unsigned char* L, int tid) {
    const int ch = tid & 7, r0 = tid >> 3;
#pragma unroll
    for (int p = 0; p < 2; ++p) *(LAS u32x4*)(L + AT_QS + (r0 + 64 * p) * 144 + ch * 16) = R.q[p];
#pragma unroll
    for (int p = 0; p < 4; ++p) { *(LAS u32x4*)(L + AT_KS + (r0 + 64 * p) * 144 + ch * 16) = R.k[p]; *(LAS u32x4*)(L + AT_VS + (r0 + 64 * p) * 144 + ch * 16) = R.v[p]; }
}
__device__ __forceinline__ void attn_compute(LAS unsigned char* L, int u, bf16* OB, float* LSE, int tid) {
    const AttnCoord cd = attn_coord(u); const int jq0 = 128 * cd.n, jk0 = jq0 - 128;
    const int lane = tid & 63, w = tid >> 6, c = lane & 15, quad = lane >> 4;
    const int kbase = 32 * (w >> 1), ql = 16 * w + c;
    bf16x8 qf[2];
#pragma unroll
    for (int ks = 0; ks < 2; ++ks) qf[ks] = *(const LAS bf16x8*)(L + AT_QS + ql * 144 + ks * 64 + quad * 16);
    f32x4 s[10];
#pragma unroll
    for (int t = 0; t < 10; ++t) { s[t] = (f32x4){0.f, 0.f, 0.f, 0.f};
#pragma unroll
        for (int ks = 0; ks < 2; ++ks) { const bf16x8 kf = *(const LAS bf16x8*)(L + AT_KS + (kbase + 16 * t + c) * 144 + ks * 64 + quad * 16); s[t] = MFMA16(kf, qf[ks], s[t]); } }
    float mx = -3.0e38f;
#pragma unroll
    for (int t = 0; t < 10; ++t)
#pragma unroll
        for (int i = 0; i < 4; ++i) { const int kl = kbase + 16 * t + 4 * quad + i; const bool ok = (kl >= ql) && (kl <= ql + 128) && (jk0 + kl >= 0); s[t][i] = ok ? s[t][i] : -3.0e38f; mx = fmaxf(mx, s[t][i]); }
    mx = fmaxf(mx, __shfl_xor(mx, 16)); mx = fmaxf(mx, __shfl_xor(mx, 32));
    float lsum = 0.f;
#pragma unroll
    for (int t = 0; t < 10; ++t)
#pragma unroll
        for (int i = 0; i < 4; ++i) { const float p = s[t][i] > -1.0e38f ? __expf(s[t][i] - mx) : 0.f; s[t][i] = p; lsum += p; }
    lsum += __shfl_xor(lsum, 16); lsum += __shfl_xor(lsum, 32);
    f32x4 o[4];
#pragma unroll
    for (int dt = 0; dt < 4; ++dt) o[dt] = (f32x4){0.f, 0.f, 0.f, 0.f};
    const LAS unsigned char* vb = L + AT_VS + (kbase + 4 * quad + (c >> 2)) * 144 + 8 * (c & 3);
#pragma unroll
    for (int kk = 0; kk < 5; ++kk) {
        u32x4 pw; pw.x = pk2(s[2 * kk][0], s[2 * kk][1]); pw.y = pk2(s[2 * kk][2], s[2 * kk][3]); pw.z = pk2(s[2 * kk + 1][0], s[2 * kk + 1][1]); pw.w = pk2(s[2 * kk + 1][2], s[2 * kk + 1][3]);
        const bf16x8 pf = __builtin_bit_cast(bf16x8, pw);
#pragma unroll
        for (int dt = 0; dt < 4; ++dt) {
            const s16x4 lo = tr16(vb + (32 * kk) * 144 + dt * 32), hi = tr16(vb + (32 * kk + 16) * 144 + dt * 32);
            const bf16x8 vf = {lo[0], lo[1], lo[2], lo[3], hi[0], hi[1], hi[2], hi[3]};
            o[dt] = MFMA16(vf, pf, o[dt]);
        }
    }
    const float inv = 1.0f / lsum; const int tok = cd.tokb + ((jq0 + ql) << cd.dl);
    bf16* orow = OB + ((size_t)cd.br * M + tok) * 512 + cd.h * 64 + 4 * quad;
#pragma unroll
    for (int dt = 0; dt < 4; ++dt) { u32x2 wv; wv.x = pk2(o[dt][0] * inv, o[dt][1] * inv); wv.y = pk2(o[dt][2] * inv, o[dt][3] * inv); *(u32x2*)(orow + 16 * dt) = wv; }
    if (quad == 0) LSE[((size_t)cd.br * M + tok) * 8 + cd.h] = mx + __logf(lsum);
}

constexpr int GL_TOT = 0, GL_KT = 2048, GL_V = GL_KT + 9216, GL_QD = GL_V + 64 * 272, GL_SSQ = GL_QD + 9216, GL_GA = GL_SSQ + 512;
__device__ __forceinline__ void gla_gate(LAS unsigned char* L, const u32x4 ga, const float (&w2)[17], int tid, float (&la)[8]) {
    const int seg = tid >> 6;
    if (tid < 256) *(LAS u32x4*)(L + GL_GA + tid * 16) = ga;
    __syncthreads();
#pragma unroll
    for (int i = 0; i < 8; ++i) { const LAS f32x4* gr = (const LAS f32x4*)(L + GL_GA + (8 * seg + i) * 64); float z = w2[16];
#pragma unroll
        for (int q = 0; q < 4; ++q) { const f32x4 g = gr[q]; z += g[0] * w2[4 * q] + g[1] * w2[4 * q + 1] + g[2] * w2[4 * q + 2] + g[3] * w2[4 * q + 3]; }
        la[i] = (fminf(z, 0.f) - __logf(1.0f + __expf(-fabsf(z)))) * (1.0f / 16.0f); }
}
__device__ __forceinline__ void gla_prefix(LAS unsigned char* L, const float (&la)[8], int tid, float (&bb)[8], float& blast) {
    const int seg = tid >> 6, d = tid & 63; float run = 0.f;
#pragma unroll
    for (int i = 0; i < 8; ++i) { run += la[i]; bb[i] = run; }
    LAS float* tot = (LAS float*)(L + GL_TOT);
    tot[seg * 64 + d] = run;
    __syncthreads();
    float off = 0.f, all = 0.f;
#pragma unroll
    for (int s = 0; s < 8; ++s) { const float v = tot[s * 64 + d]; all += v; off += (s < seg) ? v : 0.f; }
#pragma unroll
    for (int i = 0; i < 8; ++i) bb[i] += off;
    blast = all;
}
struct GlaURegs { unsigned short kr[8]; u32x4 vr[2]; u32x4 ga; float w2[17]; };
__device__ __forceinline__ void gla_u_load(GlaURegs& R, int unit, const bf16* PG, const float* GA, const float* wa2, const float* ba, int tid) {
    const int bh = unit >> 7, n = unit & 127, b = bh >> 2, h = bh & 3, tok0 = b * SEQ + 64 * n, seg = tid >> 6, d = tid & 63;
#pragma unroll
    for (int i = 0; i < 8; ++i) { const bf16* rp = PG + (size_t)(tok0 + 8 * seg + i) * LDG + h * 64 + d; R.kr[i] = rp[256]; }
#pragma unroll
    for (int p = 0; p < 2; ++p) { const int id = tid + 512 * p; R.vr[p] = *(const u32x4*)(PG + (size_t)(tok0 + (id >> 4)) * LDG + 512 + h * 128 + (id & 15) * 8); }
    R.ga = (u32x4){0u, 0u, 0u, 0u}; if (tid < 256) R.ga = *(const u32x4*)(GA + (size_t)tok0 * 16 + tid * 4);
#pragma unroll
    for (int r = 0; r < 16; ++r) R.w2[r] = wa2[r * 256 + h * 64 + d];
    R.w2[16] = ba[h * 64 + d];
}
__device__ __forceinline__ void gla_u_phase(LAS unsigned char* L, const bf16* PG, const float* GA, const float* wa2, const float* ba, float* UT, float* DEC, int tid, int G) {
    const int lane = tid & 63, w = tid >> 6, c = lane & 15, quad = lane >> 4, seg = tid >> 6, d = tid & 63;
    int unit = blockIdx.x;
    GlaURegs R;
    if (unit < 1024) gla_u_load(R, unit, PG, GA, wa2, ba, tid);
    while (unit < 1024) {
        float la[8]; gla_gate(L, R.ga, R.w2, tid, la);
        float bb[8], blast; gla_prefix(L, la, tid, bb, blast);
        { float kv[8];
#pragma unroll
          for (int i = 0; i < 8; ++i) kv[i] = bf2f(R.kr[i]) * __expf(blast - bb[i]);
          u32x4 wv; wv.x = pk2(kv[0], kv[1]); wv.y = pk2(kv[2], kv[3]); wv.z = pk2(kv[4], kv[5]); wv.w = pk2(kv[6], kv[7]);
          *(LAS u32x4*)(L + GL_KT + d * 144 + seg * 16) = wv;
          if (seg == 0) DEC[(size_t)unit * 64 + d] = __expf(blast); }
#pragma unroll
        for (int p = 0; p < 2; ++p) { const int id = tid + 512 * p; *(LAS u32x4*)(L + GL_V + (id >> 4) * 272 + (id & 15) * 16) = R.vr[p]; }
        __syncthreads();
        const int nu = unit + G;
        if (nu < 1024) gla_u_load(R, nu, PG, GA, wa2, ba, tid);
        f32x4 acc[4];
#pragma unroll
        for (int dt = 0; dt < 4; ++dt) acc[dt] = (f32x4){0.f, 0.f, 0.f, 0.f};
#pragma unroll
        for (int ks = 0; ks < 2; ++ks) {
            const LAS unsigned char* vp = L + GL_V + (32 * ks + 8 * quad + (c >> 2)) * 272 + (16 * w) * 2 + 8 * (c & 3);
            const s16x4 lo = tr16(vp), hi = tr16(vp + 4 * 272);
            const bf16x8 af = {lo[0], lo[1], lo[2], lo[3], hi[0], hi[1], hi[2], hi[3]};
#pragma unroll
            for (int dt = 0; dt < 4; ++dt) { const bf16x8 bfr = *(const LAS bf16x8*)(L + GL_KT + (16 * dt + c) * 144 + ks * 64 + quad * 16); acc[dt] = MFMA16(af, bfr, acc[dt]); } }
        float* up = UT + ((size_t)unit * 128 + 16 * w + 4 * quad) * 64 + c;
#pragma unroll
        for (int dt = 0; dt < 4; ++dt)
#pragma unroll
            for (int i = 0; i < 4; ++i) up[i * 64 + 16 * dt] = acc[dt][i];
        __syncthreads();
        unit = nu;
    }
}
struct GlaORegs { unsigned short qr[8], kr[8]; u32x4 vr[2]; u32x4 ga; float w2[17]; };
__device__ __forceinline__ void gla_o_load(GlaORegs& R, int unit, const bf16* PG, const float* GA, const float* wa2, const float* ba, int tid) {
    const int bh = unit >> 7, n = unit & 127, b = bh >> 2, h = bh & 3, tok0 = b * SEQ + 64 * n, seg = tid >> 6, d = tid & 63;
#pragma unroll
    for (int i = 0; i < 8; ++i) { const bf16* rp = PG + (size_t)(tok0 + 8 * seg + i) * LDG + h * 64 + d; R.qr[i] = rp[0]; R.kr[i] = rp[256]; }
#pragma unroll
    for (int p = 0; p < 2; ++p) { const int id = tid + 512 * p; R.vr[p] = *(const u32x4*)(PG + (size_t)(tok0 + (id >> 4)) * LDG + 512 + h * 128 + (id & 15) * 8); }
    R.ga = (u32x4){0u, 0u, 0u, 0u}; if (tid < 256) R.ga = *(const u32x4*)(GA + (size_t)tok0 * 16 + tid * 4);
#pragma unroll
    for (int r = 0; r < 16; ++r) R.w2[r] = wa2[r * 256 + h * 64 + d];
    R.w2[16] = ba[h * 64 + d];
}
__device__ __forceinline__ void gla_o_phase(LAS unsigned char* L, const bf16* PG, const float* GA, const float* wa2, const float* ba, const bf16* ST, const float* ggla, bf16* OM, int tid, int G) {
    const int lane = tid & 63, w = tid >> 6, c = lane & 15, quad = lane >> 4, seg = tid >> 6, d = tid & 63;
    const int it = w & 3, eh = w >> 2, itok = 16 * it + c;
    int unit = blockIdx.x;
    GlaORegs R;
    if (unit < 1024) gla_o_load(R, unit, PG, GA, wa2, ba, tid);
    while (unit < 1024) {
        const int bh = unit >> 7, n = unit & 127, b = bh >> 2, h = bh & 3, tok0 = b * SEQ + 64 * n;
        const size_t trow = (size_t)(tok0 + itok);
        bf16x8 sf[4][2]; u32x2 rv[4]; f32x4 gg[4];
#pragma unroll
        for (int e4 = 0; e4 < 4; ++e4) { const int et = 4 * eh + e4;
#pragma unroll
            for (int ks = 0; ks < 2; ++ks) sf[e4][ks] = *(const bf16x8*)(ST + ((size_t)unit * 128 + 16 * et + c) * 64 + 32 * ks + 8 * quad);
            rv[e4] = *(const u32x2*)(PG + trow * LDG + 1024 + h * 128 + 16 * et + 4 * quad); gg[e4] = *(const f32x4*)(ggla + h * 128 + 16 * et + 4 * quad); }
        float la[8]; gla_gate(L, R.ga, R.w2, tid, la);
        float bb[8], blast; gla_prefix(L, la, tid, bb, blast);
#pragma unroll
        for (int i = 0; i < 8; ++i) { const int t = 8 * seg + i;
            const float qv = bf2f(R.qr[i]) * 0.125f * __expf(bb[i]), kv = bf2f(R.kr[i]) * __expf(-bb[i]);
            *(LAS unsigned short*)(L + GL_QD + t * 144 + d * 2) = f2bf(qv); *(LAS unsigned short*)(L + GL_KT + t * 144 + d * 2) = f2bf(kv); }
#pragma unroll
        for (int p = 0; p < 2; ++p) { const int id = tid + 512 * p; *(LAS u32x4*)(L + GL_V + (id >> 4) * 272 + (id & 15) * 16) = R.vr[p]; }
        __syncthreads();
        const int nu = unit + G;
        if (nu < 1024) gla_o_load(R, nu, PG, GA, wa2, ba, tid);
        bf16x8 qf[2];
#pragma unroll
        for (int ks = 0; ks < 2; ++ks) qf[ks] = *(const LAS bf16x8*)(L + GL_QD + itok * 144 + ks * 64 + quad * 16);
        f32x4 at[4];
#pragma unroll
        for (int jt = 0; jt < 4; ++jt) { at[jt] = (f32x4){0.f, 0.f, 0.f, 0.f};
#pragma unroll
            for (int ks = 0; ks < 2; ++ks) { const bf16x8 kf = *(const LAS bf16x8*)(L + GL_KT + (16 * jt + c) * 144 + ks * 64 + quad * 16); at[jt] = MFMA16(kf, qf[ks], at[jt]); }
#pragma unroll
            for (int i = 0; i < 4; ++i) at[jt][i] = (16 * jt + 4 * quad + i <= itok) ? at[jt][i] : 0.f; }
        bf16x8 pf[2];
#pragma unroll
        for (int kk = 0; kk < 2; ++kk) { u32x4 pw; pw.x = pk2(at[2 * kk][0], at[2 * kk][1]); pw.y = pk2(at[2 * kk][2], at[2 * kk][3]); pw.z = pk2(at[2 * kk + 1][0], at[2 * kk + 1][1]); pw.w = pk2(at[2 * kk + 1][2], at[2 * kk + 1][3]);
            pf[kk] = __builtin_bit_cast(bf16x8, pw); }
        f32x4 o[4]; float ssq = 0.f;
        const LAS unsigned char* vb = L + GL_V + (4 * quad + (c >> 2)) * 272 + 8 * (c & 3);
#pragma unroll
        for (int e4 = 0; e4 < 4; ++e4) { const int et = 4 * eh + e4; f32x4 acc = {0.f, 0.f, 0.f, 0.f};
#pragma unroll
            for (int kk = 0; kk < 2; ++kk) { const s16x4 lo = tr16(vb + (32 * kk) * 272 + et * 32), hi = tr16(vb + (32 * kk + 16) * 272 + et * 32);
                const bf16x8 vf = {lo[0], lo[1], lo[2], lo[3], hi[0], hi[1], hi[2], hi[3]};
                acc = MFMA16(vf, pf[kk], acc); }
#pragma unroll
            for (int ks = 0; ks < 2; ++ks) acc = MFMA16(sf[e4][ks], qf[ks], acc);
            o[e4] = acc; ssq += (acc[0] * acc[0] + acc[1] * acc[1]) + (acc[2] * acc[2] + acc[3] * acc[3]); }
        ssq += __shfl_xor(ssq, 16); ssq += __shfl_xor(ssq, 32);
        LAS float* SSQ = (LAS float*)(L + GL_SSQ);
        if (quad == 0) SSQ[eh * 64 + itok] = ssq;
        __syncthreads();
        const float rstd = __builtin_amdgcn_rsqf((SSQ[itok] + SSQ[64 + itok]) * (1.0f / 128.0f) + EPS);
#pragma unroll
        for (int e4 = 0; e4 < 4; ++e4) { const int e = 16 * (4 * eh + e4) + 4 * quad; const f32x4 g = gg[e4];
            const float r0 = __uint_as_float(rv[e4].x << 16), r1 = __uint_as_float(rv[e4].x & 0xffff0000u), r2 = __uint_as_float(rv[e4].y << 16), r3 = __uint_as_float(rv[e4].y & 0xffff0000u);
            u32x2 wv; wv.x = pk2(o[e4][0] * rstd * g[0] * pg8::silu_f(r0), o[e4][1] * rstd * g[1] * pg8::silu_f(r1)); wv.y = pk2(o[e4][2] * rstd * g[2] * pg8::silu_f(r2), o[e4][3] * rstd * g[3] * pg8::silu_f(r3));
            *(u32x2*)(OM + trow * D + h * 128 + e) = wv; }
        __syncthreads();
        unit = nu;
    }
}

#define XB_TMO      128
#define XB_XCNT(j)  (256  + 64 * (j))
#define XB_XSUB(j)  (1280 + 64 * (j))
#define XB_XGEN(j)  (2304 + 64 * (j))
#define XB_TOP      3328
#define XB_TOPGEN   3392
#define XCD_BAR_WORDS 3456
#define XB_SPIN_CAP (1u << 18)

__device__ __forceinline__ unsigned xb_ld(unsigned* p)              { return __hip_atomic_load(p, __ATOMIC_RELAXED, __HIP_MEMORY_SCOPE_AGENT); }
__device__ __forceinline__ unsigned xb_add(unsigned* p, unsigned v) { return __hip_atomic_fetch_add(p, v, __ATOMIC_RELAXED, __HIP_MEMORY_SCOPE_AGENT); }
__device__ __forceinline__ unsigned xb_xcc_id() { return (unsigned)__builtin_amdgcn_s_getreg((3 << 11) | 20) & 0xFu; }
#define XB_SPIN(cond, bar) do { unsigned _sp = 0; while (cond) { __builtin_amdgcn_s_sleep(1); \
    if ((++_sp & 255u) == 0u) { if (xb_ld(&(bar)[XB_TMO])) break; if (_sp > XB_SPIN_CAP) { atomicAdd(&(bar)[XB_TMO], 1u); break; } } } } while (0)

struct XcdBarrier {
    unsigned* bar; unsigned x;
    volatile LAS unsigned* st;
};

__device__ __forceinline__ XcdBarrier xcd_barrier_post(unsigned* bar, volatile LAS unsigned* st) {
    XcdBarrier b; b.bar = bar; b.x = xb_xcc_id(); b.st = st;
    if (threadIdx.x == 0) (void)xb_add(&bar[XB_XCNT(b.x)], 1u);
    return b;
}
__device__ __forceinline__ void xcd_barrier_complete(unsigned* bar, unsigned x, unsigned& nloc, unsigned& nx) {
    const unsigned G = gridDim.x * gridDim.y * gridDim.z;
    unsigned sum, cnt, mine, sp = 0u;
    for (;;) {
        sum = 0u; cnt = 0u; mine = 0u;
#pragma unroll
        for (unsigned j = 0; j < 16; ++j) { const unsigned c = xb_ld(&bar[XB_XCNT(j)]); sum += c; cnt += (c > 0u) ? 1u : 0u; mine = (j == x) ? c : mine; }
        if (sum == G) break;
        __builtin_amdgcn_s_sleep(1);
        if ((++sp & 255u) == 0u) { if (xb_ld(&bar[XB_TMO])) break; if (sp > XB_SPIN_CAP) { atomicAdd(&bar[XB_TMO], 1u); break; } }
    }
    nloc = mine > 0u ? mine : 1u; nx = cnt > 0u ? cnt : 1u;
}

__device__ __forceinline__ void xcd_barrier(const XcdBarrier& b) {
    asm volatile("s_waitcnt vmcnt(0)" ::: "memory");
    __syncthreads();
    if (threadIdx.x == 0) {
        unsigned* bar = b.bar;
        __builtin_amdgcn_s_waitcnt(0);
        unsigned nloc = b.st[0], nx = b.st[1];
        if (nloc == 0u) { xcd_barrier_complete(bar, b.x, nloc, nx); b.st[0] = nloc; b.st[1] = nx; }
        const unsigned old = xb_add(&bar[XB_XSUB(b.x)], 1u);
        const unsigned gen = old / nloc;
        if (old + 1u == (gen + 1u) * nloc) {
            __builtin_amdgcn_fence(__ATOMIC_RELEASE, "agent");
            asm volatile("s_waitcnt vmcnt(0)" ::: "memory");
            const unsigned og = xb_add(&bar[XB_TOP], 1u);
            const unsigned tg = og / nx;
            if (og + 1u == (tg + 1u) * nx) xb_add(&bar[XB_TOPGEN], 1u);
            else XB_SPIN(xb_ld(&bar[XB_TOPGEN]) == tg, bar);
            __builtin_amdgcn_fence(__ATOMIC_ACQUIRE, "agent");
            xb_add(&bar[XB_XGEN(b.x)], 1u);
            asm volatile("s_waitcnt vmcnt(0)" ::: "memory");
        } else {
            XB_SPIN(xb_ld(&bar[XB_XGEN(b.x)]) == gen, bar);
            __builtin_amdgcn_fence(__ATOMIC_ACQUIRE, "agent");
            asm volatile("s_waitcnt vmcnt(0)" ::: "memory");
        }
    }
    __syncthreads();
}

__global__ void __launch_bounds__(NTHR, 2) layer_fwd(Args a) {
    extern __shared__ __attribute__((aligned(16))) unsigned char lds_raw[];
    cg::grid_group grid = cg::this_grid();
    LAS unsigned char* lds = (LAS unsigned char*)lds_raw;
    const int tid = threadIdx.x, lane = tid & 63, wave = __builtin_amdgcn_readfirstlane(tid >> 6);
    const int G = gridDim.x;
    unsigned char* ws = a.ws;
    bf16* XN = (bf16*)(ws + WS_XN); bf16* HB = (bf16*)(ws + WS_H); bf16* PG = (bf16*)(ws + WS_PG); bf16* PA = (bf16*)(ws + WS_PA); bf16* OM = (bf16*)(ws + WS_OM); bf16* OB = (bf16*)(ws + WS_OB);
    bf16* ST = (bf16*)(ws + WS_ST); float* UT = a.out;     float* DEC = (float*)(ws + WS_DEC); float* LSE = (float*)(ws + WS_LSE); float* CS = (float*)(ws + WS_CS);
    float* GA = (float*)(ws + WS_GA); float* SS0 = (float*)(ws + WS_SS0); float* SS1 = (float*)(ws + WS_SS1); float* SS2 = (float*)(ws + WS_SS2);
    unsigned* CTR = (unsigned*)(ws + WS_CTL);
    if (tid < 32) ((LAS unsigned*)(lds + MISC_OFF))[tid] = 0u;
    __syncthreads();
    if (a.use_cg_sync) grid.sync();
    const XcdBarrier bar = xcd_barrier_post((unsigned*)(ws + WS_BAR), (volatile LAS unsigned*)(lds + MISC_OFF) + 8);

    for (int rp = 0; rp < REP_P0; ++rp) p0_prologue(a, lds, tid, lane, wave);
    GSYNC();
    { pg8::Gemm g{XN, (const bf16*)(ws + WS_W13A), M, NUP, D}; pg8::StaticOrder S; S.init(M, NUP, G, (int)blockIdx.x);
      pg8::EpiSwiglu E{HB, FF, SS0};
      for (int rp = 0; rp < REP_UP; ++rp) pg8::gemm_phase<pg8::EpiSwiglu, pg8::StaticOrder, true, true>(lds, g, S, E); }
    { int li, nl; light_wg((M / 256) * (NUP / 256), G, li, nl);
      if (li >= 0) { conv_items(a, lds, IT_W2A, IT_W13B, li * NWAVES + wave, nl * NWAVES, lane, wave); gate_cols(a, li * NTHR + tid, nl * NTHR); } }
    GSYNC();
    { pg8::Gemm g{HB, (const bf16*)(ws + WS_W2A), M, D, FF}; pg8::StaticOrder S; S.init(M, D, G, (int)blockIdx.x);
      pg8::EpiResidB<false> E{a.x, XN, SS1, 0.5f, D};
      pg8::gemm_phase<pg8::EpiResidB<false>, pg8::StaticOrder, true, true>(lds, g, S, E); }
    GSYNC();
    { pg8::Gemm g{XN, (const bf16*)(ws + WS_WIN), M, NIN, D}; pg8::StaticOrder S; S.init(M, NIN, G, (int)blockIdx.x);
      pg8::EpiProj E{PG, PA, SS1, CS};
      ga_job(lds, XN, (const bf16*)(ws + WS_WGA), SS1, GA, tid, G);
      for (int rp = 0; rp < REP_IN; ++rp) pg8::gemm_phase<pg8::EpiProj, pg8::StaticOrder, true, true>(lds, g, S, E); }
    GSYNC();
    for (int rp = 0; rp < REP_MIX; ++rp) {
    gla_u_phase(lds, PG, GA, a.wa2, a.ba, UT, DEC, tid, G);
    GSYNC();
    for (int set = blockIdx.x; set < 512; set += G) {
        const int sg = tid >> 7, gcol = set * 128 + (tid & 127), bh = gcol >> 13, ed = gcol & 8191, d = ed & 63;
        const float* up = UT + ((size_t)bh * 128 + 32 * sg) * 8192 + ed; const float* dp = DEC + ((size_t)bh * 128 + 32 * sg) * 64 + d; bf16* sp = ST + ((size_t)bh * 128 + 32 * sg) * 8192 + ed;
        float uu[32], dd[32];
#pragma unroll
        for (int k = 0; k < 32; ++k) { uu[k] = up[(size_t)k * 8192]; dd[k] = dp[k * 64]; }
        float S = 0.f, P = 1.f;
#pragma unroll
        for (int k = 0; k < 32; ++k) { S = dd[k] * S + uu[k]; P *= dd[k]; }
        LAS f32x2* agg = (LAS f32x2*)lds;
        agg[sg * 128 + (tid & 127)] = (f32x2){P, S};
        __syncthreads();
        float st = 0.f;
#pragma unroll
        for (int q = 0; q < 3; ++q) { const f32x2 ag = agg[q * 128 + (tid & 127)]; if (q < sg) st = ag.x * st + ag.y; }
#pragma unroll
        for (int k = 0; k < 32; ++k) { sp[(size_t)k * 8192] = f2bf(st); st = dd[k] * st + uu[k]; }
        __syncthreads();
    }
    {
        volatile LAS unsigned* nxt = (volatile LAS unsigned*)(lds + MISC_OFF);
        if (tid == 0) nxt[0] = atomicAdd(CTR + 64 * rp, 1u);
        __syncthreads();
        unsigned u = nxt[0];
        AttnRegs R;
        if (u < 3072u) attn_load(R, (int)u, PA, tid);
        while (u < 3072u) {
            attn_store(R, lds, tid);
            if (tid == 0) nxt[1] = atomicAdd(CTR + 64 * rp, 1u);
            __syncthreads();
            const unsigned un = nxt[1];
            if (un < 3072u) attn_load(R, (int)un, PA, tid);
            attn_compute(lds, (int)u, OB, LSE, tid);
            __syncthreads();
            u = un;
        }
        constexpr unsigned NCONV = (IT_W2B - IT_W13B) / 16;
        while (u < 3072u + NCONV) {
            const int lo = IT_W13B + 16 * (int)(u - 3072u);
            conv_items(a, lds, lo, lo + 16, wave, NWAVES, lane, wave);
            __syncthreads();
            if (tid == 0) nxt[0] = atomicAdd(CTR + 64 * rp, 1u);
            __syncthreads();
            u = nxt[0];
        }
    }
    GSYNC();
    }
    for (int rp = 0; rp < REP_MIXC; ++rp) {
    gla_o_phase(lds, PG, GA, a.wa2, a.ba, ST, a.ggla, OM, tid, G);
    {
        const f32x4 g0 = *(const f32x4*)(a.gatt + 8 * lane), g1 = *(const f32x4*)(a.gatt + 8 * lane + 4);
        const int hh = lane >> 3;
        for (int tk0 = (blockIdx.x * NWAVES + wave) * 4; tk0 < M; tk0 += G * NWAVES * 4) {
            float ls[4][3]; u32x4 vv[4][3];
#pragma unroll
            for (int q = 0; q < 4; ++q)
#pragma unroll
                for (int r = 0; r < 3; ++r) { ls[q][r] = LSE[((size_t)r * M + tk0 + q) * 8 + hh]; vv[q][r] = *(const u32x4*)(OB + ((size_t)r * M + tk0 + q) * 512 + 8 * lane); }
#pragma unroll
            for (int q = 0; q < 4; ++q) {
                const float mx = fmaxf(ls[q][0], fmaxf(ls[q][1], ls[q][2])); float w0 = __expf(ls[q][0] - mx), w1 = __expf(ls[q][1] - mx), w2 = __expf(ls[q][2] - mx); const float iw = 1.0f / (w0 + w1 + w2); w0 *= iw; w1 *= iw; w2 *= iw;
                float o[8]; float ssq = 0.f;
#pragma unroll
                for (int i = 0; i < 4; ++i) {
                    o[2 * i] = w0 * __uint_as_float(vv[q][0][i] << 16) + w1 * __uint_as_float(vv[q][1][i] << 16) + w2 * __uint_as_float(vv[q][2][i] << 16);
                    o[2 * i + 1] = w0 * __uint_as_float(vv[q][0][i] & 0xffff0000u) + w1 * __uint_as_float(vv[q][1][i] & 0xffff0000u) + w2 * __uint_as_float(vv[q][2][i] & 0xffff0000u);
                    ssq += o[2 * i] * o[2 * i] + o[2 * i + 1] * o[2 * i + 1]; }
                ssq = wave_sum(ssq);
                const float rstd = __builtin_amdgcn_rsqf(ssq * (1.0f / 512.0f) + EPS);
                u32x4 wv; wv.x = pk2(o[0] * rstd * g0[0], o[1] * rstd * g0[1]); wv.y = pk2(o[2] * rstd * g0[2], o[3] * rstd * g0[3]); wv.z = pk2(o[4] * rstd * g1[0], o[5] * rstd * g1[1]); wv.w = pk2(o[6] * rstd * g1[2], o[7] * rstd * g1[3]);
                *(u32x4*)(OM + (size_t)(tk0 + q) * D + 512 + 8 * lane) = wv;
            }
        }
    }
    GSYNC();
    }
    { pg8::Gemm g{OM, (const bf16*)(ws + WS_WOUT), M, D, D}; pg8::StaticOrder S; S.init(M, D, G, (int)blockIdx.x);
      pg8::EpiResidB<true> E{XN, XN, SS2, 1.0f, D};
      pg8::gemm_phase<pg8::EpiResidB<true>, pg8::StaticOrder, true, true>(lds, g, S, E); }
    GSYNC();
    { pg8::Gemm g{XN, (const bf16*)(ws + WS_W13B), M, NUP, D}; pg8::StaticOrder S; S.init(M, NUP, G, (int)blockIdx.x);
      pg8::EpiSwiglu E{HB, FF, SS2};
      pg8::gemm_phase<pg8::EpiSwiglu, pg8::StaticOrder, true, true>(lds, g, S, E); }
    { int li, nl; light_wg((M / 256) * (NUP / 256), G, li, nl);
      if (li >= 0) conv_items(a, lds, IT_W2B, IT_END, li * NWAVES + wave, nl * NWAVES, lane, wave); }
    GSYNC();
    if (G == (M / 256) * (D / 256)) {
        pg8::Gemm g{HB, (const bf16*)(ws + WS_W2B), M, D, FF}; pg8::StaticOrder S; S.init(M, D, G, (int)blockIdx.x);
        pg8::EpiFinal E{XN, a.out, (float*)(ws + WS_SS3), (unsigned*)(ws + WS_PCNT), a.gf, 0.5f, D, 32u};
        pg8::gemm_phase<pg8::EpiFinal, pg8::StaticOrder, true, true>(lds, g, S, E);
    } else {
        { pg8::Gemm g{HB, (const bf16*)(ws + WS_W2B), M, D, FF}; pg8::StaticOrder S; S.init(M, D, G, (int)blockIdx.x);
          pg8::EpiResidF E{XN, a.out, 0.5f, D};
          pg8::gemm_phase<pg8::EpiResidF, pg8::StaticOrder, true, true>(lds, g, S, E); }
        GSYNC();
        for (int m = blockIdx.x * NWAVES + wave; m < M; m += G * NWAVES) {
            f32x4* xr = (f32x4*)(a.out + (size_t)m * D) + lane; f32x4 v[4]; float s = 0.f;
#pragma unroll
            for (int j = 0; j < 4; ++j) { v[j] = xr[64 * j]; s += (v[j][0] * v[j][0] + v[j][1] * v[j][1]) + (v[j][2] * v[j][2] + v[j][3] * v[j][3]); }
            const float rstd = __builtin_amdgcn_rsqf(wave_sum(s) * (1.0f / 1024.0f) + EPS);
#pragma unroll
            for (int j = 0; j < 4; ++j) { const f32x4 g = *((const f32x4*)a.gf + lane + 64 * j); xr[64 * j] = v[j] * rstd * g; }
        }
    }
}

extern "C" void kernel_launch(void* const* d_in, const int* in_sizes, int n_in, void* d_out, int out_size, void* d_ws, size_t ws_size, hipStream_t stream) {
    static int grid = 0;
    if (grid == 0) {
        if (n_in != 18 || in_sizes[0] != M * D || out_size != M * D || ws_size < WS_END) { fprintf(stderr, "kernel_launch: unexpected shapes (n_in %d, in0 %d, out %d, ws %zu)\n", n_in, n_in > 0 ? in_sizes[0] : -1, out_size, ws_size); grid = -1; return; }
        int dev = 0, cus = 0, per_cu = 0;
        if (hipGetDevice(&dev) != hipSuccess || hipDeviceGetAttribute(&cus, hipDeviceAttributeMultiprocessorCount, dev) != hipSuccess) { grid = -1; return; }
        if (hipFuncSetAttribute((const void*)layer_fwd, hipFuncAttributeMaxDynamicSharedMemorySize, LDS_BYTES) != hipSuccess) { fprintf(stderr, "kernel_launch: hipFuncSetAttribute failed\n"); grid = -1; return; }
        if (hipOccupancyMaxActiveBlocksPerMultiprocessor(&per_cu, (const void*)layer_fwd, NTHR, LDS_BYTES) != hipSuccess || per_cu < 1) { fprintf(stderr, "kernel_launch: occupancy query gave %d\n", per_cu); per_cu = 1; }
        (void)hipGetLastError();
        grid = cus * per_cu;
    }
    if (grid < 0) return;
    (void)hipMemsetAsync((char*)d_ws + WS_CTL, 0, CTL_ZERO_BYTES, stream);
    Args a{};
    a.x = (const float*)d_in[0]; a.pos = (const int*)d_in[1]; a.g1 = (const float*)d_in[2]; a.w1a = (const float*)d_in[3]; a.w3a = (const float*)d_in[4]; a.w2a = (const float*)d_in[5];
    a.gm = (const float*)d_in[6]; a.win = (const float*)d_in[7]; a.wa2 = (const float*)d_in[8]; a.ba = (const float*)d_in[9]; a.ggla = (const float*)d_in[10]; a.gatt = (const float*)d_in[11];
    a.wout = (const float*)d_in[12]; a.g2 = (const float*)d_in[13]; a.w1b = (const float*)d_in[14]; a.w3b = (const float*)d_in[15]; a.w2b = (const float*)d_in[16]; a.gf = (const float*)d_in[17];
    a.out = (float*)d_out; a.ws = (unsigned char*)d_ws;
    void* args[] = {&a};
    const hipError_t e = hipLaunchCooperativeKernel((const void*)layer_fwd, dim3(grid), dim3(NTHR), args, LDS_BYTES, stream);
    if (e != hipSuccess) fprintf(stderr, "kernel_launch: cooperative launch failed: %s (grid %d)\n", hipGetErrorString(e), grid);
}
```

```cpp
#include <hip/hip_runtime.h>
#include <hip/hip_cooperative_groups.h>
#include <cstdio>
#include <cstdint>
namespace cg = cooperative_groups;
namespace pg8 {
#define PG8_LAS __attribute__((address_space(3)))
typedef unsigned short bf16_t;
typedef short bf16x8 __attribute__((ext_vector_type(8)));
typedef float f32x4 __attribute__((ext_vector_type(4)));
typedef unsigned u32x4 __attribute__((ext_vector_type(4)));
constexpr int BM = 256, BK = 64, HALF = 128, HTB = HALF * BK * 2  , STAGE_BYTES = 8 * HTB, NXCD = 8, WGM = 8;

__host__ __device__ __forceinline__ int lds_byte(int r, int c) { const int st = (r >> 4) * 2 + (c >> 5), rr = r & 15, cc = c & 31, ob = rr * 64 + cc * 2; return st * 1024 + (ob ^ (((ob >> 9) & 1) << 5)); }
__host__ __device__ __forceinline__ void stage_rc(int b, int& R, int& C) { const int st = b / 1024, sb = b % 1024, swz = sb ^ (((sb >> 9) & 1) << 5); R = (st >> 1) * 16 + swz / 64; C = (st & 1) * 32 + (swz % 64) / 2; }
__host__ __device__ __forceinline__ int perm32(int rho) { const int n = rho >> 4, i = rho & 15; return 8 * (i >> 2) + 4 * n + (i & 3); }

struct Unit { int pm, pn; };
struct Gemm { const bf16_t* A; const bf16_t* Bt; int M, N, K; };

struct StaticOrder {
    int nM, nN, nwg, G, c;
    __host__ __device__ void init(int M, int N, int G_, int c_) { nM = M / BM; nN = N / BM; nwg = nM * nN; G = G_; c = c_; }
    __host__ __device__ bool next(int i, Unit& u) const {
        const long L = (long)i * G + c; if (L >= nwg) return false;
        int wgid = (int)L; { const int q = nwg / NXCD, r = nwg % NXCD, xcd = wgid % NXCD, off = wgid / NXCD; wgid = (xcd < r ? xcd * (q + 1) : r * (q + 1) + (xcd - r) * q) + off; }
        const int nig = WGM * nN, gid = wgid / nig, fm = gid * WGM, gsz = (nM - fm) < WGM ? (nM - fm) : WGM;
        u.pm = fm + ((wgid % nig) % gsz); u.pn = (wgid % nig) / gsz; return true;
    }
    __device__ __forceinline__ void a_ready(const Unit&) const {}
    __device__ __forceinline__ void done(const Unit&) const {}
};

__device__ __forceinline__ unsigned cvt_pk_bf16(float lo, float hi) { unsigned r; asm volatile("v_cvt_pk_bf16_f32 %0, %1, %2" : "=v"(r) : "v"(lo), "v"(hi)); return r; }
__device__ __forceinline__ float sum_x16(float x) { auto r = __builtin_amdgcn_permlane16_swap(__float_as_uint(x), __float_as_uint(x), false, false); return __uint_as_float(r[0]) + __uint_as_float(r[1]); }
__device__ __forceinline__ float sum_x32(float x) { auto r = __builtin_amdgcn_permlane32_swap(__float_as_uint(x), __float_as_uint(x), false, false); return __uint_as_float(r[0]) + __uint_as_float(r[1]); }
__device__ __forceinline__ float max_x16(float x) { auto r = __builtin_amdgcn_permlane16_swap(__float_as_uint(x), __float_as_uint(x), false, false); return fmaxf(__uint_as_float(r[0]), __uint_as_float(r[1])); }
__device__ __forceinline__ float max_x32(float x) { auto r = __builtin_amdgcn_permlane32_swap(__float_as_uint(x), __float_as_uint(x), false, false); return fmaxf(__uint_as_float(r[0]), __uint_as_float(r[1])); }
typedef unsigned u32x2w __attribute__((ext_vector_type(2)));
__device__ __forceinline__ u32x4 widen_pair(u32x2w A, u32x2w B, bool odd) {
    auto rx = __builtin_amdgcn_permlane16_swap(A.x, B.x, false, false); auto ry = __builtin_amdgcn_permlane16_swap(A.y, B.y, false, false);
    u32x4 o; if (odd) { o.x = rx[0]; o.y = ry[0]; o.z = B.x; o.w = B.y; } else { o.x = A.x; o.y = A.y; o.z = rx[1]; o.w = ry[1]; }
    return o;
}
__device__ __forceinline__ float get_x16(float x, bool odd) { auto r = __builtin_amdgcn_permlane16_swap(__float_as_uint(x), __float_as_uint(x), false, false); return __uint_as_float(odd ? r[0] : r[1]); }
constexpr float RMS_EPS = 1e-6f;
__device__ __forceinline__ float silu_f(float x) { return x * __builtin_amdgcn_rcpf(1.0f + __expf(-x)); }
struct EpiSwiglu {
    static constexpr bool PERM = true, AFTER_DRAIN = false;
    bf16_t* O; int ldc; const float* ss;
    __device__ __forceinline__ void operator()(const f32x4 (&acc)[2][2][4][2], const Unit& u, int wr, int wc, int fr, int fq) const {
        const int row0 = u.pm * BM + wr * 64 + fr, col0 = u.pn * HALF + wc * 32 + 8 * fq;
        float ssv[2][4];
#pragma unroll
        for (int ai = 0; ai < 2; ++ai)
#pragma unroll
            for (int m = 0; m < 4; ++m) ssv[ai][m] = ss[row0 + ai * HALF + m * 16];
#pragma unroll
        for (int ai = 0; ai < 2; ++ai)
#pragma unroll
            for (int m = 0; m < 4; ++m) {
                const int row = row0 + ai * HALF + m * 16;
                const float rs = __builtin_amdgcn_rsqf(ssv[ai][m] * (1.0f / 1024.0f) + RMS_EPS);
                const f32x4 a0 = acc[ai][0][m][0] * rs, a1 = acc[ai][0][m][1] * rs, b0 = acc[ai][1][m][0] * rs, b1 = acc[ai][1][m][1] * rs;
                u32x4 w;
                w.x = cvt_pk_bf16(silu_f(a0[0]) * b0[0], silu_f(a0[1]) * b0[1]); w.y = cvt_pk_bf16(silu_f(a0[2]) * b0[2], silu_f(a0[3]) * b0[3]);
                w.z = cvt_pk_bf16(silu_f(a1[0]) * b1[0], silu_f(a1[1]) * b1[1]); w.w = cvt_pk_bf16(silu_f(a1[2]) * b1[2], silu_f(a1[3]) * b1[3]);
                *(u32x4*)(O + (size_t)row * ldc + col0) = w;
            }
    }
};
struct EpiProj {
    static constexpr bool PERM = true, AFTER_DRAIN = false;
    bf16_t* PG; bf16_t* PA; const float* ss; const float* cs;
    __device__ __forceinline__ void operator()(const f32x4 (&acc)[2][2][4][2], const Unit& u, int wr, int wc, int fr, int fq) const {
        const int row0 = u.pm * BM + wr * 64 + fr;
        bf16_t* base; int ldc;
        if (u.pn < 6) { base = PG + u.pn * BM; ldc = 1792; } else { base = PA + (u.pn - 6) * BM; ldc = 1536; }
        base += wc * 32 + 8 * fq;
        const bool rot = (u.pn >= 6) && (u.pn < 10) && ((wc & 1) == 0);
        const float qs = (u.pn == 6 || u.pn == 7) ? 0.125f * 1.4426950408889634f : 1.0f;
        float ssv[2][4];
#pragma unroll
        for (int ai = 0; ai < 2; ++ai)
#pragma unroll
            for (int m = 0; m < 4; ++m) ssv[ai][m] = ss[row0 + ai * HALF + m * 16];
#pragma unroll
        for (int ai = 0; ai < 2; ++ai)
#pragma unroll
            for (int m = 0; m < 4; ++m) {
                const int row = row0 + ai * HALF + m * 16;
                const float rs = __builtin_amdgcn_rsqf(ssv[ai][m] * (1.0f / 1024.0f) + RMS_EPS);
                f32x4 c0 = {1.f, 1.f, 1.f, 1.f}, c1 = c0, s0 = {0.f, 0.f, 0.f, 0.f}, s1 = s0;
                if (rot && fq < 2) { const float* cr = cs + (size_t)row * 16; c0 = *(const f32x4*)cr; c1 = *(const f32x4*)(cr + 4); s0 = *(const f32x4*)(cr + 8); s1 = *(const f32x4*)(cr + 12);
                    if (fq == 0) { s0 = -s0; s1 = -s1; } }
#pragma unroll
                for (int bj = 0; bj < 2; ++bj) {
                    f32x4 v0 = acc[ai][bj][m][0] * rs, v1 = acc[ai][bj][m][1] * rs;
                    if (rot) {
                        f32x4 p0, p1;
#pragma unroll
                        for (int j = 0; j < 4; ++j) { p0[j] = get_x16(v0[j], fq & 1); p1[j] = get_x16(v1[j], fq & 1); }
                        v0 = v0 * c0 + p0 * s0; v1 = v1 * c1 + p1 * s1;
                    }
                    v0 = v0 * qs; v1 = v1 * qs;
                    u32x4 w; w.x = cvt_pk_bf16(v0[0], v0[1]); w.y = cvt_pk_bf16(v0[2], v0[3]); w.z = cvt_pk_bf16(v1[0], v1[1]); w.w = cvt_pk_bf16(v1[2], v1[3]);
                    *(u32x4*)(base + (size_t)row * ldc + bj * HALF) = w;
                }
            }
    }
};
struct EpiResidF {
    static constexpr bool PERM = true, AFTER_DRAIN = false;
    const bf16_t* base; float* out; float alpha; int ldc;
    __device__ __forceinline__ void operator()(const f32x4 (&acc)[2][2][4][2], const Unit& u, int wr, int wc, int fr, int fq) const {
        const int row0 = u.pm * BM + wr * 64 + fr, col0 = u.pn * BM + wc * 32 + 8 * fq;
#pragma unroll
        for (int ai = 0; ai < 2; ++ai)
#pragma unroll
            for (int m = 0; m < 4; ++m) {
                const size_t off = (size_t)(row0 + ai * HALF + m * 16) * ldc + col0;
#pragma unroll
                for (int bj = 0; bj < 2; ++bj) {
                    const u32x4 w = *(const u32x4*)(base + off + bj * HALF);
                    const f32x4 r0 = {__uint_as_float(w.x << 16), __uint_as_float(w.x & 0xffff0000u), __uint_as_float(w.y << 16), __uint_as_float(w.y & 0xffff0000u)};
                    const f32x4 r1 = {__uint_as_float(w.z << 16), __uint_as_float(w.z & 0xffff0000u), __uint_as_float(w.w << 16), __uint_as_float(w.w & 0xffff0000u)};
                    *(f32x4*)(out + off + bj * HALF) = r0 + acc[ai][bj][m][0] * alpha; *(f32x4*)(out + off + bj * HALF + 4) = r1 + acc[ai][bj][m][1] * alpha;
                }
            }
    }
};
__device__ __forceinline__ void unpack8(const u32x4 w, f32x4& a, f32x4& b) {
    a = (f32x4){__uint_as_float(w.x << 16), __uint_as_float(w.x & 0xffff0000u), __uint_as_float(w.y << 16), __uint_as_float(w.y & 0xffff0000u)};
    b = (f32x4){__uint_as_float(w.z << 16), __uint_as_float(w.z & 0xffff0000u), __uint_as_float(w.w << 16), __uint_as_float(w.w & 0xffff0000u)};
}
template <bool BASE_BF16> struct EpiResidB {
    static constexpr bool PERM = true, AFTER_DRAIN = false;
    const void* base; bf16_t* xn; float* ss; float alpha; int ldc;
    __device__ __forceinline__ void operator()(const f32x4 (&acc)[2][2][4][2], const Unit& u, int wr, int wc, int fr, int fq) const {
        const int row0 = u.pm * BM + wr * 64 + fr, col0 = u.pn * BM + wc * 32 + 8 * fq;
        if constexpr (BASE_BF16) {
            u32x4 rb[2][4][2];
#pragma unroll
            for (int ai = 0; ai < 2; ++ai)
#pragma unroll
                for (int m = 0; m < 4; ++m)
#pragma unroll
                    for (int bj = 0; bj < 2; ++bj) rb[ai][m][bj] = *(const u32x4*)((const bf16_t*)base + (size_t)(row0 + ai * HALF + m * 16) * ldc + col0 + bj * HALF);
#pragma unroll
            for (int ai = 0; ai < 2; ++ai)
#pragma unroll
                for (int m = 0; m < 4; ++m) {
                    const int row = row0 + ai * HALF + m * 16; const size_t off = (size_t)row * ldc + col0; float s = 0.f;
#pragma unroll
                    for (int bj = 0; bj < 2; ++bj) {
                        f32x4 r0, r1; unpack8(rb[ai][m][bj], r0, r1);
                        const f32x4 o0 = r0 + acc[ai][bj][m][0] * alpha, o1 = r1 + acc[ai][bj][m][1] * alpha;
                        u32x4 w; w.x = cvt_pk_bf16(o0[0], o0[1]); w.y = cvt_pk_bf16(o0[2], o0[3]); w.z = cvt_pk_bf16(o1[0], o1[1]); w.w = cvt_pk_bf16(o1[2], o1[3]);
                        *(u32x4*)(xn + off + bj * HALF) = w;
                        s += (o0[0] * o0[0] + o0[1] * o0[1]) + (o0[2] * o0[2] + o0[3] * o0[3]) + (o1[0] * o1[0] + o1[1] * o1[1]) + (o1[2] * o1[2] + o1[3] * o1[3]);
                    }
                    s = sum_x32(sum_x16(s)); if (fq == 0) atomicAdd(ss + row, s);
                }
        } else {
#pragma unroll
            for (int ai = 0; ai < 2; ++ai) {
                f32x4 rf[4][2][2];
#pragma unroll
                for (int m = 0; m < 4; ++m)
#pragma unroll
                    for (int bj = 0; bj < 2; ++bj) { const float* bp = (const float*)base + (size_t)(row0 + ai * HALF + m * 16) * ldc + col0 + bj * HALF; rf[m][bj][0] = *(const f32x4*)bp; rf[m][bj][1] = *(const f32x4*)(bp + 4); }
#pragma unroll
                for (int m = 0; m < 4; ++m) {
                    const int row = row0 + ai * HALF + m * 16; const size_t off = (size_t)row * ldc + col0; float s = 0.f;
#pragma unroll
                    for (int bj = 0; bj < 2; ++bj) {
                        const f32x4 o0 = rf[m][bj][0] + acc[ai][bj][m][0] * alpha, o1 = rf[m][bj][1] + acc[ai][bj][m][1] * alpha;
                        u32x4 w; w.x = cvt_pk_bf16(o0[0], o0[1]); w.y = cvt_pk_bf16(o0[2], o0[3]); w.z = cvt_pk_bf16(o1[0], o1[1]); w.w = cvt_pk_bf16(o1[2], o1[3]);
                        *(u32x4*)(xn + off + bj * HALF) = w;
                        s += (o0[0] * o0[0] + o0[1] * o0[1]) + (o0[2] * o0[2] + o0[3] * o0[3]) + (o1[0] * o1[0] + o1[1] * o1[1]) + (o1[2] * o1[2] + o1[3] * o1[3]);
                    }
                    s = sum_x32(sum_x16(s)); if (fq == 0) atomicAdd(ss + row, s);
                }
            }
        }
    }
};
struct EpiFinal {
    static constexpr bool PERM = true, AFTER_DRAIN = false;
    const bf16_t* base; float* out; float* ss; unsigned* cnt; const float* gf; float alpha; int ldc; unsigned want;
    __device__ __forceinline__ void operator()(f32x4 (&acc)[2][2][4][2], const Unit& u, int wr, int wc, int fr, int fq) const {
        const int row0 = u.pm * BM + wr * 64 + fr, col0 = u.pn * BM + wc * 32 + 8 * fq;
        u32x4 rb[2][4][2];
#pragma unroll
        for (int ai = 0; ai < 2; ++ai)
#pragma unroll
            for (int m = 0; m < 4; ++m)
#pragma unroll
                for (int bj = 0; bj < 2; ++bj) rb[ai][m][bj] = *(const u32x4*)(base + (size_t)(row0 + ai * HALF + m * 16) * ldc + col0 + bj * HALF);
#pragma unroll
        for (int ai = 0; ai < 2; ++ai)
#pragma unroll
            for (int m = 0; m < 4; ++m) {
                const int row = row0 + ai * HALF + m * 16; const size_t off = (size_t)row * ldc + col0; float s = 0.f;
#pragma unroll
                for (int bj = 0; bj < 2; ++bj) {
                    f32x4 r0, r1; unpack8(rb[ai][m][bj], r0, r1);
                    const f32x4 o0 = r0 + acc[ai][bj][m][0] * alpha, o1 = r1 + acc[ai][bj][m][1] * alpha;
                    acc[ai][bj][m][0] = o0; acc[ai][bj][m][1] = o1;
                    s += (o0[0] * o0[0] + o0[1] * o0[1]) + (o0[2] * o0[2] + o0[3] * o0[3]) + (o1[0] * o1[0] + o1[1] * o1[1]) + (o1[2] * o1[2] + o1[3] * o1[3]);
                }
                s = sum_x32(sum_x16(s));
                if (fq == 0) { const float old = __hip_atomic_fetch_add(ss + row, s, __ATOMIC_RELAXED, __HIP_MEMORY_SCOPE_AGENT); asm volatile("" :: "v"(old)); }
            }
        asm volatile("s_waitcnt vmcnt(0)" ::: "memory");
        unsigned* pc = cnt + 64 * u.pm;
        if ((threadIdx.x & 63) == 0) __hip_atomic_fetch_add(pc, 1u, __ATOMIC_RELAXED, __HIP_MEMORY_SCOPE_AGENT);
        { unsigned spins = 0; while ((unsigned)__builtin_amdgcn_readfirstlane(__hip_atomic_load(pc, __ATOMIC_RELAXED, __HIP_MEMORY_SCOPE_AGENT)) < want) { __builtin_amdgcn_s_sleep(2); if (++spins > (1u << 22)) break; } }
        asm volatile("" ::: "memory");
        const f32x4 g00 = *(const f32x4*)(gf + col0), g01 = *(const f32x4*)(gf + col0 + 4), g10 = *(const f32x4*)(gf + col0 + HALF), g11 = *(const f32x4*)(gf + col0 + HALF + 4);
#pragma unroll
        for (int ai = 0; ai < 2; ++ai)
#pragma unroll
            for (int m = 0; m < 4; ++m) {
                const int row = row0 + ai * HALF + m * 16; const size_t off = (size_t)row * ldc + col0;
                const float rs = __builtin_amdgcn_rsqf(__hip_atomic_load(ss + row, __ATOMIC_RELAXED, __HIP_MEMORY_SCOPE_AGENT) * (1.0f / 1024.0f) + RMS_EPS);
                *(f32x4*)(out + off) = acc[ai][0][m][0] * rs * g00; *(f32x4*)(out + off + 4) = acc[ai][0][m][1] * rs * g01;
                *(f32x4*)(out + off + HALF) = acc[ai][1][m][0] * rs * g10; *(f32x4*)(out + off + HALF + 4) = acc[ai][1][m][1] * rs * g11;
            }
    }
};
template <class Epi, class Sched, bool ALIGN_EPI = false, bool SP2 = false>
__device__ __forceinline__ void gemm_phase(PG8_LAS unsigned char* lds, const Gemm g, const Sched& S, const Epi& E) {
    int tid_ = threadIdx.x; asm volatile("" : "+v"(tid_));
    const int tid = tid_, wid = __builtin_amdgcn_readfirstlane(tid >> 6), lane = tid & 63, wr = wid >> 2, wc = wid & 3, fr = lane & 15, fq = lane >> 4;
    const int K = g.K, nt = K / BK;
    unsigned voffA[2], voffB[2];
#pragma unroll
    for (int i = 0; i < 2; ++i) { int R, C; stage_rc(tid * 16 + i * 8192, R, C); const int Rb = Epi::PERM ? ((R & ~31) + perm32(R & 31)) : R;
        voffA[i] = (unsigned)(R * K + C) * 2u; voffB[i] = (unsigned)(Rb * K + C) * 2u; }
    const size_t kstep = (size_t)(BK * 2);
    const size_t hstep = (size_t)HALF * K * 2;
    const size_t tstep = 2 * hstep;
    const unsigned ldsw = (unsigned)wid * 1024u;
    const int aoff = lds_byte(wr * 64 + fr, fq * 8), boff = lds_byte(wc * 32 + fr, fq * 8);
#define PG8_SA(b, h) (((b) * 2 + (h)) * HTB)
#define PG8_SB(b, h) ((4 + (b) * 2 + (h)) * HTB)
#define PG8_STAGE(bufoff, gbase, voff) do { _Pragma("unroll") for (int _i = 0; _i < 2; ++_i) \
        __builtin_amdgcn_global_load_lds((const unsigned*)((const char*)(gbase) + (voff)[_i]), (PG8_LAS unsigned*)(lds + (bufoff) + ldsw + _i * 8192), 16, 0, 0); } while (0)
#define PG8_LDA(dst, b, h) do { _Pragma("unroll") for (int m = 0; m < 4; ++m) _Pragma("unroll") for (int k = 0; k < 2; ++k) dst[m][k] = *(const PG8_LAS bf16x8*)(lds + PG8_SA(b, h) + aoff + m * 2048 + k * 1024); } while (0)
#define PG8_LDB(dst, b, h) do { _Pragma("unroll") for (int n = 0; n < 2; ++n) _Pragma("unroll") for (int k = 0; k < 2; ++k) dst[n][k] = *(const PG8_LAS bf16x8*)(lds + PG8_SB(b, h) + boff + n * 2048 + k * 1024); } while (0)
#define PG8_MMA(ai, bj, At, Bt) do { __builtin_amdgcn_s_setprio(1); _Pragma("unroll") for (int m = 0; m < 4; ++m) _Pragma("unroll") for (int n = 0; n < 2; ++n) _Pragma("unroll") for (int k = 0; k < 2; ++k) \
        acc[ai][bj][m][n] = __builtin_amdgcn_mfma_f32_16x16x32_bf16(Bt[n][k], At[m][k], acc[ai][bj][m][n], 0, 0, 0); __builtin_amdgcn_s_setprio(0); } while (0)
#define PG8_WAIT_V(n) asm volatile("s_waitcnt vmcnt(" #n ")" ::: "memory")
#define PG8_WAIT_L(n) asm volatile("s_waitcnt lgkmcnt(" #n ")" ::: "memory")
#define PG8_BAR __builtin_amdgcn_s_barrier()
#define PG8_SCHED __builtin_amdgcn_sched_barrier(0)
    Unit cur, nxt; int ui = 0;
    if (!S.next(0, cur)) return;
    f32x4 acc[2][2][4][2];
#pragma unroll
    for (int a = 0; a < 2; ++a)
#pragma unroll
        for (int b = 0; b < 2; ++b)
#pragma unroll
            for (int m = 0; m < 4; ++m)
#pragma unroll
                for (int n = 0; n < 2; ++n) acc[a][b][m][n] = (f32x4){0.f, 0.f, 0.f, 0.f};
    bf16x8 At[4][2], B0[2][2], B1[2][2];
    const char* cA = (const char*)g.A + (size_t)cur.pm * tstep; const char* cB = (const char*)g.Bt + (size_t)cur.pn * tstep;
    S.a_ready(cur);
    if constexpr (SP2) {
        PG8_STAGE(PG8_SB(0, 0), cB, voffB); PG8_STAGE(PG8_SB(0, 1), cB + hstep, voffB); PG8_STAGE(PG8_SA(0, 0), cA, voffA); PG8_STAGE(PG8_SA(0, 1), cA + hstep, voffA);
        if (wr == 1) PG8_BAR;
        PG8_WAIT_V(2); PG8_BAR;
        PG8_STAGE(PG8_SB(1, 0), cB + kstep, voffB); PG8_STAGE(PG8_SA(1, 0), cA + kstep, voffA); PG8_STAGE(PG8_SB(1, 1), cB + hstep + kstep, voffB);
        PG8_WAIT_V(6); PG8_BAR;
    } else {
        PG8_STAGE(PG8_SB(0, 0), cB, voffB); PG8_STAGE(PG8_SA(0, 0), cA, voffA); PG8_STAGE(PG8_SB(0, 1), cB + hstep, voffB); PG8_STAGE(PG8_SA(0, 1), cA + hstep, voffA);
        if (wr == 1) PG8_BAR;
        PG8_WAIT_V(4); PG8_BAR;
        PG8_STAGE(PG8_SB(1, 0), cB + kstep, voffB); PG8_STAGE(PG8_SA(1, 0), cA + kstep, voffA); PG8_STAGE(PG8_SB(1, 1), cB + hstep + kstep, voffB);
        PG8_WAIT_V(6); PG8_BAR;
    }
    for (;;) {
        const bool has_next = S.next(ui + 1, nxt);
        const char* nA = has_next ? (const char*)g.A + (size_t)nxt.pm * tstep : cA; const char* nB = has_next ? (const char*)g.Bt + (size_t)nxt.pn * tstep : cB;
        for (int t = 0; t < nt; t += 2) {
            const bool last = (t == nt - 2);
            const char* a1 = cA + (size_t)(t + 1) * kstep;
            const char* a2 = last ? nA : cA + (size_t)(t + 2) * kstep; const char* b2 = last ? nB : cB + (size_t)(t + 2) * kstep;
            const char* a3 = a2 + kstep; const char* b3 = b2 + kstep;
            if (last && has_next) S.a_ready(nxt);
            if constexpr (SP2) {
            PG8_LDB(B0, 0, 0); PG8_LDB(B1, 0, 1); PG8_SCHED; PG8_LDA(At, 0, 0); PG8_STAGE(PG8_SA(1, 1), a1 + hstep, voffA);
            PG8_WAIT_V(8); PG8_WAIT_L(0); PG8_BAR; PG8_MMA(0, 0, At, B0); PG8_MMA(0, 1, At, B1); PG8_BAR; PG8_SCHED;
            PG8_LDA(At, 0, 1); PG8_STAGE(PG8_SB(0, 0), b2, voffB); PG8_STAGE(PG8_SB(0, 1), b2 + hstep, voffB); PG8_STAGE(PG8_SA(0, 0), a2, voffA);
            PG8_WAIT_V(8); PG8_WAIT_L(0); PG8_BAR; PG8_MMA(1, 0, At, B0); PG8_MMA(1, 1, At, B1); PG8_BAR; PG8_SCHED;
            PG8_LDB(B0, 1, 0); PG8_LDB(B1, 1, 1); PG8_SCHED; PG8_LDA(At, 1, 0); PG8_STAGE(PG8_SA(0, 1), a2 + hstep, voffA);
            PG8_WAIT_V(8); PG8_WAIT_L(0); PG8_BAR; PG8_MMA(0, 0, At, B0); PG8_MMA(0, 1, At, B1); PG8_BAR; PG8_SCHED;
            PG8_LDA(At, 1, 1); PG8_STAGE(PG8_SB(1, 0), b3, voffB); PG8_STAGE(PG8_SB(1, 1), b3 + hstep, voffB); PG8_STAGE(PG8_SA(1, 0), a3, voffA);
            PG8_WAIT_V(8); PG8_WAIT_L(0); PG8_BAR; PG8_MMA(1, 0, At, B0); PG8_MMA(1, 1, At, B1); PG8_BAR; PG8_SCHED;
            } else {
            PG8_LDB(B0, 0, 0); PG8_SCHED; PG8_LDA(At, 0, 0); PG8_STAGE(PG8_SA(1, 1), a1 + hstep, voffA);
            PG8_WAIT_L(8); PG8_BAR; PG8_WAIT_L(0); PG8_MMA(0, 0, At, B0); PG8_BAR; PG8_SCHED;
            PG8_LDB(B1, 0, 1); PG8_STAGE(PG8_SB(0, 0), b2, voffB);
            PG8_BAR; PG8_WAIT_L(0); PG8_MMA(0, 1, At, B1); PG8_BAR;
            PG8_LDA(At, 0, 1); PG8_STAGE(PG8_SA(0, 0), a2, voffA);
            PG8_BAR; PG8_WAIT_L(0); PG8_MMA(1, 0, At, B0); PG8_BAR; PG8_SCHED;
            PG8_STAGE(PG8_SB(0, 1), b2 + hstep, voffB);
            PG8_WAIT_V(6); PG8_BAR; PG8_MMA(1, 1, At, B1); PG8_BAR;
            PG8_LDB(B0, 1, 0); PG8_SCHED; PG8_LDA(At, 1, 0); PG8_STAGE(PG8_SA(0, 1), a2 + hstep, voffA);
            PG8_WAIT_L(8); PG8_BAR; PG8_WAIT_L(0); PG8_MMA(0, 0, At, B0); PG8_BAR; PG8_SCHED;
            PG8_LDB(B1, 1, 1); PG8_STAGE(PG8_SB(1, 0), b3, voffB);
            PG8_BAR; PG8_WAIT_L(0); PG8_MMA(0, 1, At, B1); PG8_BAR;
            PG8_LDA(At, 1, 1); PG8_STAGE(PG8_SA(1, 0), a3, voffA);
            PG8_BAR; PG8_WAIT_L(0); PG8_MMA(1, 0, At, B0); PG8_BAR; PG8_SCHED;
            PG8_STAGE(PG8_SB(1, 1), b3 + hstep, voffB);
            PG8_WAIT_V(6); PG8_BAR; PG8_MMA(1, 1, At, B1); PG8_BAR;
            }
        }
        if constexpr (ALIGN_EPI) { if (wr == 0) PG8_BAR; }
        if constexpr (!Epi::AFTER_DRAIN) { E(acc, cur, wr, wc, fr, fq); S.done(cur); }
        if (!has_next) break;
#pragma unroll
        for (int a = 0; a < 2; ++a)
#pragma unroll
            for (int b = 0; b < 2; ++b)
#pragma unroll
                for (int m = 0; m < 4; ++m)
#pragma unroll
                    for (int n = 0; n < 2; ++n) acc[a][b][m][n] = (f32x4){0.f, 0.f, 0.f, 0.f};
        cur = nxt; cA = nA; cB = nB; ++ui;
        if constexpr (ALIGN_EPI) { if (wr == 1) PG8_BAR; }
    }
    PG8_WAIT_V(0);
    if constexpr (!ALIGN_EPI) { if (wr == 0) PG8_BAR; }
    PG8_BAR;
    if constexpr (Epi::AFTER_DRAIN) { E.fused(acc, cur, wr, wc, fr, fq, lds, wid, lane); S.done(cur); }
#undef PG8_SA
#undef PG8_SB
#undef PG8_STAGE
#undef PG8_LDA
#undef PG8_LDB
#undef PG8_MMA
#undef PG8_WAIT_V
#undef PG8_WAIT_L
#undef PG8_BAR
#undef PG8_SCHED
}
}

#define LAS __attribute__((address_space(3)))
typedef unsigned short bf16;
typedef short bf16x8 __attribute__((ext_vector_type(8)));
typedef short s16x4 __attribute__((ext_vector_type(4)));
typedef float f32x4 __attribute__((ext_vector_type(4)));
typedef float f32x2 __attribute__((ext_vector_type(2)));
typedef unsigned u32x4 __attribute__((ext_vector_type(4)));
typedef unsigned u32x2 __attribute__((ext_vector_type(2)));
typedef __bf16 bf16x2_t __attribute__((ext_vector_type(2)));

#ifndef PROBE_PH
#define PROBE_PH -1
#endif
#define STAMP(k) do { if (PROBE_PH >= 0 && (k) == PROBE_PH) ts0 = __builtin_amdgcn_s_memrealtime(); if (PROBE_PH >= 0 && (k) == PROBE_PH + 1) ts1 = __builtin_amdgcn_s_memrealtime(); } while (0)
#ifndef REP_MIX
#define REP_MIX 1
#endif
#ifndef REP_MIXC
#define REP_MIXC 1
#endif
#ifndef REP_UP
#define REP_UP 1
#endif
#ifndef REP_DN
#define REP_DN 1
#endif
#ifndef REP_OUT
#define REP_OUT 1
#endif
#ifndef REP_SYNC
#define REP_SYNC 1
#endif
#ifndef REP_P0
#define REP_P0 1
#endif
#ifndef REP_IN
#define REP_IN 1
#endif
#define GSYNC() do { for (int _r = 0; _r < REP_SYNC; ++_r) xcd_barrier(bar); } while (0)
constexpr int NWAVES = 8, NTHR = 512;
constexpr int SEQ = 8192, M = 16384, D = 1024, FF = 2816, NUP = 2 * FF  , NIN = 3072, DIN_SRC = 3088;
constexpr int LDG = 1792, LDA = 1536;
constexpr float EPS = 1e-6f;

constexpr size_t MiB = 1u << 20;
constexpr size_t WS_CTL = 0, CTL_ZERO_BYTES = 1 * MiB;
constexpr size_t WS_SS1 = 64 * 1024, WS_SS2 = 128 * 1024, WS_SS3 = 192 * 1024, WS_BAR = 256 * 1024, WS_PCNT = 512 * 1024;
constexpr size_t WS_SS0 = 1 * MiB;
constexpr size_t WS_CS = 1 * MiB + 256 * 1024;
constexpr size_t WS_DEC = 2 * MiB + 512 * 1024;
constexpr size_t WS_LSE = 3 * MiB;
constexpr size_t WS_WGA = 4 * MiB + 512 * 1024;
constexpr size_t WS_GA = 232 * MiB;
constexpr size_t WS_W13A = 5 * MiB, WS_W2A = 16 * MiB, WS_WIN = 22 * MiB, WS_WOUT = 29 * MiB, WS_W13B = 31 * MiB, WS_W2B = 42 * MiB;
constexpr size_t WS_ST = 5 * MiB;
constexpr size_t WS_XN = 48 * MiB;
constexpr size_t WS_UT = 48 * MiB;
constexpr size_t WS_PG = 80 * MiB;
constexpr size_t WS_PA = 136 * MiB;
constexpr size_t WS_OM = 136 * MiB;
constexpr size_t WS_OB = 184 * MiB;
constexpr size_t WS_H = 80 * MiB;
constexpr size_t WS_END = 233 * MiB;
static_assert(WS_W13A + (size_t)NUP * D * 2 <= WS_W2A && WS_W2A + (size_t)D * FF * 2 <= WS_WIN && WS_WIN + (size_t)NIN * D * 2 <= WS_WOUT && WS_WOUT + (size_t)D * D * 2 <= WS_W13B &&
              WS_W13B + (size_t)NUP * D * 2 <= WS_W2B && WS_W2B + (size_t)D * FF * 2 <= WS_XN && WS_ST + 16 * MiB <= WS_WIN && WS_PG + (size_t)M * LDG * 2 <= WS_PA &&
              WS_PA + (size_t)M * LDA * 2 <= WS_OB && WS_H + (size_t)M * FF * 2 <= WS_OB && WS_OB + (size_t)3 * M * 512 * 2 <= WS_END, "d_ws map");

constexpr int RING_BYTES = 131072, LDS_BYTES = 147456, MISC_OFF = RING_BYTES;

__device__ __forceinline__ float bf2f(unsigned short v) { return __uint_as_float(((unsigned)v) << 16); }
__device__ __forceinline__ unsigned pk2(float lo, float hi) { f32x2 v = {lo, hi}; bf16x2_t b = __builtin_convertvector(v, bf16x2_t); return __builtin_bit_cast(unsigned, b); }
__device__ __forceinline__ unsigned short f2bf(float x) { return (unsigned short)(pk2(x, 0.f) & 0xffffu); }
__device__ __forceinline__ float wave_sum(float v) {
#pragma unroll
    for (int o = 1; o < 64; o <<= 1) v += __shfl_xor(v, o);
    return v;
}
#define MFMA16(a, b, c) __builtin_amdgcn_mfma_f32_16x16x32_bf16((a), (b), (c), 0, 0, 0)

struct Args {
    const float* x; const int* pos; const float* g1; const float* w1a; const float* w3a; const float* w2a; const float* gm; const float* win; const float* wa2; const float* ba;
    const float* ggla; const float* gatt; const float* wout; const float* g2; const float* w1b; const float* w3b; const float* w2b; const float* gf;
    float* out; unsigned char* ws; int use_cg_sync; int pad;
};

__device__ __forceinline__ void tr_item(const float* W, int ldw, int col0, int k0, const float* gain, bf16* WT, int K, int drow0, LAS float* scr, int lane) {
    const float* src = W + (size_t)(k0 + (lane >> 5)) * ldw + col0 + (lane & 31);
    float v[32];
#pragma unroll
    for (int i = 0; i < 32; ++i) v[i] = __builtin_nontemporal_load(src + (size_t)(2 * i) * ldw);
    const int c = lane & 7;
    f32x4 g0 = {1.f, 1.f, 1.f, 1.f}, g1 = g0;
    if (gain) { g0 = *(const f32x4*)(gain + k0 + 8 * c); g1 = *(const f32x4*)(gain + k0 + 8 * c + 4); }
#pragma unroll
    for (int i = 0; i < 32; ++i) scr[(2 * i + (lane >> 5)) * 33 + (lane & 31)] = v[i];
    asm volatile("s_waitcnt lgkmcnt(0)" ::: "memory");
#pragma unroll
    for (int j = 0; j < 4; ++j) { const int n = (lane >> 3) + 8 * j; const LAS float* s = scr + (8 * c) * 33 + n;
        u32x4 o; o.x = pk2(s[0 * 33] * g0[0], s[1 * 33] * g0[1]); o.y = pk2(s[2 * 33] * g0[2], s[3 * 33] * g0[3]); o.z = pk2(s[4 * 33] * g1[0], s[5 * 33] * g1[1]); o.w = pk2(s[6 * 33] * g1[2], s[7 * 33] * g1[3]);
        *(u32x4*)(WT + (size_t)(drow0 + n) * K + k0 + 8 * c) = o; }
    asm volatile("s_waitcnt lgkmcnt(0)" ::: "memory");
}
__device__ __forceinline__ void up_item(const float* w1, const float* w3, const float* g, bf16* WT, int r, LAS float* scr, int lane) {
    const int which = r / 1408, rr = r % 1408, kb = rr / 88, nb = rr % 88;
    tr_item(which ? w3 : w1, FF, 32 * nb, 64 * kb, g, WT, D, 256 * (nb >> 2) + 32 * (nb & 3) + 128 * which, scr, lane);
}
__device__ __forceinline__ void conv_items(const Args& a, LAS unsigned char* lds, int lo, int hi, int widx, int nw, int lane_in, int wave) {
    int lane = lane_in; asm volatile("" : "+v"(lane));
    unsigned char* ws = a.ws;
    LAS float* scr = (LAS float*)(lds + wave * 16384);
    bf16* W13A = (bf16*)(ws + WS_W13A); bf16* W2A = (bf16*)(ws + WS_W2A); bf16* WIN = (bf16*)(ws + WS_WIN); bf16* WOUT = (bf16*)(ws + WS_WOUT); bf16* W13B = (bf16*)(ws + WS_W13B); bf16* W2B = (bf16*)(ws + WS_W2B);
    constexpr int I_UP = 2816, I_DN = 1408, I_IN = 1536, I_OUT = 512;
    for (int it = lo + widx; it < hi; it += nw) {
        int r = it;
        if (r < I_UP) { up_item(a.w1a, a.w3a, a.g1, W13A, r, scr, lane); continue; } r -= I_UP;
        if (r < I_DN) { tr_item(a.w2a, D, 32 * (r % 32), 64 * (r / 32), nullptr, W2A, FF, 32 * (r % 32), scr, lane); continue; } r -= I_DN;
        if (r < I_IN) { const int kb = r / 96, nb = r % 96; tr_item(a.win, DIN_SRC, nb < 48 ? 32 * nb : 32 * nb + 16, 64 * kb, a.gm, WIN, D, 32 * nb, scr, lane); continue; } r -= I_IN;
        if (r < I_OUT) { tr_item(a.wout, D, 32 * (r % 32), 64 * (r / 32), nullptr, WOUT, D, 32 * (r % 32), scr, lane); continue; } r -= I_OUT;
        if (r < I_UP) { up_item(a.w1b, a.w3b, a.g2, W13B, r, scr, lane); continue; } r -= I_UP;
        tr_item(a.w2b, D, 32 * (r % 32), 64 * (r / 32), nullptr, W2B, FF, 32 * (r % 32), scr, lane);
    }
}
constexpr int IT_W13A = 0, IT_W2A = 2816, IT_W13B = 6272, IT_W2B = 9088, IT_END = 10496;
__device__ __forceinline__ void gate_cols(const Args& a, int tidx, int nthr) {
    bf16* WGA = (bf16*)(a.ws + WS_WGA);
    for (int item = tidx; item < 16 * 128; item += nthr) {
        const int r = item & 15, kc = item >> 4; float o[8];
#pragma unroll
        for (int i = 0; i < 8; ++i) { const int k = 8 * kc + i; o[i] = a.win[(size_t)k * DIN_SRC + 1536 + r] * a.gm[k]; }
        u32x4 w; w.x = pk2(o[0], o[1]); w.y = pk2(o[2], o[3]); w.z = pk2(o[4], o[5]); w.w = pk2(o[6], o[7]);
        *(u32x4*)(WGA + (size_t)r * D + 8 * kc) = w;
    }
}
__device__ __forceinline__ void ga_job(LAS unsigned char* L, const bf16* XN, const bf16* WGA, const float* ss, float* GA, int tid, int G) {
    const int lane = tid & 63, w = tid >> 6, c = lane & 15, quad = lane >> 4, mt = w & 3, kh = w >> 2;
    for (int rb = blockIdx.x; rb < M / 64; rb += G) {
        const bf16* ap = XN + (size_t)(rb * 64 + 16 * mt + c) * D + kh * 512 + 8 * quad; const bf16* bp = WGA + (size_t)c * D + kh * 512 + 8 * quad;
        f32x4 acc = {0.f, 0.f, 0.f, 0.f};
        {   bf16x8 af[16], bfr[16];
#pragma unroll
            for (int ks = 0; ks < 16; ++ks) { af[ks] = *(const bf16x8*)(ap + ks * 32); bfr[ks] = *(const bf16x8*)(bp + ks * 32); }
#pragma unroll
            for (int ks = 0; ks < 16; ++ks) acc = MFMA16(af[ks], bfr[ks], acc);
        }
        LAS float* P = (LAS float*)L;
#pragma unroll
        for (int i = 0; i < 4; ++i) P[(kh * 64 + 16 * mt + 4 * quad + i) * 16 + c] = acc[i];
        __syncthreads();
        { const int row = tid >> 3, r2 = (tid & 7) * 2; const float rs = __builtin_amdgcn_rsqf(ss[rb * 64 + row] * (1.0f / 1024.0f) + EPS);
          f32x2 o; o.x = (P[row * 16 + r2] + P[(64 + row) * 16 + r2]) * rs; o.y = (P[row * 16 + r2 + 1] + P[(64 + row) * 16 + r2 + 1]) * rs;
          *(f32x2*)(GA + (size_t)(rb * 64 + row) * 16 + r2) = o; }
        __syncthreads();
    }
}
__device__ __forceinline__ void light_wg(int nunits, int G, int& idx, int& nlight) { const int rem = nunits % G; nlight = rem ? G - rem : G; idx = rem ? (int)blockIdx.x - rem : (int)blockIdx.x; }
__device__ __forceinline__ void p0_xn(const Args& a, int lane, int wave) {
    unsigned char* ws = a.ws;
    const int gw = blockIdx.x * NWAVES + wave, NGW = gridDim.x * NWAVES;
    bf16* XN = (bf16*)(ws + WS_XN); float* SS0 = (float*)(ws + WS_SS0);
    for (int m0 = gw * 8; m0 < M; m0 += NGW * 8) {
        f32x4 v[8][4];
#pragma unroll
        for (int r = 0; r < 8; ++r) { const f32x4* xr = (const f32x4*)(a.x + (size_t)(m0 + r) * D) + lane;
#pragma unroll
            for (int j = 0; j < 4; ++j) v[r][j] = __builtin_nontemporal_load(xr + 64 * j); }
#pragma unroll
        for (int r = 0; r < 8; ++r) { unsigned long long* o8 = (unsigned long long*)(XN + (size_t)(m0 + r) * D) + lane; float s = 0.f;
#pragma unroll
            for (int j = 0; j < 4; ++j) { const f32x4 x4 = v[r][j]; s += (x4[0] * x4[0] + x4[1] * x4[1]) + (x4[2] * x4[2] + x4[3] * x4[3]);
                o8[64 * j] = (unsigned long long)pk2(x4[0], x4[1]) | ((unsigned long long)pk2(x4[2], x4[3]) << 32); }
            s = wave_sum(s); if (lane == 0) SS0[m0 + r] = s; }
    }
}
__device__ __forceinline__ void p0_cs(const Args& a, int tidx, int nthr) {
    unsigned char* ws = a.ws;
    float* CS = (float*)(ws + WS_CS);
    for (int e = tidx; e < M * 8; e += nthr) {
        const int tok = e >> 3, i = e & 7;
        const float inv = i == 0 ? 1.0f : i == 1 ? 0.1939227432012558f : i == 2 ? 0.03760603070259094f : i == 3 ? 0.007292664609849453f : i == 4 ? 0.0014142135623842478f : i == 5 ? 0.00027424818836152554f : i == 6 ? 5.318296098266728e-05f : 1.0313386155758053e-05f;
        const float ang = (float)a.pos[tok] * inv;
        const double ad = (double)ang, kq = __builtin_rint(ad * 0.15915494309189535), rd = ad - kq * 6.283185307179586;
        const float rr = (float)rd;
        CS[tok * 16 + i] = cosf(rr); CS[tok * 16 + 8 + i] = sinf(rr);
    }
}

constexpr int AT_KS = 0, AT_VS = 384 * 144, AT_BYTES = 2 * 384 * 144;
static_assert(AT_BYTES <= RING_BYTES, "attention LDS");
typedef short v4i16_t __attribute__((ext_vector_type(4)));
__device__ __forceinline__ s16x4 tr16(const LAS unsigned char* p) { return __builtin_amdgcn_ds_read_tr16_b64_v4i16((LAS v4i16_t*)p); }
struct AttnRegs { u32x4 k[6], v[6]; bf16x8 q[2][2]; };
struct AttnCoord { int br, dl, tokb, h, n2; };
__device__ __forceinline__ AttnCoord attn_coord(int U) {
    AttnCoord c; c.br = U >> 9; const int rem = U & 511, b = rem >> 8, idx = rem & 31; c.h = (rem >> 5) & 7; c.dl = 2 * c.br; const int pl = 5 - c.dl;
    c.tokb = b * SEQ + (idx >> pl); c.n2 = idx & ((1 << pl) - 1); return c;
}
__device__ __forceinline__ void attn_load(AttnRegs& R, int U, const bf16* PA, int tid) {
    const AttnCoord c = attn_coord(U); const int ch = tid & 7, r0 = tid >> 3, jq0 = 256 * c.n2, jk0 = jq0 - 128;
    const int lane = tid & 63, w = tid >> 6, cc = lane & 15, quad = lane >> 4;
#pragma unroll
    for (int p = 0; p < 6; ++p) { const int j = jk0 + r0 + 64 * p; const bool valid = j >= 0; const int tok = c.tokb + ((valid ? j : 0) << c.dl);
        const bf16* src = PA + (size_t)tok * LDA + 512 + c.h * 64 + ch * 8;
        R.k[p] = (u32x4){0u, 0u, 0u, 0u}; R.v[p] = (u32x4){0u, 0u, 0u, 0u};
        if (valid) { R.k[p] = *(const u32x4*)src; R.v[p] = *(const u32x4*)(src + 512); } }
#pragma unroll
    for (int qa = 0; qa < 2; ++qa) { const int tok = c.tokb + ((jq0 + 32 * w + 16 * qa + cc) << c.dl);
#pragma unroll
        for (int ks = 0; ks < 2; ++ks) R.q[qa][ks] = *(const bf16x8*)(PA + (size_t)tok * LDA + c.h * 64 + ks * 32 + quad * 8); }
}
__device__ __forceinline__ void attn_store(const AttnRegs& R, LAS unsigned char* L, int tid) {
    const int ch = tid & 7, r0 = tid >> 3;
#pragma unroll
    for (int p = 0; p < 6; ++p) { *(LAS u32x4*)(L + AT_KS + (r0 + 64 * p) * 144 + ch * 16) = R.k[p]; *(LAS u32x4*)(L + AT_VS + (r0 + 64 * p) * 144 + ch * 16) = R.v[p]; }
}
__device__ __forceinline__ void attn_compute(LAS unsigned char* L, int U, const bf16x8 (&qf)[2][2], bf16* OB, float* LSE, int tid) {
    const AttnCoord cd = attn_coord(U); const int jq0 = 256 * cd.n2;
    const int lane = tid & 63, w = tid >> 6, c = lane & 15, quad = lane >> 4;
    const int kbase = 32 * w;
    f32x4 sa[10], sb[10];
#pragma unroll
    for (int t = 0; t < 10; ++t) { sa[t] = (f32x4){0.f, 0.f, 0.f, 0.f}; sb[t] = (f32x4){0.f, 0.f, 0.f, 0.f}; }
    {
        const LAS unsigned char* kp = L + AT_KS + (kbase + c) * 144 + quad * 16;
        bf16x8 kf[2][2];
#pragma unroll
        for (int ks = 0; ks < 2; ++ks) kf[0][ks] = *(const LAS bf16x8*)(kp + ks * 64);
#pragma unroll
        for (int t = 0; t < 10; ++t) {
            if (t + 1 < 10) {
#pragma unroll
                for (int ks = 0; ks < 2; ++ks) kf[(t + 1) & 1][ks] = *(const LAS bf16x8*)(kp + (16 * (t + 1)) * 144 + ks * 64); }
            __builtin_amdgcn_sched_barrier(0);
#pragma unroll
            for (int ks = 0; ks < 2; ++ks) { if (t != 9) sa[t] = MFMA16(kf[t & 1][ks], qf[0][ks], sa[t]); if (t != 0) sb[t] = MFMA16(kf[t & 1][ks], qf[1][ks], sb[t]); }
            __builtin_amdgcn_sched_barrier(0);
        }
    }
#pragma unroll
    for (int i = 0; i < 4; ++i) { const bool lo = 4 * quad + i >= c, hi = 4 * quad + i <= c;
        sa[0][i] = lo ? sa[0][i] : -3.0e38f; sa[8][i] = hi ? sa[8][i] : -3.0e38f; sb[1][i] = lo ? sb[1][i] : -3.0e38f; sb[9][i] = hi ? sb[9][i] : -3.0e38f; }
    if (cd.n2 == 0 && w < 4) {
#pragma unroll
        for (int t = 0; t < 10; ++t)
#pragma unroll
            for (int i = 0; i < 4; ++i) { const bool ex = kbase + 16 * t + 4 * quad + i >= 128; if (t != 9) sa[t][i] = ex ? sa[t][i] : -3.0e38f; if (t != 0) sb[t][i] = ex ? sb[t][i] : -3.0e38f; }
    }
    float ma = -3.0e38f, mb = -3.0e38f;
#pragma unroll
    for (int t = 0; t < 10; ++t) { if (t != 9) ma = fmaxf(fmaxf(ma, fmaxf(sa[t][0], sa[t][1])), fmaxf(sa[t][2], sa[t][3])); if (t != 0) mb = fmaxf(fmaxf(mb, fmaxf(sb[t][0], sb[t][1])), fmaxf(sb[t][2], sb[t][3])); }
    ma = pg8::max_x32(pg8::max_x16(ma)); mb = pg8::max_x32(pg8::max_x16(mb));
#pragma unroll
    for (int t = 0; t < 10; ++t)
#pragma unroll
        for (int i = 0; i < 4; ++i) { if (t != 9) sa[t][i] = __builtin_amdgcn_exp2f(sa[t][i] - ma); if (t != 0) sb[t][i] = __builtin_amdgcn_exp2f(sb[t][i] - mb); }
    f32x4 lsa = {0.f, 0.f, 0.f, 0.f}, lsb = lsa;
    const bf16x8 ones = {(short)0x3f80, (short)0x3f80, (short)0x3f80, (short)0x3f80, (short)0x3f80, (short)0x3f80, (short)0x3f80, (short)0x3f80};
    f32x4 oa[4], ob[4];
#pragma unroll
    for (int dt = 0; dt < 4; ++dt) { oa[dt] = (f32x4){0.f, 0.f, 0.f, 0.f}; ob[dt] = (f32x4){0.f, 0.f, 0.f, 0.f}; }
    const LAS unsigned char* vb = L + AT_VS + (kbase + 4 * quad + (c >> 2)) * 144 + 8 * (c & 3);
#pragma unroll
    for (int kk = 0; kk < 5; ++kk) {
        u32x4 pa, pb;
        pa.x = pk2(sa[2 * kk][0], sa[2 * kk][1]); pa.y = pk2(sa[2 * kk][2], sa[2 * kk][3]); pa.z = pk2(sa[2 * kk + 1][0], sa[2 * kk + 1][1]); pa.w = pk2(sa[2 * kk + 1][2], sa[2 * kk + 1][3]);
        pb.x = pk2(sb[2 * kk][0], sb[2 * kk][1]); pb.y = pk2(sb[2 * kk][2], sb[2 * kk][3]); pb.z = pk2(sb[2 * kk + 1][0], sb[2 * kk + 1][1]); pb.w = pk2(sb[2 * kk + 1][2], sb[2 * kk + 1][3]);
        const bf16x8 pfa = __builtin_bit_cast(bf16x8, pa), pfb = __builtin_bit_cast(bf16x8, pb);
        lsa = MFMA16(ones, pfa, lsa); lsb = MFMA16(ones, pfb, lsb);
        s16x4 vl[4], vh[4];
#pragma unroll
        for (int dt = 0; dt < 4; ++dt) { vl[dt] = tr16(vb + (32 * kk) * 144 + dt * 32); vh[dt] = tr16(vb + (32 * kk + 16) * 144 + dt * 32); }
#pragma unroll
        for (int dt = 0; dt < 4; ++dt) {
            const bf16x8 vf = {vl[dt][0], vl[dt][1], vl[dt][2], vl[dt][3], vh[dt][0], vh[dt][1], vh[dt][2], vh[dt][3]};
            oa[dt] = MFMA16(vf, pfa, oa[dt]); ob[dt] = MFMA16(vf, pfb, ob[dt]);
        }
    }
    const float la = lsa[0], lb = lsb[0];
    {   const float inv = 1.0f / la; const int tok = cd.tokb + ((jq0 + 32 * w + c) << cd.dl);
        bf16* orow = OB + ((size_t)cd.br * M + tok) * 512 + cd.h * 64 + ((quad & 1) ? 16 + 4 * (quad - 1) : 4 * quad);
#pragma unroll
        for (int p2 = 0; p2 < 2; ++p2) { u32x2 wa, wb; wa.x = pk2(oa[2 * p2][0] * inv, oa[2 * p2][1] * inv); wa.y = pk2(oa[2 * p2][2] * inv, oa[2 * p2][3] * inv);
            wb.x = pk2(oa[2 * p2 + 1][0] * inv, oa[2 * p2 + 1][1] * inv); wb.y = pk2(oa[2 * p2 + 1][2] * inv, oa[2 * p2 + 1][3] * inv);
            *(u32x4*)(orow + 32 * p2) = pg8::widen_pair(wa, wb, quad & 1); }
        if (quad == 0) LSE[((size_t)cd.br * M + tok) * 8 + cd.h] = (ma + __builtin_amdgcn_logf(la)) * 0.6931471805599453f; }
    {   const float inv = 1.0f / lb; const int tok = cd.tokb + ((jq0 + 32 * w + 16 + c) << cd.dl);
        bf16* orow = OB + ((size_t)cd.br * M + tok) * 512 + cd.h * 64 + ((quad & 1) ? 16 + 4 * (quad - 1) : 4 * quad);
#pragma unroll
        for (int p2 = 0; p2 < 2; ++p2) { u32x2 wa, wb; wa.x = pk2(ob[2 * p2][0] * inv, ob[2 * p2][1] * inv); wa.y = pk2(ob[2 * p2][2] * inv, ob[2 * p2][3] * inv);
            wb.x = pk2(ob[2 * p2 + 1][0] * inv, ob[2 * p2 + 1][1] * inv); wb.y = pk2(ob[2 * p2 + 1][2] * inv, ob[2 * p2 + 1][3] * inv);
            *(u32x4*)(orow + 32 * p2) = pg8::widen_pair(wa, wb, quad & 1); }
        if (quad == 0) LSE[((size_t)cd.br * M + tok) * 8 + cd.h] = (mb + __builtin_amdgcn_logf(lb)) * 0.6931471805599453f; }
}

constexpr int GL_TOT = 0, GL_KT = 2048, GL_V = GL_KT + 9216, GL_QD = GL_V + 64 * 272, GL_SSQ = GL_QD + 9216, GL_GA = GL_SSQ + 512;
struct GateRegs { f32x4 ga0, ga1; float wb[2][8]; float bias[2]; };
__device__ __forceinline__ void gate_load(GateRegs& Gt, int tok0, int h, const float* GA, const float* wa2, const float* ba, int tid) {
    const int lane = tid & 63, w = tid >> 6, c = lane & 15, quad = lane >> 4, tt = w & 3, dp = w >> 2;
    Gt.ga0 = (f32x4){0.f, 0.f, 0.f, 0.f}; Gt.ga1 = Gt.ga0;
#pragma unroll
    for (int p = 0; p < 2; ++p) { Gt.bias[p] = ba[h * 64 + 16 * (2 * dp + p) + c];
#pragma unroll
        for (int j = 0; j < 8; ++j) Gt.wb[p][j] = 0.f; }
    if (quad < 2) {
        const float* gp = GA + (size_t)(tok0 + 16 * tt + c) * 16 + 8 * quad; Gt.ga0 = *(const f32x4*)gp; Gt.ga1 = *(const f32x4*)(gp + 4);
#pragma unroll
        for (int p = 0; p < 2; ++p)
#pragma unroll
            for (int j = 0; j < 8; ++j) Gt.wb[p][j] = wa2[(8 * quad + j) * 256 + h * 64 + 16 * (2 * dp + p) + c];
    }
}
__device__ __forceinline__ void gla_gate(LAS unsigned char* L, const GateRegs& Gt, int tid, float (&la)[8]) {
    const int lane = tid & 63, w = tid >> 6, c = lane & 15, quad = lane >> 4, tt = w & 3, dp = w >> 2, seg = tid >> 6, d = tid & 63;
    u32x4 aw; aw.x = pk2(Gt.ga0[0], Gt.ga0[1]); aw.y = pk2(Gt.ga0[2], Gt.ga0[3]); aw.z = pk2(Gt.ga1[0], Gt.ga1[1]); aw.w = pk2(Gt.ga1[2], Gt.ga1[3]);
    const bf16x8 af = __builtin_bit_cast(bf16x8, aw);
    LAS float* LA = (LAS float*)(L + GL_GA);
#pragma unroll
    for (int p = 0; p < 2; ++p) {
        u32x4 bw; bw.x = pk2(Gt.wb[p][0], Gt.wb[p][1]); bw.y = pk2(Gt.wb[p][2], Gt.wb[p][3]); bw.z = pk2(Gt.wb[p][4], Gt.wb[p][5]); bw.w = pk2(Gt.wb[p][6], Gt.wb[p][7]);
        const f32x4 z4 = MFMA16(af, __builtin_bit_cast(bf16x8, bw), ((f32x4){0.f, 0.f, 0.f, 0.f}));
        float s4 = 0.f;
#pragma unroll
        for (int i = 0; i < 4; ++i) { const float z = z4[i] + Gt.bias[p]; const float lv = (fminf(z, 0.f) - __logf(1.0f + __expf(-fabsf(z)))) * (1.0f / 16.0f);
            LA[(16 * tt + 4 * quad + i) * 65 + 16 * (2 * dp + p) + c] = lv; s4 += lv; }
        const float s8 = pg8::sum_x16(s4);
        if ((quad & 1) == 0) ((LAS float*)(L + GL_TOT))[(2 * tt + (quad >> 1)) * 64 + 16 * (2 * dp + p) + c] = s8;
    }
    __syncthreads();
#pragma unroll
    for (int i = 0; i < 8; ++i) la[i] = LA[(8 * seg + i) * 65 + d];
}
__device__ __forceinline__ void gla_gate_prefix(LAS unsigned char* L, const GateRegs& Gt, int tid, float (&bb)[8], float& blast) {
    const int seg = tid >> 6, d = tid & 63;
    float la[8]; gla_gate(L, Gt, tid, la);
    const LAS float* tot = (const LAS float*)(L + GL_TOT);
    float off = 0.f, all = 0.f;
#pragma unroll
    for (int sgi = 0; sgi < 8; ++sgi) { const float v = tot[sgi * 64 + d]; all += v; off += (sgi < seg) ? v : 0.f; }
    float run = off;
#pragma unroll
    for (int i = 0; i < 8; ++i) { run += la[i]; bb[i] = run; }
    blast = all;
}
__device__ __forceinline__ void gla_prefix(LAS unsigned char* L, const float (&la)[8], int tid, float (&bb)[8], float& blast) {
    const int seg = tid >> 6, d = tid & 63; float run = 0.f;
#pragma unroll
    for (int i = 0; i < 8; ++i) { run += la[i]; bb[i] = run; }
    LAS float* tot = (LAS float*)(L + GL_TOT);
    tot[seg * 64 + d] = run;
    __syncthreads();
    float off = 0.f, all = 0.f;
#pragma unroll
    for (int s = 0; s < 8; ++s) { const float v = tot[s * 64 + d]; all += v; off += (s < seg) ? v : 0.f; }
#pragma unroll
    for (int i = 0; i < 8; ++i) bb[i] += off;
    blast = all;
}
__device__ __forceinline__ int gla_first_unit(int G) { if ((G & 7) == 0) { const int n = (int)blockIdx.x >> 3; return n < 128 ? ((int)blockIdx.x & 7) * 128 + n : 1024; } return (int)blockIdx.x; }
__device__ __forceinline__ int gla_next_unit(int unit, int G) { if ((G & 7) == 0) { const int st = G >> 3; return ((unit & 127) + st < 128) ? unit + st : 1024; } return unit + G; }
struct GlaURegs { unsigned short kr[8]; u32x4 vr[2]; GateRegs gt; };
__device__ __forceinline__ void gla_u_load(GlaURegs& R, int unit, const bf16* PG, const float* GA, const float* wa2, const float* ba, int tid) {
    const int bh = unit >> 7, n = unit & 127, b = bh >> 2, h = bh & 3, tok0 = b * SEQ + 64 * n, seg = tid >> 6, d = tid & 63;
#pragma unroll
    for (int i = 0; i < 8; ++i) { const bf16* rp = PG + (size_t)(tok0 + 8 * seg + i) * LDG + h * 64 + d; R.kr[i] = rp[256]; }
#pragma unroll
    for (int p = 0; p < 2; ++p) { const int id = tid + 512 * p; R.vr[p] = *(const u32x4*)(PG + (size_t)(tok0 + (id >> 4)) * LDG + 512 + h * 128 + (id & 15) * 8); }
    gate_load(R.gt, tok0, h, GA, wa2, ba, tid);
}
__device__ __forceinline__ void gla_u_phase(LAS unsigned char* L, const bf16* PG, const float* GA, const float* wa2, const float* ba, bf16* UT, float* DEC, int tid, int G) {
    const int lane = tid & 63, w = tid >> 6, c = lane & 15, quad = lane >> 4, seg = tid >> 6, d = tid & 63;
    int unit = gla_first_unit(G);
    GlaURegs R;
    if (unit < 1024) gla_u_load(R, unit, PG, GA, wa2, ba, tid);
    while (unit < 1024) {
        float bb[8], blast; gla_gate_prefix(L, R.gt, tid, bb, blast);
        { float kv[8];
#pragma unroll
          for (int i = 0; i < 8; ++i) kv[i] = bf2f(R.kr[i]) * __expf(blast - bb[i]);
          u32x4 wv; wv.x = pk2(kv[0], kv[1]); wv.y = pk2(kv[2], kv[3]); wv.z = pk2(kv[4], kv[5]); wv.w = pk2(kv[6], kv[7]);
          *(LAS u32x4*)(L + GL_KT + d * 144 + seg * 16) = wv;
          if (seg == 0) DEC[(size_t)unit * 64 + d] = __expf(blast); }
#pragma unroll
        for (int p = 0; p < 2; ++p) { const int id = tid + 512 * p; *(LAS u32x4*)(L + GL_V + (id >> 4) * 272 + (id & 15) * 16) = R.vr[p]; }
        __syncthreads();
        const int nu = gla_next_unit(unit, G);
        if (nu < 1024) gla_u_load(R, nu, PG, GA, wa2, ba, tid);
        f32x4 acc[4];
#pragma unroll
        for (int dt = 0; dt < 4; ++dt) acc[dt] = (f32x4){0.f, 0.f, 0.f, 0.f};
#pragma unroll
        for (int ks = 0; ks < 2; ++ks) {
            const LAS unsigned char* vp = L + GL_V + (32 * ks + 8 * quad + (c >> 2)) * 272 + (16 * w) * 2 + 8 * (c & 3);
            const s16x4 lo = tr16(vp), hi = tr16(vp + 4 * 272);
            const bf16x8 af = {lo[0], lo[1], lo[2], lo[3], hi[0], hi[1], hi[2], hi[3]};
#pragma unroll
            for (int dt = 0; dt < 4; ++dt) { const bf16x8 bfr = *(const LAS bf16x8*)(L + GL_KT + (16 * dt + c) * 144 + ks * 64 + quad * 16); acc[dt] = MFMA16(af, bfr, acc[dt]); } }
        bf16* up = UT + ((size_t)unit * 128 + 16 * w + 4 * quad) * 64 + c;
#pragma unroll
        for (int dt = 0; dt < 4; ++dt)
#pragma unroll
            for (int i = 0; i < 4; ++i) up[i * 64 + 16 * dt] = f2bf(acc[dt][i]);
        __syncthreads();
        unit = nu;
    }
}
struct GlaORegs { unsigned short qr[8], kr[8]; u32x4 vr[2]; GateRegs gt; };
__device__ __forceinline__ void gla_o_load(GlaORegs& R, int unit, const bf16* PG, const float* GA, const float* wa2, const float* ba, int tid) {
    const int bh = unit >> 7, n = unit & 127, b = bh >> 2, h = bh & 3, tok0 = b * SEQ + 64 * n, seg = tid >> 6, d = tid & 63;
#pragma unroll
    for (int i = 0; i < 8; ++i) { const bf16* rp = PG + (size_t)(tok0 + 8 * seg + i) * LDG + h * 64 + d; R.qr[i] = rp[0]; R.kr[i] = rp[256]; }
#pragma unroll
    for (int p = 0; p < 2; ++p) { const int id = tid + 512 * p; R.vr[p] = *(const u32x4*)(PG + (size_t)(tok0 + (id >> 4)) * LDG + 512 + h * 128 + (id & 15) * 8); }
    gate_load(R.gt, tok0, h, GA, wa2, ba, tid);
}
__device__ __forceinline__ void gla_o_phase(LAS unsigned char* L, const bf16* PG, const float* GA, const float* wa2, const float* ba, const bf16* ST, const float* ggla, bf16* OM, int tid, int G) {
    const int lane = tid & 63, w = tid >> 6, c = lane & 15, quad = lane >> 4, seg = tid >> 6, d = tid & 63;
    const int it = w & 3, eh = w >> 2, itok = 16 * it + c;
    int unit = gla_first_unit(G);
    GlaORegs R;
    if (unit < 1024) gla_o_load(R, unit, PG, GA, wa2, ba, tid);
    while (unit < 1024) {
        const int bh = unit >> 7, n = unit & 127, b = bh >> 2, h = bh & 3, tok0 = b * SEQ + 64 * n;
        const size_t trow = (size_t)(tok0 + itok);
        bf16x8 sf[4][2]; u32x2 rv[4]; f32x4 gg[4];
#pragma unroll
        for (int e4 = 0; e4 < 4; ++e4) { const int et = 4 * eh + e4;
#pragma unroll
            for (int ks = 0; ks < 2; ++ks) sf[e4][ks] = *(const bf16x8*)(ST + ((size_t)unit * 128 + 16 * et + c) * 64 + 32 * ks + 8 * quad);
            rv[e4] = *(const u32x2*)(PG + trow * LDG + 1024 + h * 128 + 16 * et + 4 * quad); gg[e4] = *(const f32x4*)(ggla + h * 128 + 16 * et + 4 * quad); }
        float bb[8], blast; gla_gate_prefix(L, R.gt, tid, bb, blast);
#pragma unroll
        for (int i = 0; i < 8; ++i) { const int t = 8 * seg + i;
            const float qv = bf2f(R.qr[i]) * 0.125f * __expf(bb[i]), kv = bf2f(R.kr[i]) * __expf(-bb[i]);
            *(LAS unsigned short*)(L + GL_QD + t * 144 + d * 2) = f2bf(qv); *(LAS unsigned short*)(L + GL_KT + t * 144 + d * 2) = f2bf(kv); }
#pragma unroll
        for (int p = 0; p < 2; ++p) { const int id = tid + 512 * p; *(LAS u32x4*)(L + GL_V + (id >> 4) * 272 + (id & 15) * 16) = R.vr[p]; }
        __syncthreads();
        const int nu = gla_next_unit(unit, G);
        if (nu < 1024) gla_o_load(R, nu, PG, GA, wa2, ba, tid);
        bf16x8 qf[2];
#pragma unroll
        for (int ks = 0; ks < 2; ++ks) qf[ks] = *(const LAS bf16x8*)(L + GL_QD + itok * 144 + ks * 64 + quad * 16);
        f32x4 at[4];
#pragma unroll
        for (int jt = 0; jt < 4; ++jt) { at[jt] = (f32x4){0.f, 0.f, 0.f, 0.f};
#pragma unroll
            for (int ks = 0; ks < 2; ++ks) { const bf16x8 kf = *(const LAS bf16x8*)(L + GL_KT + (16 * jt + c) * 144 + ks * 64 + quad * 16); at[jt] = MFMA16(kf, qf[ks], at[jt]); }
#pragma unroll
            for (int i = 0; i < 4; ++i) at[jt][i] = (16 * jt + 4 * quad + i <= itok) ? at[jt][i] : 0.f; }
        bf16x8 pf[2];
#pragma unroll
        for (int kk = 0; kk < 2; ++kk) { u32x4 pw; pw.x = pk2(at[2 * kk][0], at[2 * kk][1]); pw.y = pk2(at[2 * kk][2], at[2 * kk][3]); pw.z = pk2(at[2 * kk + 1][0], at[2 * kk + 1][1]); pw.w = pk2(at[2 * kk + 1][2], at[2 * kk + 1][3]);
            pf[kk] = __builtin_bit_cast(bf16x8, pw); }
        f32x4 o[4]; float ssq = 0.f;
        const LAS unsigned char* vb = L + GL_V + (4 * quad + (c >> 2)) * 272 + 8 * (c & 3);
#pragma unroll
        for (int e4 = 0; e4 < 4; ++e4) { const int et = 4 * eh + e4; f32x4 acc = {0.f, 0.f, 0.f, 0.f};
#pragma unroll
            for (int kk = 0; kk < 2; ++kk) { const s16x4 lo = tr16(vb + (32 * kk) * 272 + et * 32), hi = tr16(vb + (32 * kk + 16) * 272 + et * 32);
                const bf16x8 vf = {lo[0], lo[1], lo[2], lo[3], hi[0], hi[1], hi[2], hi[3]};
                acc = MFMA16(vf, pf[kk], acc); }
#pragma unroll
            for (int ks = 0; ks < 2; ++ks) acc = MFMA16(sf[e4][ks], qf[ks], acc);
            o[e4] = acc; ssq += (acc[0] * acc[0] + acc[1] * acc[1]) + (acc[2] * acc[2] + acc[3] * acc[3]); }
        ssq = pg8::sum_x32(pg8::sum_x16(ssq));
        LAS float* SSQ = (LAS float*)(L + GL_SSQ);
        if (quad == 0) SSQ[eh * 64 + itok] = ssq;
        __syncthreads();
        const float rstd = __builtin_amdgcn_rsqf((SSQ[itok] + SSQ[64 + itok]) * (1.0f / 128.0f) + EPS);
        u32x2 wv4[4];
#pragma unroll
        for (int e4 = 0; e4 < 4; ++e4) { const f32x4 g = gg[e4];
            const float r0 = __uint_as_float(rv[e4].x << 16), r1 = __uint_as_float(rv[e4].x & 0xffff0000u), r2 = __uint_as_float(rv[e4].y << 16), r3 = __uint_as_float(rv[e4].y & 0xffff0000u);
            wv4[e4].x = pk2(o[e4][0] * rstd * g[0] * pg8::silu_f(r0), o[e4][1] * rstd * g[1] * pg8::silu_f(r1)); wv4[e4].y = pk2(o[e4][2] * rstd * g[2] * pg8::silu_f(r2), o[e4][3] * rstd * g[3] * pg8::silu_f(r3)); }
        { bf16* orow = OM + trow * D + h * 128 + 64 * eh + ((quad & 1) ? 16 + 4 * (quad - 1) : 4 * quad);
#pragma unroll
          for (int p2 = 0; p2 < 2; ++p2) *(u32x4*)(orow + 32 * p2) = pg8::widen_pair(wv4[2 * p2], wv4[2 * p2 + 1], quad & 1); }
        __syncthreads();
        unit = nu;
    }
}

#define XB_TMO      128
#define XB_XCNT(j)  (256  + 64 * (j))
#define XB_XSUB(j)  (1280 + 64 * (j))
#define XB_XGEN(j)  (2304 + 64 * (j))
#define XB_TOP      3328
#define XB_TOPGEN   3392
#define XCD_BAR_WORDS 3456
#define XB_SPIN_CAP (1u << 18)

__device__ __forceinline__ unsigned xb_ld(unsigned* p)              { return __hip_atomic_load(p, __ATOMIC_RELAXED, __HIP_MEMORY_SCOPE_AGENT); }
__device__ __forceinline__ unsigned xb_add(unsigned* p, unsigned v) { return __hip_atomic_fetch_add(p, v, __ATOMIC_RELAXED, __HIP_MEMORY_SCOPE_AGENT); }
__device__ __forceinline__ unsigned xb_xcc_id() { return (unsigned)__builtin_amdgcn_s_getreg((3 << 11) | 20) & 0xFu; }
#define XB_SPIN(cond, bar) do { unsigned _sp = 0; while (cond) { __builtin_amdgcn_s_sleep(1); \
    if ((++_sp & 255u) == 0u) { if (xb_ld(&(bar)[XB_TMO])) break; if (_sp > XB_SPIN_CAP) { atomicAdd(&(bar)[XB_TMO], 1u); break; } } } } while (0)

struct XcdBarrier {
    unsigned* bar; unsigned x;
    volatile LAS unsigned* st;
};

__device__ __forceinline__ XcdBarrier xcd_barrier_post(unsigned* bar, volatile LAS unsigned* st) {
    XcdBarrier b; b.bar = bar; b.x = xb_xcc_id(); b.st = st;
    if (threadIdx.x == 0) (void)xb_add(&bar[XB_XCNT(b.x)], 1u);
    return b;
}
__device__ __forceinline__ void xcd_barrier_complete(unsigned* bar, unsigned x, unsigned& nloc, unsigned& nx) {
    const unsigned G = gridDim.x * gridDim.y * gridDim.z;
    unsigned sum, cnt, mine, sp = 0u;
    for (;;) {
        sum = 0u; cnt = 0u; mine = 0u;
#pragma unroll
        for (unsigned j = 0; j < 16; ++j) { const unsigned c = xb_ld(&bar[XB_XCNT(j)]); sum += c; cnt += (c > 0u) ? 1u : 0u; mine = (j == x) ? c : mine; }
        if (sum == G) break;
        __builtin_amdgcn_s_sleep(1);
        if ((++sp & 255u) == 0u) { if (xb_ld(&bar[XB_TMO])) break; if (sp > XB_SPIN_CAP) { atomicAdd(&bar[XB_TMO], 1u); break; } }
    }
    nloc = mine > 0u ? mine : 1u; nx = cnt > 0u ? cnt : 1u;
}

__device__ __forceinline__ void xcd_barrier(const XcdBarrier& b) {
    asm volatile("s_waitcnt vmcnt(0)" ::: "memory");
    __syncthreads();
    if (threadIdx.x == 0) {
        unsigned* bar = b.bar;
        __builtin_amdgcn_s_waitcnt(0);
        unsigned nloc = b.st[0], nx = b.st[1];
        if (nloc == 0u) { xcd_barrier_complete(bar, b.x, nloc, nx); b.st[0] = nloc; b.st[1] = nx; }
        const unsigned old = xb_add(&bar[XB_XSUB(b.x)], 1u);
        const unsigned gen = old / nloc;
        if (old + 1u == (gen + 1u) * nloc) {
            __builtin_amdgcn_fence(__ATOMIC_RELEASE, "agent");
            asm volatile("s_waitcnt vmcnt(0)" ::: "memory");
            const unsigned og = xb_add(&bar[XB_TOP], 1u);
            const unsigned tg = og / nx;
            if (og + 1u == (tg + 1u) * nx) xb_add(&bar[XB_TOPGEN], 1u);
            else XB_SPIN(xb_ld(&bar[XB_TOPGEN]) == tg, bar);
            __builtin_amdgcn_fence(__ATOMIC_ACQUIRE, "agent");
            xb_add(&bar[XB_XGEN(b.x)], 1u);
            asm volatile("s_waitcnt vmcnt(0)" ::: "memory");
        } else {
            XB_SPIN(xb_ld(&bar[XB_XGEN(b.x)]) == gen, bar);
            __builtin_amdgcn_fence(__ATOMIC_ACQUIRE, "agent");
            asm volatile("s_waitcnt vmcnt(0)" ::: "memory");
        }
    }
    __syncthreads();
}

constexpr unsigned ATT_END = 0xffffffffu;
__device__ __forceinline__ unsigned attn_unit_of(unsigned q, unsigned t) {
    const unsigned bh = 2u * q + t / 96u, wi = t % 96u, c4 = wi / 48u, w48 = wi % 48u;
    unsigned br, idx;
    if (w48 < 16u) { br = 2u; idx = (w48 << 1) | c4; }
    else { const unsigned w32 = w48 - 16u, c1 = w32 >> 3, w8 = w32 & 7u;
        if (w8 < 4u) { br = 1u; idx = (w8 << 3) | (4u * c4 + c1); } else { br = 0u; idx = 16u * c4 + 4u * c1 + (w8 - 4u); } }
    return br * 512u + bh * 32u + idx;
}
__device__ __forceinline__ unsigned attn_draw(unsigned* qctr, unsigned x0, volatile LAS unsigned* qoffp) {
    unsigned qoff = *qoffp;
    while (qoff < 8u) { const unsigned q = (x0 + qoff) & 7u, t = atomicAdd(qctr + 64u * q, 1u); if (t < 192u) { *qoffp = qoff; return attn_unit_of(q, t); } ++qoff; }
    *qoffp = qoff; return ATT_END;
}
__global__ void __launch_bounds__(NTHR, 2) layer_fwd(Args a) {
    extern __shared__ __attribute__((aligned(16))) unsigned char lds_raw[];
    cg::grid_group grid = cg::this_grid();
    LAS unsigned char* lds = (LAS unsigned char*)lds_raw;
    const int tid = threadIdx.x, lane = tid & 63, wave = __builtin_amdgcn_readfirstlane(tid >> 6);
    const int G = gridDim.x;
    unsigned char* ws = a.ws;
    bf16* XN = (bf16*)(ws + WS_XN); bf16* HB = (bf16*)(ws + WS_H); bf16* PG = (bf16*)(ws + WS_PG); bf16* PA = (bf16*)(ws + WS_PA); bf16* OM = (bf16*)(ws + WS_OM); bf16* OB = (bf16*)(ws + WS_OB);
    bf16* ST = (bf16*)(ws + WS_ST); bf16* UT = (bf16*)a.out;     float* DEC = (float*)(ws + WS_DEC); float* LSE = (float*)(ws + WS_LSE); float* CS = (float*)(ws + WS_CS);
    float* GA = (float*)(ws + WS_GA); float* SS0 = (float*)(ws + WS_SS0); float* SS1 = (float*)(ws + WS_SS1); float* SS2 = (float*)(ws + WS_SS2);
    unsigned* CTR = (unsigned*)(ws + WS_CTL);
    if (tid < 32) ((LAS unsigned*)(lds + MISC_OFF))[tid] = 0u;
    __syncthreads();
    if (a.use_cg_sync) grid.sync();
    const XcdBarrier bar = xcd_barrier_post((unsigned*)(ws + WS_BAR), (volatile LAS unsigned*)(lds + MISC_OFF) + 8);
    unsigned long long ts0 = 0, ts1 = 0; STAMP(0);

    p0_xn(a, lane, wave);
    conv_items(a, lds, IT_W13A, IT_W2A, blockIdx.x * NWAVES + wave, G * NWAVES, lane, wave);
    GSYNC(); STAMP(1);
    { pg8::Gemm g{XN, (const bf16*)(ws + WS_W13A), M, NUP, D}; pg8::StaticOrder S; S.init(M, NUP, G, (int)blockIdx.x);
      pg8::EpiSwiglu E{HB, FF, SS0};
      for (int rp = 0; rp < REP_UP; ++rp) pg8::gemm_phase<pg8::EpiSwiglu, pg8::StaticOrder, true, true>(lds, g, S, E); }
    { int li, nl; light_wg((M / 256) * (NUP / 256), G, li, nl);
      if (li >= 0) { p0_cs(a, li * NTHR + tid, nl * NTHR); conv_items(a, lds, IT_W2A, IT_W13B, li * NWAVES + wave, nl * NWAVES, lane, wave); gate_cols(a, li * NTHR + tid, nl * NTHR); } }
    GSYNC(); STAMP(2);
    { pg8::Gemm g{HB, (const bf16*)(ws + WS_W2A), M, D, FF}; pg8::StaticOrder S; S.init(M, D, G, (int)blockIdx.x);
      pg8::EpiResidB<false> E{a.x, XN, SS1, 0.5f, D};
      pg8::gemm_phase<pg8::EpiResidB<false>, pg8::StaticOrder, true, true>(lds, g, S, E); }
    GSYNC(); STAMP(3);
    { pg8::Gemm g{XN, (const bf16*)(ws + WS_WIN), M, NIN, D}; pg8::StaticOrder S; S.init(M, NIN, G, (int)blockIdx.x);
      pg8::EpiProj E{PG, PA, SS1, CS};
      ga_job(lds, XN, (const bf16*)(ws + WS_WGA), SS1, GA, tid, G);
      for (int rp = 0; rp < REP_IN; ++rp) pg8::gemm_phase<pg8::EpiProj, pg8::StaticOrder, true, true>(lds, g, S, E); }
    GSYNC(); STAMP(4);
    for (int rp = 0; rp < REP_MIX; ++rp) {
    gla_u_phase(lds, PG, GA, a.wa2, a.ba, UT, DEC, tid, G);
    GSYNC(); STAMP(5);
    const bool xal = (G & 7) == 0; const int sstep = xal ? (G >> 3) : G, slim = xal ? 64 : 512, sbase = xal ? ((int)blockIdx.x & 7) * 64 : 0;
    for (int sl0 = xal ? ((int)blockIdx.x >> 3) : (int)blockIdx.x; sl0 < slim; sl0 += 2 * sstep) {
        const int sg = tid >> 7, cl = tid & 127;
        float uu[2][32], dd[2][32]; bf16* sp[2];
#pragma unroll
        for (int j = 0; j < 2; ++j) {
            const int set = sbase + ((sl0 + j * sstep < slim) ? sl0 + j * sstep : sl0);
            const int gcol = set * 128 + cl, bh = gcol >> 13, ed = gcol & 8191, d = ed & 63;
            const bf16* up = UT + ((size_t)bh * 128 + 32 * sg) * 8192 + ed; const float* dp = DEC + ((size_t)bh * 128 + 32 * sg) * 64 + d; sp[j] = ST + ((size_t)bh * 128 + 32 * sg) * 8192 + ed;
#pragma unroll
            for (int k = 0; k < 32; ++k) { uu[j][k] = bf2f(up[(size_t)k * 8192]); dd[j][k] = dp[k * 64]; }
        }
        LAS f32x2* agg = (LAS f32x2*)lds;
#pragma unroll
        for (int j = 0; j < 2; ++j) { float S = 0.f, P = 1.f;
#pragma unroll
            for (int k = 0; k < 32; ++k) { S = dd[j][k] * S + uu[j][k]; P *= dd[j][k]; }
            agg[(j * 4 + sg) * 128 + cl] = (f32x2){P, S}; }
        __syncthreads();
#pragma unroll
        for (int j = 0; j < 2; ++j) { float st = 0.f;
#pragma unroll
            for (int q = 0; q < 3; ++q) { const f32x2 ag = agg[(j * 4 + q) * 128 + cl]; if (q < sg) st = ag.x * st + ag.y; }
#pragma unroll
            for (int k = 0; k < 32; ++k) { sp[j][(size_t)k * 8192] = f2bf(st); st = dd[j][k] * st + uu[j][k]; } }
        __syncthreads();
    }
    {
        volatile LAS unsigned* nxt = (volatile LAS unsigned*)(lds + MISC_OFF);
        constexpr unsigned NCONV = (IT_W2B - IT_W13B) / 8;
        for (;;) {
            if (tid == 0) nxt[0] = atomicAdd(CTR + 64 * rp, 1u);
            __syncthreads();
            const unsigned t = nxt[0];
            __syncthreads();
            if (t >= NCONV) break;
            const int lo = IT_W13B + 8 * (int)t;
            conv_items(a, lds, lo, lo + 8, wave, NWAVES, lane, wave);
        }
        unsigned* qctr = CTR + 64 * (2 + 8 * rp); const unsigned x0 = bar.x & 7u;
        if (tid == 0) { nxt[4] = 0u; nxt[0] = attn_draw(qctr, x0, nxt + 4); nxt[1] = attn_draw(qctr, x0, nxt + 4); }
        __syncthreads();
        unsigned u = nxt[0], un = nxt[1];
        AttnRegs R;
        if (u != ATT_END) attn_load(R, (int)u, PA, tid);
        while (u != ATT_END) {
            attn_store(R, lds, tid);
            bf16x8 qf[2][2];
#pragma unroll
            for (int qa = 0; qa < 2; ++qa)
#pragma unroll
                for (int ks = 0; ks < 2; ++ks) qf[qa][ks] = R.q[qa][ks];
            unsigned tk = 0u;
            if (tid == 0) tk = attn_draw(qctr, x0, nxt + 4);
            __syncthreads();
            if (un != ATT_END) attn_load(R, (int)un, PA, tid);
            attn_compute(lds, (int)u, qf, OB, LSE, tid);
            if (tid == 0) nxt[2] = tk;
            __syncthreads();
            u = un; un = nxt[2];
        }
    }
    GSYNC(); STAMP(6);
    }
    for (int rp = 0; rp < REP_MIXC; ++rp) {
    gla_o_phase(lds, PG, GA, a.wa2, a.ba, ST, a.ggla, OM, tid, G);
    {
        const f32x4 g0 = *(const f32x4*)(a.gatt + 8 * lane), g1 = *(const f32x4*)(a.gatt + 8 * lane + 4);
        const int hh = lane >> 3;
        for (int tk0 = (blockIdx.x * NWAVES + wave) * 4; tk0 < M; tk0 += G * NWAVES * 4) {
            float ls[4][3]; u32x4 vv[4][3];
#pragma unroll
            for (int q = 0; q < 4; ++q)
#pragma unroll
                for (int r = 0; r < 3; ++r) { ls[q][r] = LSE[((size_t)r * M + tk0 + q) * 8 + hh]; vv[q][r] = *(const u32x4*)(OB + ((size_t)r * M + tk0 + q) * 512 + 8 * lane); }
#pragma unroll
            for (int q = 0; q < 4; ++q) {
                const float mx = fmaxf(ls[q][0], fmaxf(ls[q][1], ls[q][2])); float w0 = __expf(ls[q][0] - mx), w1 = __expf(ls[q][1] - mx), w2 = __expf(ls[q][2] - mx); const float iw = 1.0f / (w0 + w1 + w2); w0 *= iw; w1 *= iw; w2 *= iw;
                float o[8]; float ssq = 0.f;
#pragma unroll
                for (int i = 0; i < 4; ++i) {
                    o[2 * i] = w0 * __uint_as_float(vv[q][0][i] << 16) + w1 * __uint_as_float(vv[q][1][i] << 16) + w2 * __uint_as_float(vv[q][2][i] << 16);
                    o[2 * i + 1] = w0 * __uint_as_float(vv[q][0][i] & 0xffff0000u) + w1 * __uint_as_float(vv[q][1][i] & 0xffff0000u) + w2 * __uint_as_float(vv[q][2][i] & 0xffff0000u);
                    ssq += o[2 * i] * o[2 * i] + o[2 * i + 1] * o[2 * i + 1]; }
                ssq = wave_sum(ssq);
                const float rstd = __builtin_amdgcn_rsqf(ssq * (1.0f / 512.0f) + EPS);
                u32x4 wv; wv.x = pk2(o[0] * rstd * g0[0], o[1] * rstd * g0[1]); wv.y = pk2(o[2] * rstd * g0[2], o[3] * rstd * g0[3]); wv.z = pk2(o[4] * rstd * g1[0], o[5] * rstd * g1[1]); wv.w = pk2(o[6] * rstd * g1[2], o[7] * rstd * g1[3]);
                *(u32x4*)(OM + (size_t)(tk0 + q) * D + 512 + 8 * lane) = wv;
            }
        }
    }
    GSYNC(); STAMP(7);
    }
    { pg8::Gemm g{OM, (const bf16*)(ws + WS_WOUT), M, D, D}; pg8::StaticOrder S; S.init(M, D, G, (int)blockIdx.x);
      pg8::EpiResidB<true> E{XN, XN, SS2, 1.0f, D};
      pg8::gemm_phase<pg8::EpiResidB<true>, pg8::StaticOrder, true, true>(lds, g, S, E); }
    GSYNC(); STAMP(8);
    { pg8::Gemm g{XN, (const bf16*)(ws + WS_W13B), M, NUP, D}; pg8::StaticOrder S; S.init(M, NUP, G, (int)blockIdx.x);
      pg8::EpiSwiglu E{HB, FF, SS2};
      pg8::gemm_phase<pg8::EpiSwiglu, pg8::StaticOrder, true, true>(lds, g, S, E); }
    { int li, nl; light_wg((M / 256) * (NUP / 256), G, li, nl);
      if (li >= 0) conv_items(a, lds, IT_W2B, IT_END, li * NWAVES + wave, nl * NWAVES, lane, wave); }
    GSYNC(); STAMP(9);
    if (G == (M / 256) * (D / 256)) {
        pg8::Gemm g{HB, (const bf16*)(ws + WS_W2B), M, D, FF}; pg8::StaticOrder S; S.init(M, D, G, (int)blockIdx.x);
        pg8::EpiFinal E{XN, a.out, (float*)(ws + WS_SS3), (unsigned*)(ws + WS_PCNT), a.gf, 0.5f, D, 32u};
        pg8::gemm_phase<pg8::EpiFinal, pg8::StaticOrder, true, true>(lds, g, S, E);
    } else {
        { pg8::Gemm g{HB, (const bf16*)(ws + WS_W2B), M, D, FF}; pg8::StaticOrder S; S.init(M, D, G, (int)blockIdx.x);
          pg8::EpiResidF E{XN, a.out, 0.5f, D};
          pg8::gemm_phase<pg8::EpiResidF, pg8::StaticOrder, true, true>(lds, g, S, E); }
        GSYNC(); STAMP(10);
        for (int m = blockIdx.x * NWAVES + wave; m < M; m += G * NWAVES) {
            f32x4* xr = (f32x4*)(a.out + (size_t)m * D) + lane; f32x4 v[4]; float s = 0.f;
#pragma unroll
            for (int j = 0; j < 4; ++j) { v[j] = xr[64 * j]; s += (v[j][0] * v[j][0] + v[j][1] * v[j][1]) + (v[j][2] * v[j][2] + v[j][3] * v[j][3]); }
            const float rstd = __builtin_amdgcn_rsqf(wave_sum(s) * (1.0f / 1024.0f) + EPS);
#pragma unroll
            for (int j = 0; j < 4; ++j) { const f32x4 g = *((const f32x4*)a.gf + lane + 64 * j); xr[64 * j] = v[j] * rstd * g; }
        }
    }
    if (PROBE_PH >= 0) {
        STAMP(10);
        if (blockIdx.x == 0) { const unsigned long long dt = (ts1 - ts0) * 4ull, t0 = __builtin_amdgcn_s_memrealtime(); while (__builtin_amdgcn_s_memrealtime() - t0 < dt) __builtin_amdgcn_s_sleep(8); }
    }
}

extern "C" void kernel_launch(void* const* d_in, const int* in_sizes, int n_in, void* d_out, int out_size, void* d_ws, size_t ws_size, hipStream_t stream) {
    static int grid = 0;
    if (grid == 0) {
        if (n_in != 18 || in_sizes[0] != M * D || out_size != M * D || ws_size < WS_END) { fprintf(stderr, "kernel_launch: unexpected shapes (n_in %d, in0 %d, out %d, ws %zu)\n", n_in, n_in > 0 ? in_sizes[0] : -1, out_size, ws_size); grid = -1; return; }
        int dev = 0, cus = 0, per_cu = 0;
        if (hipGetDevice(&dev) != hipSuccess || hipDeviceGetAttribute(&cus, hipDeviceAttributeMultiprocessorCount, dev) != hipSuccess) { grid = -1; return; }
        if (hipFuncSetAttribute((const void*)layer_fwd, hipFuncAttributeMaxDynamicSharedMemorySize, LDS_BYTES) != hipSuccess) { fprintf(stderr, "kernel_launch: hipFuncSetAttribute failed\n"); grid = -1; return; }
        if (hipOccupancyMaxActiveBlocksPerMultiprocessor(&per_cu, (const void*)layer_fwd, NTHR, LDS_BYTES) != hipSuccess || per_cu < 1) { fprintf(stderr, "kernel_launch: occupancy query gave %d\n", per_cu); per_cu = 1; }
        (void)hipGetLastError();
        grid = cus * per_cu;
    }
    if (grid < 0) return;
    (void)hipMemsetAsync((char*)d_ws + WS_CTL, 0, CTL_ZERO_BYTES, stream);
    Args a{};
    a.x = (const float*)d_in[0]; a.pos = (const int*)d_in[1]; a.g1 = (const float*)d_in[2]; a.w1a = (const float*)d_in[3]; a.w3a = (const float*)d_in[4]; a.w2a = (const float*)d_in[5];
    a.gm = (const float*)d_in[6]; a.win = (const float*)d_in[7]; a.wa2 = (const float*)d_in[8]; a.ba = (const float*)d_in[9]; a.ggla = (const float*)d_in[10]; a.gatt = (const float*)d_in[11];
    a.wout = (const float*)d_in[12]; a.g2 = (const float*)d_in[13]; a.w1b = (const float*)d_in[14]; a.w3b = (const float*)d_in[15]; a.w2b = (const float*)d_in[16]; a.gf = (const float*)d_in[17];
    a.out = (float*)d_out; a.ws = (unsigned char*)d_ws;
    void* args[] = {&a};
    const hipError_t e = hipLaunchCooperativeKernel((const void*)layer_fwd, dim3(grid), dim3(NTHR), args, LDS_BYTES, stream);
    if (e != hipSuccess) fprintf(stderr, "kernel_launch: cooperative launch failed: %s (grid %d)\n", hipGetErrorString(e), grid);
}
```

```cpp
#include <hip/hip_runtime.h>
#include <hip/hip_cooperative_groups.h>
#include <cstdio>
#include <cstdint>
namespace cg = cooperative_groups;
namespace pg8 {
#define PG8_LAS __attribute__((address_space(3)))
typedef unsigned short bf16_t;
typedef short bf16x8 __attribute__((ext_vector_type(8)));
typedef float f32x4 __attribute__((ext_vector_type(4)));
typedef unsigned u32x4 __attribute__((ext_vector_type(4)));
constexpr int BM = 256, BK = 64, HALF = 128, HTB = HALF * BK * 2  , STAGE_BYTES = 8 * HTB, NXCD = 8, WGM = 8;

__host__ __device__ __forceinline__ int lds_byte(int r, int c) { const int st = (r >> 4) * 2 + (c >> 5), rr = r & 15, cc = c & 31, ob = rr * 64 + cc * 2; return st * 1024 + (ob ^ (((ob >> 9) & 1) << 5)); }
__host__ __device__ __forceinline__ void stage_rc(int b, int& R, int& C) { const int st = b / 1024, sb = b % 1024, swz = sb ^ (((sb >> 9) & 1) << 5); R = (st >> 1) * 16 + swz / 64; C = (st & 1) * 32 + (swz % 64) / 2; }
__host__ __device__ __forceinline__ int perm32(int rho) { const int n = rho >> 4, i = rho & 15; return 8 * (i >> 2) + 4 * n + (i & 3); }

struct Unit { int pm, pn; };
struct Gemm { const bf16_t* A; const bf16_t* Bt; int M, N, K; };

struct StaticOrder {
    int nM, nN, nwg, G, c;
    __host__ __device__ void init(int M, int N, int G_, int c_) { nM = M / BM; nN = N / BM; nwg = nM * nN; G = G_; c = c_; }
    __host__ __device__ bool next(int i, Unit& u) const {
        const long L = (long)i * G + c; if (L >= nwg) return false;
        int wgid = (int)L; { const int q = nwg / NXCD, r = nwg % NXCD, xcd = wgid % NXCD, off = wgid / NXCD; wgid = (xcd < r ? xcd * (q + 1) : r * (q + 1) + (xcd - r) * q) + off; }
        const int nig = WGM * nN, gid = wgid / nig, fm = gid * WGM, gsz = (nM - fm) < WGM ? (nM - fm) : WGM;
        u.pm = fm + ((wgid % nig) % gsz); u.pn = (wgid % nig) / gsz; return true;
    }
    __device__ __forceinline__ void a_ready(const Unit&) const {}
    __device__ __forceinline__ void done(const Unit&) const {}
};

__device__ __forceinline__ unsigned cvt_pk_bf16(float lo, float hi) { unsigned r; asm volatile("v_cvt_pk_bf16_f32 %0, %1, %2" : "=v"(r) : "v"(lo), "v"(hi)); return r; }
__device__ __forceinline__ float sum_x16(float x) { auto r = __builtin_amdgcn_permlane16_swap(__float_as_uint(x), __float_as_uint(x), false, false); return __uint_as_float(r[0]) + __uint_as_float(r[1]); }
__device__ __forceinline__ float sum_x32(float x) { auto r = __builtin_amdgcn_permlane32_swap(__float_as_uint(x), __float_as_uint(x), false, false); return __uint_as_float(r[0]) + __uint_as_float(r[1]); }
__device__ __forceinline__ float max_x16(float x) { auto r = __builtin_amdgcn_permlane16_swap(__float_as_uint(x), __float_as_uint(x), false, false); return fmaxf(__uint_as_float(r[0]), __uint_as_float(r[1])); }
__device__ __forceinline__ float max_x32(float x) { auto r = __builtin_amdgcn_permlane32_swap(__float_as_uint(x), __float_as_uint(x), false, false); return fmaxf(__uint_as_float(r[0]), __uint_as_float(r[1])); }
typedef unsigned u32x2w __attribute__((ext_vector_type(2)));
__device__ __forceinline__ u32x4 widen_pair(u32x2w A, u32x2w B, bool odd) {
    auto rx = __builtin_amdgcn_permlane16_swap(A.x, B.x, false, false); auto ry = __builtin_amdgcn_permlane16_swap(A.y, B.y, false, false);
    u32x4 o; if (odd) { o.x = rx[0]; o.y = ry[0]; o.z = B.x; o.w = B.y; } else { o.x = A.x; o.y = A.y; o.z = rx[1]; o.w = ry[1]; }
    return o;
}
__device__ __forceinline__ float get_x16(float x, bool odd) { auto r = __builtin_amdgcn_permlane16_swap(__float_as_uint(x), __float_as_uint(x), false, false); return __uint_as_float(odd ? r[0] : r[1]); }
constexpr float RMS_EPS = 1e-6f;
__device__ __forceinline__ float silu_f(float x) { return x * __builtin_amdgcn_rcpf(1.0f + __expf(-x)); }
struct EpiSwiglu {
    static constexpr bool PERM = true, AFTER_DRAIN = false;
    bf16_t* O; int ldc; const float* ss;
    __device__ __forceinline__ void operator()(const f32x4 (&acc)[2][2][4][2], const Unit& u, int wr, int wc, int fr, int fq) const {
        const int row0 = u.pm * BM + wr * 64 + fr, col0 = u.pn * HALF + wc * 32 + 8 * fq;
        float ssv[2][4];
#pragma unroll
        for (int ai = 0; ai < 2; ++ai)
#pragma unroll
            for (int m = 0; m < 4; ++m) ssv[ai][m] = ss[row0 + ai * HALF + m * 16];
#pragma unroll
        for (int ai = 0; ai < 2; ++ai)
#pragma unroll
            for (int m = 0; m < 4; ++m) {
                const int row = row0 + ai * HALF + m * 16;
                const float rs = __builtin_amdgcn_rsqf(ssv[ai][m] * (1.0f / 1024.0f) + RMS_EPS);
                const f32x4 a0 = acc[ai][0][m][0] * rs, a1 = acc[ai][0][m][1] * rs, b0 = acc[ai][1][m][0] * rs, b1 = acc[ai][1][m][1] * rs;
                u32x4 w;
                w.x = cvt_pk_bf16(silu_f(a0[0]) * b0[0], silu_f(a0[1]) * b0[1]); w.y = cvt_pk_bf16(silu_f(a0[2]) * b0[2], silu_f(a0[3]) * b0[3]);
                w.z = cvt_pk_bf16(silu_f(a1[0]) * b1[0], silu_f(a1[1]) * b1[1]); w.w = cvt_pk_bf16(silu_f(a1[2]) * b1[2], silu_f(a1[3]) * b1[3]);
                *(u32x4*)(O + (size_t)row * ldc + col0) = w;
            }
    }
};
struct EpiProj {
    static constexpr bool PERM = true, AFTER_DRAIN = false;
    bf16_t* PG; bf16_t* PA; const float* ss; const float* cs;
    __device__ __forceinline__ void operator()(const f32x4 (&acc)[2][2][4][2], const Unit& u, int wr, int wc, int fr, int fq) const {
        const int row0 = u.pm * BM + wr * 64 + fr;
        bf16_t* base; int ldc;
        if (u.pn < 6) { base = PG + u.pn * BM; ldc = 1792; } else { base = PA + (u.pn - 6) * BM; ldc = 1536; }
        base += wc * 32 + 8 * fq;
        const bool rot = (u.pn >= 6) && (u.pn < 10) && ((wc & 1) == 0);
        const float qs = (u.pn == 6 || u.pn == 7) ? 0.125f * 1.4426950408889634f : 1.0f;
        float ssv[2][4];
#pragma unroll
        for (int ai = 0; ai < 2; ++ai)
#pragma unroll
            for (int m = 0; m < 4; ++m) ssv[ai][m] = ss[row0 + ai * HALF + m * 16];
#pragma unroll
        for (int ai = 0; ai < 2; ++ai)
#pragma unroll
            for (int m = 0; m < 4; ++m) {
                const int row = row0 + ai * HALF + m * 16;
                const float rs = __builtin_amdgcn_rsqf(ssv[ai][m] * (1.0f / 1024.0f) + RMS_EPS);
                f32x4 c0 = {1.f, 1.f, 1.f, 1.f}, c1 = c0, s0 = {0.f, 0.f, 0.f, 0.f}, s1 = s0;
                if (rot && fq < 2) { const float* cr = cs + (size_t)row * 16; c0 = *(const f32x4*)cr; c1 = *(const f32x4*)(cr + 4); s0 = *(const f32x4*)(cr + 8); s1 = *(const f32x4*)(cr + 12);
                    if (fq == 0) { s0 = -s0; s1 = -s1; } }
#pragma unroll
                for (int bj = 0; bj < 2; ++bj) {
                    f32x4 v0 = acc[ai][bj][m][0] * rs, v1 = acc[ai][bj][m][1] * rs;
                    if (rot) {
                        f32x4 p0, p1;
#pragma unroll
                        for (int j = 0; j < 4; ++j) { p0[j] = get_x16(v0[j], fq & 1); p1[j] = get_x16(v1[j], fq & 1); }
                        v0 = v0 * c0 + p0 * s0; v1 = v1 * c1 + p1 * s1;
                    }
                    v0 = v0 * qs; v1 = v1 * qs;
                    u32x4 w; w.x = cvt_pk_bf16(v0[0], v0[1]); w.y = cvt_pk_bf16(v0[2], v0[3]); w.z = cvt_pk_bf16(v1[0], v1[1]); w.w = cvt_pk_bf16(v1[2], v1[3]);
                    *(u32x4*)(base + (size_t)row * ldc + bj * HALF) = w;
                }
            }
    }
};
struct EpiResidF {
    static constexpr bool PERM = true, AFTER_DRAIN = false;
    const bf16_t* base; float* out; float alpha; int ldc;
    __device__ __forceinline__ void operator()(const f32x4 (&acc)[2][2][4][2], const Unit& u, int wr, int wc, int fr, int fq) const {
        const int row0 = u.pm * BM + wr * 64 + fr, col0 = u.pn * BM + wc * 32 + 8 * fq;
#pragma unroll
        for (int ai = 0; ai < 2; ++ai)
#pragma unroll
            for (int m = 0; m < 4; ++m) {
                const size_t off = (size_t)(row0 + ai * HALF + m * 16) * ldc + col0;
#pragma unroll
                for (int bj = 0; bj < 2; ++bj) {
                    const u32x4 w = *(const u32x4*)(base + off + bj * HALF);
                    const f32x4 r0 = {__uint_as_float(w.x << 16), __uint_as_float(w.x & 0xffff0000u), __uint_as_float(w.y << 16), __uint_as_float(w.y & 0xffff0000u)};
                    const f32x4 r1 = {__uint_as_float(w.z << 16), __uint_as_float(w.z & 0xffff0000u), __uint_as_float(w.w << 16), __uint_as_float(w.w & 0xffff0000u)};
                    *(f32x4*)(out + off + bj * HALF) = r0 + acc[ai][bj][m][0] * alpha; *(f32x4*)(out + off + bj * HALF + 4) = r1 + acc[ai][bj][m][1] * alpha;
                }
            }
    }
};
__device__ __forceinline__ void unpack8(const u32x4 w, f32x4& a, f32x4& b) {
    a = (f32x4){__uint_as_float(w.x << 16), __uint_as_float(w.x & 0xffff0000u), __uint_as_float(w.y << 16), __uint_as_float(w.y & 0xffff0000u)};
    b = (f32x4){__uint_as_float(w.z << 16), __uint_as_float(w.z & 0xffff0000u), __uint_as_float(w.w << 16), __uint_as_float(w.w & 0xffff0000u)};
}
template <bool BASE_BF16> struct EpiResidB {
    static constexpr bool PERM = true, AFTER_DRAIN = false;
    const void* base; bf16_t* xn; float* ss; float alpha; int ldc;
    __device__ __forceinline__ void operator()(const f32x4 (&acc)[2][2][4][2], const Unit& u, int wr, int wc, int fr, int fq) const {
        const int row0 = u.pm * BM + wr * 64 + fr, col0 = u.pn * BM + wc * 32 + 8 * fq;
        if constexpr (BASE_BF16) {
            u32x4 rb[2][4][2];
#pragma unroll
            for (int ai = 0; ai < 2; ++ai)
#pragma unroll
                for (int m = 0; m < 4; ++m)
#pragma unroll
                    for (int bj = 0; bj < 2; ++bj) rb[ai][m][bj] = *(const u32x4*)((const bf16_t*)base + (size_t)(row0 + ai * HALF + m * 16) * ldc + col0 + bj * HALF);
#pragma unroll
            for (int ai = 0; ai < 2; ++ai)
#pragma unroll
                for (int m = 0; m < 4; ++m) {
                    const int row = row0 + ai * HALF + m * 16; const size_t off = (size_t)row * ldc + col0; float s = 0.f;
#pragma unroll
                    for (int bj = 0; bj < 2; ++bj) {
                        f32x4 r0, r1; unpack8(rb[ai][m][bj], r0, r1);
                        const f32x4 o0 = r0 + acc[ai][bj][m][0] * alpha, o1 = r1 + acc[ai][bj][m][1] * alpha;
                        u32x4 w; w.x = cvt_pk_bf16(o0[0], o0[1]); w.y = cvt_pk_bf16(o0[2], o0[3]); w.z = cvt_pk_bf16(o1[0], o1[1]); w.w = cvt_pk_bf16(o1[2], o1[3]);
                        *(u32x4*)(xn + off + bj * HALF) = w;
                        s += (o0[0] * o0[0] + o0[1] * o0[1]) + (o0[2] * o0[2] + o0[3] * o0[3]) + (o1[0] * o1[0] + o1[1] * o1[1]) + (o1[2] * o1[2] + o1[3] * o1[3]);
                    }
                    s = sum_x32(sum_x16(s)); if (fq == 0) atomicAdd(ss + row, s);
                }
        } else {
#pragma unroll
            for (int ai = 0; ai < 2; ++ai) {
                f32x4 rf[4][2][2];
#pragma unroll
                for (int m = 0; m < 4; ++m)
#pragma unroll
                    for (int bj = 0; bj < 2; ++bj) { const float* bp = (const float*)base + (size_t)(row0 + ai * HALF + m * 16) * ldc + col0 + bj * HALF; rf[m][bj][0] = *(const f32x4*)bp; rf[m][bj][1] = *(const f32x4*)(bp + 4); }
#pragma unroll
                for (int m = 0; m < 4; ++m) {
                    const int row = row0 + ai * HALF + m * 16; const size_t off = (size_t)row * ldc + col0; float s = 0.f;
#pragma unroll
                    for (int bj = 0; bj < 2; ++bj) {
                        const f32x4 o0 = rf[m][bj][0] + acc[ai][bj][m][0] * alpha, o1 = rf[m][bj][1] + acc[ai][bj][m][1] * alpha;
                        u32x4 w; w.x = cvt_pk_bf16(o0[0], o0[1]); w.y = cvt_pk_bf16(o0[2], o0[3]); w.z = cvt_pk_bf16(o1[0], o1[1]); w.w = cvt_pk_bf16(o1[2], o1[3]);
                        *(u32x4*)(xn + off + bj * HALF) = w;
                        s += (o0[0] * o0[0] + o0[1] * o0[1]) + (o0[2] * o0[2] + o0[3] * o0[3]) + (o1[0] * o1[0] + o1[1] * o1[1]) + (o1[2] * o1[2] + o1[3] * o1[3]);
                    }
                    s = sum_x32(sum_x16(s)); if (fq == 0) atomicAdd(ss + row, s);
                }
            }
        }
    }
};
struct EpiFinal {
    static constexpr bool PERM = true, AFTER_DRAIN = false;
    const bf16_t* base; float* out; float* ss; unsigned* cnt; const float* gf; float alpha; int ldc; unsigned want;
    __device__ __forceinline__ void operator()(f32x4 (&acc)[2][2][4][2], const Unit& u, int wr, int wc, int fr, int fq) const {
        const int row0 = u.pm * BM + wr * 64 + fr, col0 = u.pn * BM + wc * 32 + 8 * fq;
        u32x4 rb[2][4][2];
#pragma unroll
        for (int ai = 0; ai < 2; ++ai)
#pragma unroll
            for (int m = 0; m < 4; ++m)
#pragma unroll
                for (int bj = 0; bj < 2; ++bj) rb[ai][m][bj] = *(const u32x4*)(base + (size_t)(row0 + ai * HALF + m * 16) * ldc + col0 + bj * HALF);
#pragma unroll
        for (int ai = 0; ai < 2; ++ai)
#pragma unroll
            for (int m = 0; m < 4; ++m) {
                const int row = row0 + ai * HALF + m * 16; const size_t off = (size_t)row * ldc + col0; float s = 0.f;
#pragma unroll
                for (int bj = 0; bj < 2; ++bj) {
                    f32x4 r0, r1; unpack8(rb[ai][m][bj], r0, r1);
                    const f32x4 o0 = r0 + acc[ai][bj][m][0] * alpha, o1 = r1 + acc[ai][bj][m][1] * alpha;
                    acc[ai][bj][m][0] = o0; acc[ai][bj][m][1] = o1;
                    s += (o0[0] * o0[0] + o0[1] * o0[1]) + (o0[2] * o0[2] + o0[3] * o0[3]) + (o1[0] * o1[0] + o1[1] * o1[1]) + (o1[2] * o1[2] + o1[3] * o1[3]);
                }
                s = sum_x32(sum_x16(s));
                if (fq == 0) { const float old = __hip_atomic_fetch_add(ss + row, s, __ATOMIC_RELAXED, __HIP_MEMORY_SCOPE_AGENT); asm volatile("" :: "v"(old)); }
            }
        asm volatile("s_waitcnt vmcnt(0)" ::: "memory");
        unsigned* pc = cnt + 64 * u.pm;
        if ((threadIdx.x & 63) == 0) __hip_atomic_fetch_add(pc, 1u, __ATOMIC_RELAXED, __HIP_MEMORY_SCOPE_AGENT);
        { unsigned spins = 0; while ((unsigned)__builtin_amdgcn_readfirstlane(__hip_atomic_load(pc, __ATOMIC_RELAXED, __HIP_MEMORY_SCOPE_AGENT)) < want) { __builtin_amdgcn_s_sleep(2); if (++spins > (1u << 22)) break; } }
        asm volatile("" ::: "memory");
        const f32x4 g00 = *(const f32x4*)(gf + col0), g01 = *(const f32x4*)(gf + col0 + 4), g10 = *(const f32x4*)(gf + col0 + HALF), g11 = *(const f32x4*)(gf + col0 + HALF + 4);
#pragma unroll
        for (int ai = 0; ai < 2; ++ai)
#pragma unroll
            for (int m = 0; m < 4; ++m) {
                const int row = row0 + ai * HALF + m * 16; const size_t off = (size_t)row * ldc + col0;
                const float rs = __builtin_amdgcn_rsqf(__hip_atomic_load(ss + row, __ATOMIC_RELAXED, __HIP_MEMORY_SCOPE_AGENT) * (1.0f / 1024.0f) + RMS_EPS);
                *(f32x4*)(out + off) = acc[ai][0][m][0] * rs * g00; *(f32x4*)(out + off + 4) = acc[ai][0][m][1] * rs * g01;
                *(f32x4*)(out + off + HALF) = acc[ai][1][m][0] * rs * g10; *(f32x4*)(out + off + HALF + 4) = acc[ai][1][m][1] * rs * g11;
            }
    }
};
template <class Epi, class Sched, bool ALIGN_EPI = false, bool SP2 = false>
__device__ __forceinline__ void gemm_phase(PG8_LAS unsigned char* lds, const Gemm g, const Sched& S, const Epi& E) {
    int tid_ = threadIdx.x; asm volatile("" : "+v"(tid_));
    const int tid = tid_, wid = __builtin_amdgcn_readfirstlane(tid >> 6), lane = tid & 63, wr = wid >> 2, wc = wid & 3, fr = lane & 15, fq = lane >> 4;
    const int K = g.K, nt = K / BK;
    unsigned voffA[2], voffB[2];
#pragma unroll
    for (int i = 0; i < 2; ++i) { int R, C; stage_rc(tid * 16 + i * 8192, R, C); const int Rb = Epi::PERM ? ((R & ~31) + perm32(R & 31)) : R;
        voffA[i] = (unsigned)(R * K + C) * 2u; voffB[i] = (unsigned)(Rb * K + C) * 2u; }
    const size_t kstep = (size_t)(BK * 2);
    const size_t hstep = (size_t)HALF * K * 2;
    const size_t tstep = 2 * hstep;
    const unsigned ldsw = (unsigned)wid * 1024u;
    const int aoff = lds_byte(wr * 64 + fr, fq * 8), boff = lds_byte(wc * 32 + fr, fq * 8);
#define PG8_SA(b, h) (((b) * 2 + (h)) * HTB)
#define PG8_SB(b, h) ((4 + (b) * 2 + (h)) * HTB)
#define PG8_STAGE(bufoff, gbase, voff) do { _Pragma("unroll") for (int _i = 0; _i < 2; ++_i) \
        __builtin_amdgcn_global_load_lds((const unsigned*)((const char*)(gbase) + (voff)[_i]), (PG8_LAS unsigned*)(lds + (bufoff) + ldsw + _i * 8192), 16, 0, 0); } while (0)
#define PG8_LDA(dst, b, h) do { _Pragma("unroll") for (int m = 0; m < 4; ++m) _Pragma("unroll") for (int k = 0; k < 2; ++k) dst[m][k] = *(const PG8_LAS bf16x8*)(lds + PG8_SA(b, h) + aoff + m * 2048 + k * 1024); } while (0)
#define PG8_LDB(dst, b, h) do { _Pragma("unroll") for (int n = 0; n < 2; ++n) _Pragma("unroll") for (int k = 0; k < 2; ++k) dst[n][k] = *(const PG8_LAS bf16x8*)(lds + PG8_SB(b, h) + boff + n * 2048 + k * 1024); } while (0)
#define PG8_MMA(ai, bj, At, Bt) do { __builtin_amdgcn_s_setprio(1); _Pragma("unroll") for (int m = 0; m < 4; ++m) _Pragma("unroll") for (int n = 0; n < 2; ++n) _Pragma("unroll") for (int k = 0; k < 2; ++k) \
        acc[ai][bj][m][n] = __builtin_amdgcn_mfma_f32_16x16x32_bf16(Bt[n][k], At[m][k], acc[ai][bj][m][n], 0, 0, 0); __builtin_amdgcn_s_setprio(0); } while (0)
#define PG8_WAIT_V(n) asm volatile("s_waitcnt vmcnt(" #n ")" ::: "memory")
#define PG8_WAIT_L(n) asm volatile("s_waitcnt lgkmcnt(" #n ")" ::: "memory")
#define PG8_BAR __builtin_amdgcn_s_barrier()
#define PG8_SCHED __builtin_amdgcn_sched_barrier(0)
    Unit cur, nxt; int ui = 0;
    if (!S.next(0, cur)) return;
    f32x4 acc[2][2][4][2];
#pragma unroll
    for (int a = 0; a < 2; ++a)
#pragma unroll
        for (int b = 0; b < 2; ++b)
#pragma unroll
            for (int m = 0; m < 4; ++m)
#pragma unroll
                for (int n = 0; n < 2; ++n) acc[a][b][m][n] = (f32x4){0.f, 0.f, 0.f, 0.f};
    bf16x8 At[4][2], B0[2][2], B1[2][2];
    const char* cA = (const char*)g.A + (size_t)cur.pm * tstep; const char* cB = (const char*)g.Bt + (size_t)cur.pn * tstep;
    S.a_ready(cur);
    if constexpr (SP2) {
        PG8_STAGE(PG8_SB(0, 0), cB, voffB); PG8_STAGE(PG8_SB(0, 1), cB + hstep, voffB); PG8_STAGE(PG8_SA(0, 0), cA, voffA); PG8_STAGE(PG8_SA(0, 1), cA + hstep, voffA);
        if (wr == 1) PG8_BAR;
        PG8_WAIT_V(2); PG8_BAR;
        PG8_STAGE(PG8_SB(1, 0), cB + kstep, voffB); PG8_STAGE(PG8_SA(1, 0), cA + kstep, voffA); PG8_STAGE(PG8_SB(1, 1), cB + hstep + kstep, voffB);
        PG8_WAIT_V(6); PG8_BAR;
    } else {
        PG8_STAGE(PG8_SB(0, 0), cB, voffB); PG8_STAGE(PG8_SA(0, 0), cA, voffA); PG8_STAGE(PG8_SB(0, 1), cB + hstep, voffB); PG8_STAGE(PG8_SA(0, 1), cA + hstep, voffA);
        if (wr == 1) PG8_BAR;
        PG8_WAIT_V(4); PG8_BAR;
        PG8_STAGE(PG8_SB(1, 0), cB + kstep, voffB); PG8_STAGE(PG8_SA(1, 0), cA + kstep, voffA); PG8_STAGE(PG8_SB(1, 1), cB + hstep + kstep, voffB);
        PG8_WAIT_V(6); PG8_BAR;
    }
    for (;;) {
        const bool has_next = S.next(ui + 1, nxt);
        const char* nA = has_next ? (const char*)g.A + (size_t)nxt.pm * tstep : cA; const char* nB = has_next ? (const char*)g.Bt + (size_t)nxt.pn * tstep : cB;
        for (int t = 0; t < nt; t += 2) {
            const bool last = (t == nt - 2);
            const char* a1 = cA + (size_t)(t + 1) * kstep;
            const char* a2 = last ? nA : cA + (size_t)(t + 2) * kstep; const char* b2 = last ? nB : cB + (size_t)(t + 2) * kstep;
            const char* a3 = a2 + kstep; const char* b3 = b2 + kstep;
            if (last && has_next) S.a_ready(nxt);
            if constexpr (SP2) {
            PG8_LDB(B0, 0, 0); PG8_LDB(B1, 0, 1); PG8_SCHED; PG8_LDA(At, 0, 0); PG8_STAGE(PG8_SA(1, 1), a1 + hstep, voffA);
            PG8_WAIT_V(8); PG8_WAIT_L(0); PG8_BAR; PG8_MMA(0, 0, At, B0); PG8_MMA(0, 1, At, B1); PG8_BAR; PG8_SCHED;
            PG8_LDA(At, 0, 1); PG8_STAGE(PG8_SB(0, 0), b2, voffB); PG8_STAGE(PG8_SB(0, 1), b2 + hstep, voffB); PG8_STAGE(PG8_SA(0, 0), a2, voffA);
            PG8_WAIT_V(8); PG8_WAIT_L(0); PG8_BAR; PG8_MMA(1, 0, At, B0); PG8_MMA(1, 1, At, B1); PG8_BAR; PG8_SCHED;
            PG8_LDB(B0, 1, 0); PG8_LDB(B1, 1, 1); PG8_SCHED; PG8_LDA(At, 1, 0); PG8_STAGE(PG8_SA(0, 1), a2 + hstep, voffA);
            PG8_WAIT_V(8); PG8_WAIT_L(0); PG8_BAR; PG8_MMA(0, 0, At, B0); PG8_MMA(0, 1, At, B1); PG8_BAR; PG8_SCHED;
            PG8_LDA(At, 1, 1); PG8_STAGE(PG8_SB(1, 0), b3, voffB); PG8_STAGE(PG8_SB(1, 1), b3 + hstep, voffB); PG8_STAGE(PG8_SA(1, 0), a3, voffA);
            PG8_WAIT_V(8); PG8_WAIT_L(0); PG8_BAR; PG8_MMA(1, 0, At, B0); PG8_MMA(1, 1, At, B1); PG8_BAR; PG8_SCHED;
            } else {
            PG8_LDB(B0, 0, 0); PG8_SCHED; PG8_LDA(At, 0, 0); PG8_STAGE(PG8_SA(1, 1), a1 + hstep, voffA);
            PG8_WAIT_L(8); PG8_BAR; PG8_WAIT_L(0); PG8_MMA(0, 0, At, B0); PG8_BAR; PG8_SCHED;
            PG8_LDB(B1, 0, 1); PG8_STAGE(PG8_SB(0, 0), b2, voffB);
            PG8_BAR; PG8_WAIT_L(0); PG8_MMA(0, 1, At, B1); PG8_BAR;
            PG8_LDA(At, 0, 1); PG8_STAGE(PG8_SA(0, 0), a2, voffA);
            PG8_BAR; PG8_WAIT_L(0); PG8_MMA(1, 0, At, B0); PG8_BAR; PG8_SCHED;
            PG8_STAGE(PG8_SB(0, 1), b2 + hstep, voffB);
            PG8_WAIT_V(6); PG8_BAR; PG8_MMA(1, 1, At, B1); PG8_BAR;
            PG8_LDB(B0, 1, 0); PG8_SCHED; PG8_LDA(At, 1, 0); PG8_STAGE(PG8_SA(0, 1), a2 + hstep, voffA);
            PG8_WAIT_L(8); PG8_BAR; PG8_WAIT_L(0); PG8_MMA(0, 0, At, B0); PG8_BAR; PG8_SCHED;
            PG8_LDB(B1, 1, 1); PG8_STAGE(PG8_SB(1, 0), b3, voffB);
            PG8_BAR; PG8_WAIT_L(0); PG8_MMA(0, 1, At, B1); PG8_BAR;
            PG8_LDA(At, 1, 1); PG8_STAGE(PG8_SA(1, 0), a3, voffA);
            PG8_BAR; PG8_WAIT_L(0); PG8_MMA(1, 0, At, B0); PG8_BAR; PG8_SCHED;
            PG8_STAGE(PG8_SB(1, 1), b3 + hstep, voffB);
            PG8_WAIT_V(6); PG8_BAR; PG8_MMA(1, 1, At, B1); PG8_BAR;
            }
        }
        if constexpr (ALIGN_EPI) { if (wr == 0) PG8_BAR; }
        if constexpr (!Epi::AFTER_DRAIN) { E(acc, cur, wr, wc, fr, fq); S.done(cur); }
        if (!has_next) break;
#pragma unroll
        for (int a = 0; a < 2; ++a)
#pragma unroll
            for (int b = 0; b < 2; ++b)
#pragma unroll
                for (int m = 0; m < 4; ++m)
#pragma unroll
                    for (int n = 0; n < 2; ++n) acc[a][b][m][n] = (f32x4){0.f, 0.f, 0.f, 0.f};
        cur = nxt; cA = nA; cB = nB; ++ui;
        if constexpr (ALIGN_EPI) { if (wr == 1) PG8_BAR; }
    }
    PG8_WAIT_V(0);
    if constexpr (!ALIGN_EPI) { if (wr == 0) PG8_BAR; }
    PG8_BAR;
    if constexpr (Epi::AFTER_DRAIN) { E.fused(acc, cur, wr, wc, fr, fq, lds, wid, lane); S.done(cur); }
#undef PG8_SA
#undef PG8_SB
#undef PG8_STAGE
#undef PG8_LDA
#undef PG8_LDB
#undef PG8_MMA
#undef PG8_WAIT_V
#undef PG8_WAIT_L
#undef PG8_BAR
#undef PG8_SCHED
}
}

#define LAS __attribute__((address_space(3)))
typedef unsigned short bf16;
typedef short bf16x8 __attribute__((ext_vector_type(8)));
typedef short s16x4 __attribute__((ext_vector_type(4)));
typedef float f32x4 __attribute__((ext_vector_type(4)));
typedef float f32x2 __attribute__((ext_vector_type(2)));
typedef unsigned u32x4 __attribute__((ext_vector_type(4)));
typedef unsigned u32x2 __attribute__((ext_vector_type(2)));
typedef __bf16 bf16x2_t __attribute__((ext_vector_type(2)));

#ifndef PROBE_PH
#define PROBE_PH -1
#endif
#define STAMP(k) do { if (PROBE_PH >= 0 && (k) == PROBE_PH) ts0 = __builtin_amdgcn_s_memrealtime(); if (PROBE_PH >= 0 && (k) == PROBE_PH + 1) ts1 = __builtin_amdgcn_s_memrealtime(); } while (0)
#ifndef REP_MIX
#define REP_MIX 1
#endif
#ifndef REP_MIXC
#define REP_MIXC 1
#endif
#ifndef REP_UP
#define REP_UP 1
#endif
#ifndef REP_DN
#define REP_DN 1
#endif
#ifndef REP_OUT
#define REP_OUT 1
#endif
#ifndef REP_SYNC
#define REP_SYNC 1
#endif
#ifndef REP_P0
#define REP_P0 1
#endif
#ifndef REP_IN
#define REP_IN 1
#endif
#define GSYNC() do { for (int _r = 0; _r < REP_SYNC; ++_r) xcd_barrier(bar); } while (0)
constexpr int NWAVES = 8, NTHR = 512;
constexpr int SEQ = 8192, M = 16384, D = 1024, FF = 2816, NUP = 2 * FF  , NIN = 3072, DIN_SRC = 3088;
constexpr int LDG = 1792, LDA = 1536;
constexpr float EPS = 1e-6f;

constexpr size_t MiB = 1u << 20;
constexpr size_t WS_CTL = 0, CTL_ZERO_BYTES = 1 * MiB;
constexpr size_t WS_SS1 = 64 * 1024, WS_SS2 = 128 * 1024, WS_SS3 = 192 * 1024, WS_BAR = 256 * 1024, WS_PCNT = 512 * 1024;
constexpr size_t WS_SS0 = 1 * MiB;
constexpr size_t WS_CS = 1 * MiB + 256 * 1024;
constexpr size_t WS_DEC = 2 * MiB + 512 * 1024;
constexpr size_t WS_LSE = 3 * MiB;
constexpr size_t WS_WGA = 4 * MiB + 512 * 1024;
constexpr size_t WS_GA = 232 * MiB;
constexpr size_t WS_W13A = 5 * MiB, WS_W2A = 16 * MiB, WS_WIN = 22 * MiB, WS_WOUT = 29 * MiB, WS_W13B = 31 * MiB, WS_W2B = 42 * MiB;
constexpr size_t WS_ST = 5 * MiB;
constexpr size_t WS_XN = 48 * MiB;
constexpr size_t WS_UT = 48 * MiB;
constexpr size_t WS_PG = 80 * MiB;
constexpr size_t WS_PA = 136 * MiB;
constexpr size_t WS_OM = 136 * MiB;
constexpr size_t WS_OB = 184 * MiB;
constexpr size_t WS_H = 80 * MiB;
constexpr size_t WS_END = 233 * MiB;
static_assert(WS_W13A + (size_t)NUP * D * 2 <= WS_W2A && WS_W2A + (size_t)D * FF * 2 <= WS_WIN && WS_WIN + (size_t)NIN * D * 2 <= WS_WOUT && WS_WOUT + (size_t)D * D * 2 <= WS_W13B &&
              WS_W13B + (size_t)NUP * D * 2 <= WS_W2B && WS_W2B + (size_t)D * FF * 2 <= WS_XN && WS_ST + 16 * MiB <= WS_WIN && WS_PG + (size_t)M * LDG * 2 <= WS_PA &&
              WS_PA + (size_t)M * LDA * 2 <= WS_OB && WS_H + (size_t)M * FF * 2 <= WS_OB && WS_OB + (size_t)3 * M * 512 * 2 <= WS_END, "d_ws map");

constexpr int RING_BYTES = 131072, LDS_BYTES = 147456, MISC_OFF = RING_BYTES;

__device__ __forceinline__ float bf2f(unsigned short v) { return __uint_as_float(((unsigned)v) << 16); }
__device__ __forceinline__ unsigned pk2(float lo, float hi) { f32x2 v = {lo, hi}; bf16x2_t b = __builtin_convertvector(v, bf16x2_t); return __builtin_bit_cast(unsigned, b); }
__device__ __forceinline__ unsigned short f2bf(float x) { return (unsigned short)(pk2(x, 0.f) & 0xffffu); }
__device__ __forceinline__ float wave_sum(float v) {
#pragma unroll
    for (int o = 1; o < 64; o <<= 1) v += __shfl_xor(v, o);
    return v;
}
#define MFMA16(a, b, c) __builtin_amdgcn_mfma_f32_16x16x32_bf16((a), (b), (c), 0, 0, 0)

struct Args {
    const float* x; const int* pos; const float* g1; const float* w1a; const float* w3a; const float* w2a; const float* gm; const float* win; const float* wa2; const float* ba;
    const float* ggla; const float* gatt; const float* wout; const float* g2; const float* w1b; const float* w3b; const float* w2b; const float* gf;
    float* out; unsigned char* ws; int use_cg_sync; int pad;
};

__device__ __forceinline__ void tr_item(const float* W, int ldw, int col0, int k0, const float* gain, bf16* WT, int K, int drow0, LAS float* scr, int lane) {
    const float* src = W + (size_t)(k0 + (lane >> 5)) * ldw + col0 + (lane & 31);
    float v[32];
#pragma unroll
    for (int i = 0; i < 32; ++i) v[i] = __builtin_nontemporal_load(src + (size_t)(2 * i) * ldw);
    const int c = lane & 7;
    f32x4 g0 = {1.f, 1.f, 1.f, 1.f}, g1 = g0;
    if (gain) { g0 = *(const f32x4*)(gain + k0 + 8 * c); g1 = *(const f32x4*)(gain + k0 + 8 * c + 4); }
#pragma unroll
    for (int i = 0; i < 32; ++i) scr[(2 * i + (lane >> 5)) * 33 + (lane & 31)] = v[i];
    asm volatile("s_waitcnt lgkmcnt(0)" ::: "memory");
#pragma unroll
    for (int j = 0; j < 4; ++j) { const int n = (lane >> 3) + 8 * j; const LAS float* s = scr + (8 * c) * 33 + n;
        u32x4 o; o.x = pk2(s[0 * 33] * g0[0], s[1 * 33] * g0[1]); o.y = pk2(s[2 * 33] * g0[2], s[3 * 33] * g0[3]); o.z = pk2(s[4 * 33] * g1[0], s[5 * 33] * g1[1]); o.w = pk2(s[6 * 33] * g1[2], s[7 * 33] * g1[3]);
        *(u32x4*)(WT + (size_t)(drow0 + n) * K + k0 + 8 * c) = o; }
    asm volatile("s_waitcnt lgkmcnt(0)" ::: "memory");
}
__device__ __forceinline__ void up_item(const float* w1, const float* w3, const float* g, bf16* WT, int r, LAS float* scr, int lane) {
    const int which = r / 1408, rr = r % 1408, kb = rr / 88, nb = rr % 88;
    tr_item(which ? w3 : w1, FF, 32 * nb, 64 * kb, g, WT, D, 256 * (nb >> 2) + 32 * (nb & 3) + 128 * which, scr, lane);
}
__device__ __forceinline__ void conv_items(const Args& a, LAS unsigned char* lds, int lo, int hi, int widx, int nw, int lane_in, int wave) {
    int lane = lane_in; asm volatile("" : "+v"(lane));
    unsigned char* ws = a.ws;
    LAS float* scr = (LAS float*)(lds + wave * 16384);
    bf16* W13A = (bf16*)(ws + WS_W13A); bf16* W2A = (bf16*)(ws + WS_W2A); bf16* WIN = (bf16*)(ws + WS_WIN); bf16* WOUT = (bf16*)(ws + WS_WOUT); bf16* W13B = (bf16*)(ws + WS_W13B); bf16* W2B = (bf16*)(ws + WS_W2B);
    constexpr int I_UP = 2816, I_DN = 1408, I_IN = 1536, I_OUT = 512;
    for (int it = lo + widx; it < hi; it += nw) {
        int r = it;
        if (r < I_UP) { up_item(a.w1a, a.w3a, a.g1, W13A, r, scr, lane); continue; } r -= I_UP;
        if (r < I_DN) { tr_item(a.w2a, D, 32 * (r % 32), 64 * (r / 32), nullptr, W2A, FF, 32 * (r % 32), scr, lane); continue; } r -= I_DN;
        if (r < I_IN) { const int kb = r / 96, nb = r % 96; tr_item(a.win, DIN_SRC, nb < 48 ? 32 * nb : 32 * nb + 16, 64 * kb, a.gm, WIN, D, 32 * nb, scr, lane); continue; } r -= I_IN;
        if (r < I_OUT) { tr_item(a.wout, D, 32 * (r % 32), 64 * (r / 32), nullptr, WOUT, D, 32 * (r % 32), scr, lane); continue; } r -= I_OUT;
        if (r < I_UP) { up_item(a.w1b, a.w3b, a.g2, W13B, r, scr, lane); continue; } r -= I_UP;
        tr_item(a.w2b, D, 32 * (r % 32), 64 * (r / 32), nullptr, W2B, FF, 32 * (r % 32), scr, lane);
    }
}
constexpr int IT_W13A = 0, IT_W2A = 2816, IT_W13B = 6272, IT_W2B = 9088, IT_END = 10496;
__device__ __forceinline__ void gate_cols(const Args& a, int tidx, int nthr) {
    bf16* WGA = (bf16*)(a.ws + WS_WGA);
    for (int item = tidx; item < 16 * 128; item += nthr) {
        const int r = item & 15, kc = item >> 4; float o[8];
#pragma unroll
        for (int i = 0; i < 8; ++i) { const int k = 8 * kc + i; o[i] = a.win[(size_t)k * DIN_SRC + 1536 + r] * a.gm[k]; }
        u32x4 w; w.x = pk2(o[0], o[1]); w.y = pk2(o[2], o[3]); w.z = pk2(o[4], o[5]); w.w = pk2(o[6], o[7]);
        *(u32x4*)(WGA + (size_t)r * D + 8 * kc) = w;
    }
}
__device__ __forceinline__ void ga_job(LAS unsigned char* L, const bf16* XN, const bf16* WGA, const float* ss, float* GA, int tid, int G) {
    const int lane = tid & 63, w = tid >> 6, c = lane & 15, quad = lane >> 4, mt = w & 3, kh = w >> 2;
    for (int rb = blockIdx.x; rb < M / 64; rb += G) {
        const bf16* ap = XN + (size_t)(rb * 64 + 16 * mt + c) * D + kh * 512 + 8 * quad; const bf16* bp = WGA + (size_t)c * D + kh * 512 + 8 * quad;
        f32x4 acc = {0.f, 0.f, 0.f, 0.f};
        {   bf16x8 af[16], bfr[16];
#pragma unroll
            for (int ks = 0; ks < 16; ++ks) { af[ks] = *(const bf16x8*)(ap + ks * 32); bfr[ks] = *(const bf16x8*)(bp + ks * 32); }
#pragma unroll
            for (int ks = 0; ks < 16; ++ks) acc = MFMA16(af[ks], bfr[ks], acc);
        }
        LAS float* P = (LAS float*)L;
#pragma unroll
        for (int i = 0; i < 4; ++i) P[(kh * 64 + 16 * mt + 4 * quad + i) * 16 + c] = acc[i];
        __syncthreads();
        { const int row = tid >> 3, r2 = (tid & 7) * 2; const float rs = __builtin_amdgcn_rsqf(ss[rb * 64 + row] * (1.0f / 1024.0f) + EPS);
          f32x2 o; o.x = (P[row * 16 + r2] + P[(64 + row) * 16 + r2]) * rs; o.y = (P[row * 16 + r2 + 1] + P[(64 + row) * 16 + r2 + 1]) * rs;
          *(f32x2*)(GA + (size_t)(rb * 64 + row) * 16 + r2) = o; }
        __syncthreads();
    }
}
__device__ __forceinline__ void light_wg(int nunits, int G, int& idx, int& nlight) { const int rem = nunits % G; nlight = rem ? G - rem : G; idx = rem ? (int)blockIdx.x - rem : (int)blockIdx.x; }
__device__ __forceinline__ void p0_xn(const Args& a, int lane, int wave) {
    unsigned char* ws = a.ws;
    const int gw = blockIdx.x * NWAVES + wave, NGW = gridDim.x * NWAVES;
    bf16* XN = (bf16*)(ws + WS_XN); float* SS0 = (float*)(ws + WS_SS0);
    for (int m0 = gw * 8; m0 < M; m0 += NGW * 8) {
        f32x4 v[8][4];
#pragma unroll
        for (int r = 0; r < 8; ++r) { const f32x4* xr = (const f32x4*)(a.x + (size_t)(m0 + r) * D) + lane;
#pragma unroll
            for (int j = 0; j < 4; ++j) v[r][j] = __builtin_nontemporal_load(xr + 64 * j); }
#pragma unroll
        for (int r = 0; r < 8; ++r) { unsigned long long* o8 = (unsigned long long*)(XN + (size_t)(m0 + r) * D) + lane; float s = 0.f;
#pragma unroll
            for (int j = 0; j < 4; ++j) { const f32x4 x4 = v[r][j]; s += (x4[0] * x4[0] + x4[1] * x4[1]) + (x4[2] * x4[2] + x4[3] * x4[3]);
                o8[64 * j] = (unsigned long long)pk2(x4[0], x4[1]) | ((unsigned long long)pk2(x4[2], x4[3]) << 32); }
            s = wave_sum(s); if (lane == 0) SS0[m0 + r] = s; }
    }
}
__device__ __forceinline__ void p0_cs(const Args& a, int tidx, int nthr) {
    unsigned char* ws = a.ws;
    float* CS = (float*)(ws + WS_CS);
    for (int e = tidx; e < M * 8; e += nthr) {
        const int tok = e >> 3, i = e & 7;
        const float inv = i == 0 ? 1.0f : i == 1 ? 0.1939227432012558f : i == 2 ? 0.03760603070259094f : i == 3 ? 0.007292664609849453f : i == 4 ? 0.0014142135623842478f : i == 5 ? 0.00027424818836152554f : i == 6 ? 5.318296098266728e-05f : 1.0313386155758053e-05f;
        const float ang = (float)a.pos[tok] * inv;
        const double ad = (double)ang, kq = __builtin_rint(ad * 0.15915494309189535), rd = ad - kq * 6.283185307179586;
        const float rr = (float)rd;
        CS[tok * 16 + i] = cosf(rr); CS[tok * 16 + 8 + i] = sinf(rr);
    }
}

constexpr int AT_KS = 0, AT_VS = 384 * 144, AT_BYTES = 2 * 384 * 144;
static_assert(AT_BYTES <= RING_BYTES, "attention LDS");
typedef short v4i16_t __attribute__((ext_vector_type(4)));
__device__ __forceinline__ s16x4 tr16(const LAS unsigned char* p) { return __builtin_amdgcn_ds_read_tr16_b64_v4i16((LAS v4i16_t*)p); }
struct AttnRegs { u32x4 k[6], v[6]; bf16x8 q[2][2]; };
struct AttnCoord { int br, dl, tokb, h, n2; };
__device__ __forceinline__ AttnCoord attn_coord(int U) {
    AttnCoord c; c.br = U >> 9; const int rem = U & 511, b = rem >> 8, idx = rem & 31; c.h = (rem >> 5) & 7; c.dl = 2 * c.br; const int pl = 5 - c.dl;
    c.tokb = b * SEQ + (idx >> pl); c.n2 = idx & ((1 << pl) - 1); return c;
}
__device__ __forceinline__ void attn_load(AttnRegs& R, int U, const bf16* PA, int tid) {
    const AttnCoord c = attn_coord(U); const int ch = tid & 7, r0 = tid >> 3, jq0 = 256 * c.n2, jk0 = jq0 - 128;
    const int lane = tid & 63, w = tid >> 6, cc = lane & 15, quad = lane >> 4;
#pragma unroll
    for (int p = 0; p < 6; ++p) { const int j = jk0 + r0 + 64 * p; const bool valid = j >= 0; const int tok = c.tokb + ((valid ? j : 0) << c.dl);
        const bf16* src = PA + (size_t)tok * LDA + 512 + c.h * 64 + ch * 8;
        R.k[p] = (u32x4){0u, 0u, 0u, 0u}; R.v[p] = (u32x4){0u, 0u, 0u, 0u};
        if (valid) { R.k[p] = *(const u32x4*)src; R.v[p] = *(const u32x4*)(src + 512); } }
#pragma unroll
    for (int qa = 0; qa < 2; ++qa) { const int tok = c.tokb + ((jq0 + 32 * w + 16 * qa + cc) << c.dl);
#pragma unroll
        for (int ks = 0; ks < 2; ++ks) R.q[qa][ks] = *(const bf16x8*)(PA + (size_t)tok * LDA + c.h * 64 + ks * 32 + quad * 8); }
}
__device__ __forceinline__ void attn_store(const AttnRegs& R, LAS unsigned char* L, int tid) {
    const int ch = tid & 7, r0 = tid >> 3;
#pragma unroll
    for (int p = 0; p < 6; ++p) { *(LAS u32x4*)(L + AT_KS + (r0 + 64 * p) * 144 + ch * 16) = R.k[p]; *(LAS u32x4*)(L + AT_VS + (r0 + 64 * p) * 144 + ch * 16) = R.v[p]; }
}
__device__ __forceinline__ void attn_compute(LAS unsigned char* L, int U, const bf16x8 (&qf)[2][2], bf16* OB, float* LSE, int tid) {
    const AttnCoord cd = attn_coord(U); const int jq0 = 256 * cd.n2;
    const int lane = tid & 63, w = tid >> 6, c = lane & 15, quad = lane >> 4;
    const int kbase = 32 * w;
    f32x4 sa[10], sb[10];
#pragma unroll
    for (int t = 0; t < 10; ++t) { sa[t] = (f32x4){0.f, 0.f, 0.f, 0.f}; sb[t] = (f32x4){0.f, 0.f, 0.f, 0.f}; }
    {
        const LAS unsigned char* kp = L + AT_KS + (kbase + c) * 144 + quad * 16;
        bf16x8 kf[2][2];
#pragma unroll
        for (int ks = 0; ks < 2; ++ks) kf[0][ks] = *(const LAS bf16x8*)(kp + ks * 64);
#pragma unroll
        for (int t = 0; t < 10; ++t) {
            if (t + 1 < 10) {
#pragma unroll
                for (int ks = 0; ks < 2; ++ks) kf[(t + 1) & 1][ks] = *(const LAS bf16x8*)(kp + (16 * (t + 1)) * 144 + ks * 64); }
            __builtin_amdgcn_sched_barrier(0);
#pragma unroll
            for (int ks = 0; ks < 2; ++ks) { if (t != 9) sa[t] = MFMA16(kf[t & 1][ks], qf[0][ks], sa[t]); if (t != 0) sb[t] = MFMA16(kf[t & 1][ks], qf[1][ks], sb[t]); }
            __builtin_amdgcn_sched_barrier(0);
        }
    }
#pragma unroll
    for (int i = 0; i < 4; ++i) { const bool lo = 4 * quad + i >= c, hi = 4 * quad + i <= c;
        sa[0][i] = lo ? sa[0][i] : -3.0e38f; sa[8][i] = hi ? sa[8][i] : -3.0e38f; sb[1][i] = lo ? sb[1][i] : -3.0e38f; sb[9][i] = hi ? sb[9][i] : -3.0e38f; }
    if (cd.n2 == 0 && w < 4) {
#pragma unroll
        for (int t = 0; t < 10; ++t)
#pragma unroll
            for (int i = 0; i < 4; ++i) { const bool ex = kbase + 16 * t + 4 * quad + i >= 128; if (t != 9) sa[t][i] = ex ? sa[t][i] : -3.0e38f; if (t != 0) sb[t][i] = ex ? sb[t][i] : -3.0e38f; }
    }
    float ma = -3.0e38f, mb = -3.0e38f;
#pragma unroll
    for (int t = 0; t < 10; ++t) { if (t != 9) ma = fmaxf(fmaxf(ma, fmaxf(sa[t][0], sa[t][1])), fmaxf(sa[t][2], sa[t][3])); if (t != 0) mb = fmaxf(fmaxf(mb, fmaxf(sb[t][0], sb[t][1])), fmaxf(sb[t][2], sb[t][3])); }
    ma = pg8::max_x32(pg8::max_x16(ma)); mb = pg8::max_x32(pg8::max_x16(mb));
    float la = 0.f, lb = 0.f;
#pragma unroll
    for (int t = 0; t < 10; ++t)
#pragma unroll
        for (int i = 0; i < 4; ++i) { if (t != 9) { const float p = __builtin_amdgcn_exp2f(sa[t][i] - ma); sa[t][i] = p; la += p; } if (t != 0) { const float p = __builtin_amdgcn_exp2f(sb[t][i] - mb); sb[t][i] = p; lb += p; } }
    la = pg8::sum_x32(pg8::sum_x16(la)); lb = pg8::sum_x32(pg8::sum_x16(lb));
    f32x4 oa[4], ob[4];
#pragma unroll
    for (int dt = 0; dt < 4; ++dt) { oa[dt] = (f32x4){0.f, 0.f, 0.f, 0.f}; ob[dt] = (f32x4){0.f, 0.f, 0.f, 0.f}; }
    const LAS unsigned char* vb = L + AT_VS + (kbase + 4 * quad + (c >> 2)) * 144 + 8 * (c & 3);
#pragma unroll
    for (int kk = 0; kk < 5; ++kk) {
        u32x4 pa, pb;
        pa.x = pk2(sa[2 * kk][0], sa[2 * kk][1]); pa.y = pk2(sa[2 * kk][2], sa[2 * kk][3]); pa.z = pk2(sa[2 * kk + 1][0], sa[2 * kk + 1][1]); pa.w = pk2(sa[2 * kk + 1][2], sa[2 * kk + 1][3]);
        pb.x = pk2(sb[2 * kk][0], sb[2 * kk][1]); pb.y = pk2(sb[2 * kk][2], sb[2 * kk][3]); pb.z = pk2(sb[2 * kk + 1][0], sb[2 * kk + 1][1]); pb.w = pk2(sb[2 * kk + 1][2], sb[2 * kk + 1][3]);
        const bf16x8 pfa = __builtin_bit_cast(bf16x8, pa), pfb = __builtin_bit_cast(bf16x8, pb);
        s16x4 vl[4], vh[4];
#pragma unroll
        for (int dt = 0; dt < 4; ++dt) { vl[dt] = tr16(vb + (32 * kk) * 144 + dt * 32); vh[dt] = tr16(vb + (32 * kk + 16) * 144 + dt * 32); }
#pragma unroll
        for (int dt = 0; dt < 4; ++dt) {
            const bf16x8 vf = {vl[dt][0], vl[dt][1], vl[dt][2], vl[dt][3], vh[dt][0], vh[dt][1], vh[dt][2], vh[dt][3]};
            oa[dt] = MFMA16(vf, pfa, oa[dt]); ob[dt] = MFMA16(vf, pfb, ob[dt]);
        }
    }
    {   const float inv = 1.0f / la; const int tok = cd.tokb + ((jq0 + 32 * w + c) << cd.dl);
        bf16* orow = OB + ((size_t)cd.br * M + tok) * 512 + cd.h * 64 + ((quad & 1) ? 16 + 4 * (quad - 1) : 4 * quad);
#pragma unroll
        for (int p2 = 0; p2 < 2; ++p2) { u32x2 wa, wb; wa.x = pk2(oa[2 * p2][0] * inv, oa[2 * p2][1] * inv); wa.y = pk2(oa[2 * p2][2] * inv, oa[2 * p2][3] * inv);
            wb.x = pk2(oa[2 * p2 + 1][0] * inv, oa[2 * p2 + 1][1] * inv); wb.y = pk2(oa[2 * p2 + 1][2] * inv, oa[2 * p2 + 1][3] * inv);
            *(u32x4*)(orow + 32 * p2) = pg8::widen_pair(wa, wb, quad & 1); }
        if (quad == 0) LSE[((size_t)cd.br * M + tok) * 8 + cd.h] = (ma + __builtin_amdgcn_logf(la)) * 0.6931471805599453f; }
    {   const float inv = 1.0f / lb; const int tok = cd.tokb + ((jq0 + 32 * w + 16 + c) << cd.dl);
        bf16* orow = OB + ((size_t)cd.br * M + tok) * 512 + cd.h * 64 + ((quad & 1) ? 16 + 4 * (quad - 1) : 4 * quad);
#pragma unroll
        for (int p2 = 0; p2 < 2; ++p2) { u32x2 wa, wb; wa.x = pk2(ob[2 * p2][0] * inv, ob[2 * p2][1] * inv); wa.y = pk2(ob[2 * p2][2] * inv, ob[2 * p2][3] * inv);
            wb.x = pk2(ob[2 * p2 + 1][0] * inv, ob[2 * p2 + 1][1] * inv); wb.y = pk2(ob[2 * p2 + 1][2] * inv, ob[2 * p2 + 1][3] * inv);
            *(u32x4*)(orow + 32 * p2) = pg8::widen_pair(wa, wb, quad & 1); }
        if (quad == 0) LSE[((size_t)cd.br * M + tok) * 8 + cd.h] = (mb + __builtin_amdgcn_logf(lb)) * 0.6931471805599453f; }
}

constexpr int GL_TOT = 0, GL_KT = 2048, GL_V = GL_KT + 9216, GL_QD = GL_V + 64 * 272, GL_SSQ = GL_QD + 9216, GL_GA = GL_SSQ + 512;
struct GateRegs { f32x4 ga0, ga1; float wb[2][8]; float bias[2]; };
__device__ __forceinline__ void gate_load(GateRegs& Gt, int tok0, int h, const float* GA, const float* wa2, const float* ba, int tid) {
    const int lane = tid & 63, w = tid >> 6, c = lane & 15, quad = lane >> 4, tt = w & 3, dp = w >> 2;
    Gt.ga0 = (f32x4){0.f, 0.f, 0.f, 0.f}; Gt.ga1 = Gt.ga0;
#pragma unroll
    for (int p = 0; p < 2; ++p) { Gt.bias[p] = ba[h * 64 + 16 * (2 * dp + p) + c];
#pragma unroll
        for (int j = 0; j < 8; ++j) Gt.wb[p][j] = 0.f; }
    if (quad < 2) {
        const float* gp = GA + (size_t)(tok0 + 16 * tt + c) * 16 + 8 * quad; Gt.ga0 = *(const f32x4*)gp; Gt.ga1 = *(const f32x4*)(gp + 4);
#pragma unroll
        for (int p = 0; p < 2; ++p)
#pragma unroll
            for (int j = 0; j < 8; ++j) Gt.wb[p][j] = wa2[(8 * quad + j) * 256 + h * 64 + 16 * (2 * dp + p) + c];
    }
}
__device__ __forceinline__ void gla_gate(LAS unsigned char* L, const GateRegs& Gt, int tid, float (&la)[8]) {
    const int lane = tid & 63, w = tid >> 6, c = lane & 15, quad = lane >> 4, tt = w & 3, dp = w >> 2, seg = tid >> 6, d = tid & 63;
    u32x4 aw; aw.x = pk2(Gt.ga0[0], Gt.ga0[1]); aw.y = pk2(Gt.ga0[2], Gt.ga0[3]); aw.z = pk2(Gt.ga1[0], Gt.ga1[1]); aw.w = pk2(Gt.ga1[2], Gt.ga1[3]);
    const bf16x8 af = __builtin_bit_cast(bf16x8, aw);
    LAS float* LA = (LAS float*)(L + GL_GA);
#pragma unroll
    for (int p = 0; p < 2; ++p) {
        u32x4 bw; bw.x = pk2(Gt.wb[p][0], Gt.wb[p][1]); bw.y = pk2(Gt.wb[p][2], Gt.wb[p][3]); bw.z = pk2(Gt.wb[p][4], Gt.wb[p][5]); bw.w = pk2(Gt.wb[p][6], Gt.wb[p][7]);
        const f32x4 z4 = MFMA16(af, __builtin_bit_cast(bf16x8, bw), ((f32x4){0.f, 0.f, 0.f, 0.f}));
        float s4 = 0.f;
#pragma unroll
        for (int i = 0; i < 4; ++i) { const float z = z4[i] + Gt.bias[p]; const float lv = (fminf(z, 0.f) - __logf(1.0f + __expf(-fabsf(z)))) * (1.0f / 16.0f);
            LA[(16 * tt + 4 * quad + i) * 65 + 16 * (2 * dp + p) + c] = lv; s4 += lv; }
        const float s8 = pg8::sum_x16(s4);
        if ((quad & 1) == 0) ((LAS float*)(L + GL_TOT))[(2 * tt + (quad >> 1)) * 64 + 16 * (2 * dp + p) + c] = s8;
    }
    __syncthreads();
#pragma unroll
    for (int i = 0; i < 8; ++i) la[i] = LA[(8 * seg + i) * 65 + d];
}
__device__ __forceinline__ void gla_gate_prefix(LAS unsigned char* L, const GateRegs& Gt, int tid, float (&bb)[8], float& blast) {
    const int seg = tid >> 6, d = tid & 63;
    float la[8]; gla_gate(L, Gt, tid, la);
    const LAS float* tot = (const LAS float*)(L + GL_TOT);
    float off = 0.f, all = 0.f;
#pragma unroll
    for (int sgi = 0; sgi < 8; ++sgi) { const float v = tot[sgi * 64 + d]; all += v; off += (sgi < seg) ? v : 0.f; }
    float run = off;
#pragma unroll
    for (int i = 0; i < 8; ++i) { run += la[i]; bb[i] = run; }
    blast = all;
}
__device__ __forceinline__ void gla_prefix(LAS unsigned char* L, const float (&la)[8], int tid, float (&bb)[8], float& blast) {
    const int seg = tid >> 6, d = tid & 63; float run = 0.f;
#pragma unroll
    for (int i = 0; i < 8; ++i) { run += la[i]; bb[i] = run; }
    LAS float* tot = (LAS float*)(L + GL_TOT);
    tot[seg * 64 + d] = run;
    __syncthreads();
    float off = 0.f, all = 0.f;
#pragma unroll
    for (int s = 0; s < 8; ++s) { const float v = tot[s * 64 + d]; all += v; off += (s < seg) ? v : 0.f; }
#pragma unroll
    for (int i = 0; i < 8; ++i) bb[i] += off;
    blast = all;
}
__device__ __forceinline__ int gla_first_unit(int G) { if ((G & 7) == 0) { const int n = (int)blockIdx.x >> 3; return n < 128 ? ((int)blockIdx.x & 7) * 128 + n : 1024; } return (int)blockIdx.x; }
__device__ __forceinline__ int gla_next_unit(int unit, int G) { if ((G & 7) == 0) { const int st = G >> 3; return ((unit & 127) + st < 128) ? unit + st : 1024; } return unit + G; }
struct GlaURegs { unsigned short kr[8]; u32x4 vr[2]; GateRegs gt; };
__device__ __forceinline__ void gla_u_load(GlaURegs& R, int unit, const bf16* PG, const float* GA, const float* wa2, const float* ba, int tid) {
    const int bh = unit >> 7, n = unit & 127, b = bh >> 2, h = bh & 3, tok0 = b * SEQ + 64 * n, seg = tid >> 6, d = tid & 63;
#pragma unroll
    for (int i = 0; i < 8; ++i) { const bf16* rp = PG + (size_t)(tok0 + 8 * seg + i) * LDG + h * 64 + d; R.kr[i] = rp[256]; }
#pragma unroll
    for (int p = 0; p < 2; ++p) { const int id = tid + 512 * p; R.vr[p] = *(const u32x4*)(PG + (size_t)(tok0 + (id >> 4)) * LDG + 512 + h * 128 + (id & 15) * 8); }
    gate_load(R.gt, tok0, h, GA, wa2, ba, tid);
}
__device__ __forceinline__ void gla_u_phase(LAS unsigned char* L, const bf16* PG, const float* GA, const float* wa2, const float* ba, bf16* UT, float* DEC, int tid, int G) {
    const int lane = tid & 63, w = tid >> 6, c = lane & 15, quad = lane >> 4, seg = tid >> 6, d = tid & 63;
    int unit = gla_first_unit(G);
    GlaURegs R;
    if (unit < 1024) gla_u_load(R, unit, PG, GA, wa2, ba, tid);
    while (unit < 1024) {
        float bb[8], blast; gla_gate_prefix(L, R.gt, tid, bb, blast);
        { float kv[8];
#pragma unroll
          for (int i = 0; i < 8; ++i) kv[i] = bf2f(R.kr[i]) * __expf(blast - bb[i]);
          u32x4 wv; wv.x = pk2(kv[0], kv[1]); wv.y = pk2(kv[2], kv[3]); wv.z = pk2(kv[4], kv[5]); wv.w = pk2(kv[6], kv[7]);
          *(LAS u32x4*)(L + GL_KT + d * 144 + seg * 16) = wv;
          if (seg == 0) DEC[(size_t)unit * 64 + d] = __expf(blast); }
#pragma unroll
        for (int p = 0; p < 2; ++p) { const int id = tid + 512 * p; *(LAS u32x4*)(L + GL_V + (id >> 4) * 272 + (id & 15) * 16) = R.vr[p]; }
        __syncthreads();
        const int nu = gla_next_unit(unit, G);
        if (nu < 1024) gla_u_load(R, nu, PG, GA, wa2, ba, tid);
        f32x4 acc[4];
#pragma unroll
        for (int dt = 0; dt < 4; ++dt) acc[dt] = (f32x4){0.f, 0.f, 0.f, 0.f};
#pragma unroll
        for (int ks = 0; ks < 2; ++ks) {
            const LAS unsigned char* vp = L + GL_V + (32 * ks + 8 * quad + (c >> 2)) * 272 + (16 * w) * 2 + 8 * (c & 3);
            const s16x4 lo = tr16(vp), hi = tr16(vp + 4 * 272);
            const bf16x8 af = {lo[0], lo[1], lo[2], lo[3], hi[0], hi[1], hi[2], hi[3]};
#pragma unroll
            for (int dt = 0; dt < 4; ++dt) { const bf16x8 bfr = *(const LAS bf16x8*)(L + GL_KT + (16 * dt + c) * 144 + ks * 64 + quad * 16); acc[dt] = MFMA16(af, bfr, acc[dt]); } }
        bf16* up = UT + ((size_t)unit * 128 + 16 * w + 4 * quad) * 64 + c;
#pragma unroll
        for (int dt = 0; dt < 4; ++dt)
#pragma unroll
            for (int i = 0; i < 4; ++i) up[i * 64 + 16 * dt] = f2bf(acc[dt][i]);
        __syncthreads();
        unit = nu;
    }
}
struct GlaORegs { unsigned short qr[8], kr[8]; u32x4 vr[2]; GateRegs gt; };
__device__ __forceinline__ void gla_o_load(GlaORegs& R, int unit, const bf16* PG, const float* GA, const float* wa2, const float* ba, int tid) {
    const int bh = unit >> 7, n = unit & 127, b = bh >> 2, h = bh & 3, tok0 = b * SEQ + 64 * n, seg = tid >> 6, d = tid & 63;
#pragma unroll
    for (int i = 0; i < 8; ++i) { const bf16* rp = PG + (size_t)(tok0 + 8 * seg + i) * LDG + h * 64 + d; R.qr[i] = rp[0]; R.kr[i] = rp[256]; }
#pragma unroll
    for (int p = 0; p < 2; ++p) { const int id = tid + 512 * p; R.vr[p] = *(const u32x4*)(PG + (size_t)(tok0 + (id >> 4)) * LDG + 512 + h * 128 + (id & 15) * 8); }
    gate_load(R.gt, tok0, h, GA, wa2, ba, tid);
}
__device__ __forceinline__ void gla_o_phase(LAS unsigned char* L, const bf16* PG, const float* GA, const float* wa2, const float* ba, const bf16* ST, const float* ggla, bf16* OM, int tid, int G) {
    const int lane = tid & 63, w = tid >> 6, c = lane & 15, quad = lane >> 4, seg = tid >> 6, d = tid & 63;
    const int it = w & 3, eh = w >> 2, itok = 16 * it + c;
    int unit = gla_first_unit(G);
    GlaORegs R;
    if (unit < 1024) gla_o_load(R, unit, PG, GA, wa2, ba, tid);
    while (unit < 1024) {
        const int bh = unit >> 7, n = unit & 127, b = bh >> 2, h = bh & 3, tok0 = b * SEQ + 64 * n;
        const size_t trow = (size_t)(tok0 + itok);
        bf16x8 sf[4][2]; u32x2 rv[4]; f32x4 gg[4];
#pragma unroll
        for (int e4 = 0; e4 < 4; ++e4) { const int et = 4 * eh + e4;
#pragma unroll
            for (int ks = 0; ks < 2; ++ks) sf[e4][ks] = *(const bf16x8*)(ST + ((size_t)unit * 128 + 16 * et + c) * 64 + 32 * ks + 8 * quad);
            rv[e4] = *(const u32x2*)(PG + trow * LDG + 1024 + h * 128 + 16 * et + 4 * quad); gg[e4] = *(const f32x4*)(ggla + h * 128 + 16 * et + 4 * quad); }
        float bb[8], blast; gla_gate_prefix(L, R.gt, tid, bb, blast);
#pragma unroll
        for (int i = 0; i < 8; ++i) { const int t = 8 * seg + i;
            const float qv = bf2f(R.qr[i]) * 0.125f * __expf(bb[i]), kv = bf2f(R.kr[i]) * __expf(-bb[i]);
            *(LAS unsigned short*)(L + GL_QD + t * 144 + d * 2) = f2bf(qv); *(LAS unsigned short*)(L + GL_KT + t * 144 + d * 2) = f2bf(kv); }
#pragma unroll
        for (int p = 0; p < 2; ++p) { const int id = tid + 512 * p; *(LAS u32x4*)(L + GL_V + (id >> 4) * 272 + (id & 15) * 16) = R.vr[p]; }
        __syncthreads();
        const int nu = gla_next_unit(unit, G);
        if (nu < 1024) gla_o_load(R, nu, PG, GA, wa2, ba, tid);
        bf16x8 qf[2];
#pragma unroll
        for (int ks = 0; ks < 2; ++ks) qf[ks] = *(const LAS bf16x8*)(L + GL_QD + itok * 144 + ks * 64 + quad * 16);
        f32x4 at[4];
#pragma unroll
        for (int jt = 0; jt < 4; ++jt) { at[jt] = (f32x4){0.f, 0.f, 0.f, 0.f};
#pragma unroll
            for (int ks = 0; ks < 2; ++ks) { const bf16x8 kf = *(const LAS bf16x8*)(L + GL_KT + (16 * jt + c) * 144 + ks * 64 + quad * 16); at[jt] = MFMA16(kf, qf[ks], at[jt]); }
#pragma unroll
            for (int i = 0; i < 4; ++i) at[jt][i] = (16 * jt + 4 * quad + i <= itok) ? at[jt][i] : 0.f; }
        bf16x8 pf[2];
#pragma unroll
        for (int kk = 0; kk < 2; ++kk) { u32x4 pw; pw.x = pk2(at[2 * kk][0], at[2 * kk][1]); pw.y = pk2(at[2 * kk][2], at[2 * kk][3]); pw.z = pk2(at[2 * kk + 1][0], at[2 * kk + 1][1]); pw.w = pk2(at[2 * kk + 1][2], at[2 * kk + 1][3]);
            pf[kk] = __builtin_bit_cast(bf16x8, pw); }
        f32x4 o[4]; float ssq = 0.f;
        const LAS unsigned char* vb = L + GL_V + (4 * quad + (c >> 2)) * 272 + 8 * (c & 3);
#pragma unroll
        for (int e4 = 0; e4 < 4; ++e4) { const int et = 4 * eh + e4; f32x4 acc = {0.f, 0.f, 0.f, 0.f};
#pragma unroll
            for (int kk = 0; kk < 2; ++kk) { const s16x4 lo = tr16(vb + (32 * kk) * 272 + et * 32), hi = tr16(vb + (32 * kk + 16) * 272 + et * 32);
                const bf16x8 vf = {lo[0], lo[1], lo[2], lo[3], hi[0], hi[1], hi[2], hi[3]};
                acc = MFMA16(vf, pf[kk], acc); }
#pragma unroll
            for (int ks = 0; ks < 2; ++ks) acc = MFMA16(sf[e4][ks], qf[ks], acc);
            o[e4] = acc; ssq += (acc[0] * acc[0] + acc[1] * acc[1]) + (acc[2] * acc[2] + acc[3] * acc[3]); }
        ssq = pg8::sum_x32(pg8::sum_x16(ssq));
        LAS float* SSQ = (LAS float*)(L + GL_SSQ);
        if (quad == 0) SSQ[eh * 64 + itok] = ssq;
        __syncthreads();
        const float rstd = __builtin_amdgcn_rsqf((SSQ[itok] + SSQ[64 + itok]) * (1.0f / 128.0f) + EPS);
        u32x2 wv4[4];
#pragma unroll
        for (int e4 = 0; e4 < 4; ++e4) { const f32x4 g = gg[e4];
            const float r0 = __uint_as_float(rv[e4].x << 16), r1 = __uint_as_float(rv[e4].x & 0xffff0000u), r2 = __uint_as_float(rv[e4].y << 16), r3 = __uint_as_float(rv[e4].y & 0xffff0000u);
            wv4[e4].x = pk2(o[e4][0] * rstd * g[0] * pg8::silu_f(r0), o[e4][1] * rstd * g[1] * pg8::silu_f(r1)); wv4[e4].y = pk2(o[e4][2] * rstd * g[2] * pg8::silu_f(r2), o[e4][3] * rstd * g[3] * pg8::silu_f(r3)); }
        { bf16* orow = OM + trow * D + h * 128 + 64 * eh + ((quad & 1) ? 16 + 4 * (quad - 1) : 4 * quad);
#pragma unroll
          for (int p2 = 0; p2 < 2; ++p2) *(u32x4*)(orow + 32 * p2) = pg8::widen_pair(wv4[2 * p2], wv4[2 * p2 + 1], quad & 1); }
        __syncthreads();
        unit = nu;
    }
}

#define XB_TMO      128
#define XB_XCNT(j)  (256  + 64 * (j))
#define XB_XSUB(j)  (1280 + 64 * (j))
#define XB_XGEN(j)  (2304 + 64 * (j))
#define XB_TOP      3328
#define XB_TOPGEN   3392
#define XCD_BAR_WORDS 3456
#define XB_SPIN_CAP (1u << 18)

__device__ __forceinline__ unsigned xb_ld(unsigned* p)              { return __hip_atomic_load(p, __ATOMIC_RELAXED, __HIP_MEMORY_SCOPE_AGENT); }
__device__ __forceinline__ unsigned xb_add(unsigned* p, unsigned v) { return __hip_atomic_fetch_add(p, v, __ATOMIC_RELAXED, __HIP_MEMORY_SCOPE_AGENT); }
__device__ __forceinline__ unsigned xb_xcc_id() { return (unsigned)__builtin_amdgcn_s_getreg((3 << 11) | 20) & 0xFu; }
#define XB_SPIN(cond, bar) do { unsigned _sp = 0; while (cond) { __builtin_amdgcn_s_sleep(1); \
    if ((++_sp & 255u) == 0u) { if (xb_ld(&(bar)[XB_TMO])) break; if (_sp > XB_SPIN_CAP) { atomicAdd(&(bar)[XB_TMO], 1u); break; } } } } while (0)

struct XcdBarrier {
    unsigned* bar; unsigned x;
    volatile LAS unsigned* st;
};

__device__ __forceinline__ XcdBarrier xcd_barrier_post(unsigned* bar, volatile LAS unsigned* st) {
    XcdBarrier b; b.bar = bar; b.x = xb_xcc_id(); b.st = st;
    if (threadIdx.x == 0) (void)xb_add(&bar[XB_XCNT(b.x)], 1u);
    return b;
}
__device__ __forceinline__ void xcd_barrier_complete(unsigned* bar, unsigned x, unsigned& nloc, unsigned& nx) {
    const unsigned G = gridDim.x * gridDim.y * gridDim.z;
    unsigned sum, cnt, mine, sp = 0u;
    for (;;) {
        sum = 0u; cnt = 0u; mine = 0u;
#pragma unroll
        for (unsigned j = 0; j < 16; ++j) { const unsigned c = xb_ld(&bar[XB_XCNT(j)]); sum += c; cnt += (c > 0u) ? 1u : 0u; mine = (j == x) ? c : mine; }
        if (sum == G) break;
        __builtin_amdgcn_s_sleep(1);
        if ((++sp & 255u) == 0u) { if (xb_ld(&bar[XB_TMO])) break; if (sp > XB_SPIN_CAP) { atomicAdd(&bar[XB_TMO], 1u); break; } }
    }
    nloc = mine > 0u ? mine : 1u; nx = cnt > 0u ? cnt : 1u;
}

__device__ __forceinline__ void xcd_barrier(const XcdBarrier& b) {
    asm volatile("s_waitcnt vmcnt(0)" ::: "memory");
    __syncthreads();
    if (threadIdx.x == 0) {
        unsigned* bar = b.bar;
        __builtin_amdgcn_s_waitcnt(0);
        unsigned nloc = b.st[0], nx = b.st[1];
        if (nloc == 0u) { xcd_barrier_complete(bar, b.x, nloc, nx); b.st[0] = nloc; b.st[1] = nx; }
        const unsigned old = xb_add(&bar[XB_XSUB(b.x)], 1u);
        const unsigned gen = old / nloc;
        if (old + 1u == (gen + 1u) * nloc) {
            __builtin_amdgcn_fence(__ATOMIC_RELEASE, "agent");
            asm volatile("s_waitcnt vmcnt(0)" ::: "memory");
            const unsigned og = xb_add(&bar[XB_TOP], 1u);
            const unsigned tg = og / nx;
            if (og + 1u == (tg + 1u) * nx) xb_add(&bar[XB_TOPGEN], 1u);
            else XB_SPIN(xb_ld(&bar[XB_TOPGEN]) == tg, bar);
            __builtin_amdgcn_fence(__ATOMIC_ACQUIRE, "agent");
            xb_add(&bar[XB_XGEN(b.x)], 1u);
            asm volatile("s_waitcnt vmcnt(0)" ::: "memory");
        } else {
            XB_SPIN(xb_ld(&bar[XB_XGEN(b.x)]) == gen, bar);
            __builtin_amdgcn_fence(__ATOMIC_ACQUIRE, "agent");
            asm volatile("s_waitcnt vmcnt(0)" ::: "memory");
        }
    }
    __syncthreads();
}

constexpr unsigned ATT_END = 0xffffffffu;
__device__ __forceinline__ unsigned attn_unit_of(unsigned q, unsigned t) {
    const unsigned bh = 2u * q + t / 96u, wi = t % 96u, c4 = wi / 48u, w48 = wi % 48u;
    unsigned br, idx;
    if (w48 < 16u) { br = 2u; idx = (w48 << 1) | c4; }
    else { const unsigned w32 = w48 - 16u, c1 = w32 >> 3, w8 = w32 & 7u;
        if (w8 < 4u) { br = 1u; idx = (w8 << 3) | (4u * c4 + c1); } else { br = 0u; idx = 16u * c4 + 4u * c1 + (w8 - 4u); } }
    return br * 512u + bh * 32u + idx;
}
__device__ __forceinline__ unsigned attn_draw(unsigned* qctr, unsigned x0, volatile LAS unsigned* qoffp) {
    unsigned qoff = *qoffp;
    while (qoff < 8u) { const unsigned q = (x0 + qoff) & 7u, t = atomicAdd(qctr + 64u * q, 1u); if (t < 192u) { *qoffp = qoff; return attn_unit_of(q, t); } ++qoff; }
    *qoffp = qoff; return ATT_END;
}
__global__ void __launch_bounds__(NTHR, 2) layer_fwd(Args a) {
    extern __shared__ __attribute__((aligned(16))) unsigned char lds_raw[];
    cg::grid_group grid = cg::this_grid();
    LAS unsigned char* lds = (LAS unsigned char*)lds_raw;
    const int tid = threadIdx.x, lane = tid & 63, wave = __builtin_amdgcn_readfirstlane(tid >> 6);
    const int G = gridDim.x;
    unsigned char* ws = a.ws;
    bf16* XN = (bf16*)(ws + WS_XN); bf16* HB = (bf16*)(ws + WS_H); bf16* PG = (bf16*)(ws + WS_PG); bf16* PA = (bf16*)(ws + WS_PA); bf16* OM = (bf16*)(ws + WS_OM); bf16* OB = (bf16*)(ws + WS_OB);
    bf16* ST = (bf16*)(ws + WS_ST); bf16* UT = (bf16*)a.out;     float* DEC = (float*)(ws + WS_DEC); float* LSE = (float*)(ws + WS_LSE); float* CS = (float*)(ws + WS_CS);
    float* GA = (float*)(ws + WS_GA); float* SS0 = (float*)(ws + WS_SS0); float* SS1 = (float*)(ws + WS_SS1); float* SS2 = (float*)(ws + WS_SS2);
    unsigned* CTR = (unsigned*)(ws + WS_CTL);
    if (tid < 32) ((LAS unsigned*)(lds + MISC_OFF))[tid] = 0u;
    __syncthreads();
    if (a.use_cg_sync) grid.sync();
    const XcdBarrier bar = xcd_barrier_post((unsigned*)(ws + WS_BAR), (volatile LAS unsigned*)(lds + MISC_OFF) + 8);
    unsigned long long ts0 = 0, ts1 = 0; STAMP(0);

    p0_xn(a, lane, wave);
    conv_items(a, lds, IT_W13A, IT_W2A, blockIdx.x * NWAVES + wave, G * NWAVES, lane, wave);
    GSYNC(); STAMP(1);
    { pg8::Gemm g{XN, (const bf16*)(ws + WS_W13A), M, NUP, D}; pg8::StaticOrder S; S.init(M, NUP, G, (int)blockIdx.x);
      pg8::EpiSwiglu E{HB, FF, SS0};
      for (int rp = 0; rp < REP_UP; ++rp) pg8::gemm_phase<pg8::EpiSwiglu, pg8::StaticOrder, true, true>(lds, g, S, E); }
    { int li, nl; light_wg((M / 256) * (NUP / 256), G, li, nl);
      if (li >= 0) { p0_cs(a, li * NTHR + tid, nl * NTHR); conv_items(a, lds, IT_W2A, IT_W13B, li * NWAVES + wave, nl * NWAVES, lane, wave); gate_cols(a, li * NTHR + tid, nl * NTHR); } }
    GSYNC(); STAMP(2);
    { pg8::Gemm g{HB, (const bf16*)(ws + WS_W2A), M, D, FF}; pg8::StaticOrder S; S.init(M, D, G, (int)blockIdx.x);
      pg8::EpiResidB<true> E{XN, XN, SS1, 0.5f, D};
      pg8::gemm_phase<pg8::EpiResidB<true>, pg8::StaticOrder, true, true>(lds, g, S, E); }
    GSYNC(); STAMP(3);
    { pg8::Gemm g{XN, (const bf16*)(ws + WS_WIN), M, NIN, D}; pg8::StaticOrder S; S.init(M, NIN, G, (int)blockIdx.x);
      pg8::EpiProj E{PG, PA, SS1, CS};
      ga_job(lds, XN, (const bf16*)(ws + WS_WGA), SS1, GA, tid, G);
      for (int rp = 0; rp < REP_IN; ++rp) pg8::gemm_phase<pg8::EpiProj, pg8::StaticOrder, true, true>(lds, g, S, E); }
    GSYNC(); STAMP(4);
    for (int rp = 0; rp < REP_MIX; ++rp) {
    gla_u_phase(lds, PG, GA, a.wa2, a.ba, UT, DEC, tid, G);
    GSYNC(); STAMP(5);
    const bool xal = (G & 7) == 0; const int sstep = xal ? (G >> 3) : G, slim = xal ? 64 : 512, sbase = xal ? ((int)blockIdx.x & 7) * 64 : 0;
    for (int sl0 = xal ? ((int)blockIdx.x >> 3) : (int)blockIdx.x; sl0 < slim; sl0 += 2 * sstep) {
        const int sg = tid >> 7, cl = tid & 127;
        float uu[2][32], dd[2][32]; bf16* sp[2];
#pragma unroll
        for (int j = 0; j < 2; ++j) {
            const int set = sbase + ((sl0 + j * sstep < slim) ? sl0 + j * sstep : sl0);
            const int gcol = set * 128 + cl, bh = gcol >> 13, ed = gcol & 8191, d = ed & 63;
            const bf16* up = UT + ((size_t)bh * 128 + 32 * sg) * 8192 + ed; const float* dp = DEC + ((size_t)bh * 128 + 32 * sg) * 64 + d; sp[j] = ST + ((size_t)bh * 128 + 32 * sg) * 8192 + ed;
#pragma unroll
            for (int k = 0; k < 32; ++k) { uu[j][k] = bf2f(up[(size_t)k * 8192]); dd[j][k] = dp[k * 64]; }
        }
        LAS f32x2* agg = (LAS f32x2*)lds;
#pragma unroll
        for (int j = 0; j < 2; ++j) { float S = 0.f, P = 1.f;
#pragma unroll
            for (int k = 0; k < 32; ++k) { S = dd[j][k] * S + uu[j][k]; P *= dd[j][k]; }
            agg[(j * 4 + sg) * 128 + cl] = (f32x2){P, S}; }
        __syncthreads();
#pragma unroll
        for (int j = 0; j < 2; ++j) { float st = 0.f;
#pragma unroll
            for (int q = 0; q < 3; ++q) { const f32x2 ag = agg[(j * 4 + q) * 128 + cl]; if (q < sg) st = ag.x * st + ag.y; }
#pragma unroll
            for (int k = 0; k < 32; ++k) { sp[j][(size_t)k * 8192] = f2bf(st); st = dd[j][k] * st + uu[j][k]; } }
        __syncthreads();
    }
    {
        volatile LAS unsigned* nxt = (volatile LAS unsigned*)(lds + MISC_OFF);
        constexpr unsigned NCONV = (IT_W2B - IT_W13B) / 8;
        for (;;) {
            if (tid == 0) nxt[0] = atomicAdd(CTR + 64 * rp, 1u);
            __syncthreads();
            const unsigned t = nxt[0];
            __syncthreads();
            if (t >= NCONV) break;
            const int lo = IT_W13B + 8 * (int)t;
            conv_items(a, lds, lo, lo + 8, wave, NWAVES, lane, wave);
        }
        unsigned* qctr = CTR + 64 * (2 + 8 * rp); const unsigned x0 = bar.x & 7u;
        if (tid == 0) { nxt[4] = 0u; nxt[0] = attn_draw(qctr, x0, nxt + 4); nxt[1] = attn_draw(qctr, x0, nxt + 4); }
        __syncthreads();
        unsigned u = nxt[0], un = nxt[1];
        AttnRegs R;
        if (u != ATT_END) attn_load(R, (int)u, PA, tid);
        while (u != ATT_END) {
            attn_store(R, lds, tid);
            bf16x8 qf[2][2];
#pragma unroll
            for (int qa = 0; qa < 2; ++qa)
#pragma unroll
                for (int ks = 0; ks < 2; ++ks) qf[qa][ks] = R.q[qa][ks];
            unsigned tk = 0u;
            if (tid == 0) tk = attn_draw(qctr, x0, nxt + 4);
            __syncthreads();
            if (un != ATT_END) attn_load(R, (int)un, PA, tid);
            attn_compute(lds, (int)u, qf, OB, LSE, tid);
            if (tid == 0) nxt[2] = tk;
            __syncthreads();
            u = un; un = nxt[2];
        }
    }
    GSYNC(); STAMP(6);
    }
    for (int rp = 0; rp < REP_MIXC; ++rp) {
    gla_o_phase(lds, PG, GA, a.wa2, a.ba, ST, a.ggla, OM, tid, G);
    {
        const f32x4 g0 = *(const f32x4*)(a.gatt + 8 * lane), g1 = *(const f32x4*)(a.gatt + 8 * lane + 4);
        const int hh = lane >> 3;
        for (int tk0 = (blockIdx.x * NWAVES + wave) * 4; tk0 < M; tk0 += G * NWAVES * 4) {
            float ls[4][3]; u32x4 vv[4][3];
#pragma unroll
            for (int q = 0; q < 4; ++q)
#pragma unroll
                for (int r = 0; r < 3; ++r) { ls[q][r] = LSE[((size_t)r * M + tk0 + q) * 8 + hh]; vv[q][r] = *(const u32x4*)(OB + ((size_t)r * M + tk0 + q) * 512 + 8 * lane); }
#pragma unroll
            for (int q = 0; q < 4; ++q) {
                const float mx = fmaxf(ls[q][0], fmaxf(ls[q][1], ls[q][2])); float w0 = __expf(ls[q][0] - mx), w1 = __expf(ls[q][1] - mx), w2 = __expf(ls[q][2] - mx); const float iw = 1.0f / (w0 + w1 + w2); w0 *= iw; w1 *= iw; w2 *= iw;
                float o[8]; float ssq = 0.f;
#pragma unroll
                for (int i = 0; i < 4; ++i) {
                    o[2 * i] = w0 * __uint_as_float(vv[q][0][i] << 16) + w1 * __uint_as_float(vv[q][1][i] << 16) + w2 * __uint_as_float(vv[q][2][i] << 16);
                    o[2 * i + 1] = w0 * __uint_as_float(vv[q][0][i] & 0xffff0000u) + w1 * __uint_as_float(vv[q][1][i] & 0xffff0000u) + w2 * __uint_as_float(vv[q][2][i] & 0xffff0000u);
                    ssq += o[2 * i] * o[2 * i] + o[2 * i + 1] * o[2 * i + 1]; }
                ssq = wave_sum(ssq);
                const float rstd = __builtin_amdgcn_rsqf(ssq * (1.0f / 512.0f) + EPS);
                u32x4 wv; wv.x = pk2(o[0] * rstd * g0[0], o[1] * rstd * g0[1]); wv.y = pk2(o[2] * rstd * g0[2], o[3] * rstd * g0[3]); wv.z = pk2(o[4] * rstd * g1[0], o[5] * rstd * g1[1]); wv.w = pk2(o[6] * rstd * g1[2], o[7] * rstd * g1[3]);
                *(u32x4*)(OM + (size_t)(tk0 + q) * D + 512 + 8 * lane) = wv;
            }
        }
    }
    GSYNC(); STAMP(7);
    }
    { pg8::Gemm g{OM, (const bf16*)(ws + WS_WOUT), M, D, D}; pg8::StaticOrder S; S.init(M, D, G, (int)blockIdx.x);
      pg8::EpiResidB<true> E{XN, XN, SS2, 1.0f, D};
      pg8::gemm_phase<pg8::EpiResidB<true>, pg8::StaticOrder, true, true>(lds, g, S, E); }
    GSYNC(); STAMP(8);
    { pg8::Gemm g{XN, (const bf16*)(ws + WS_W13B), M, NUP, D}; pg8::StaticOrder S; S.init(M, NUP, G, (int)blockIdx.x);
      pg8::EpiSwiglu E{HB, FF, SS2};
      pg8::gemm_phase<pg8::EpiSwiglu, pg8::StaticOrder, true, true>(lds, g, S, E); }
    { int li, nl; light_wg((M / 256) * (NUP / 256), G, li, nl);
      if (li >= 0) conv_items(a, lds, IT_W2B, IT_END, li * NWAVES + wave, nl * NWAVES, lane, wave); }
    GSYNC(); STAMP(9);
    if (G == (M / 256) * (D / 256)) {
        pg8::Gemm g{HB, (const bf16*)(ws + WS_W2B), M, D, FF}; pg8::StaticOrder S; S.init(M, D, G, (int)blockIdx.x);
        pg8::EpiFinal E{XN, a.out, (float*)(ws + WS_SS3), (unsigned*)(ws + WS_PCNT), a.gf, 0.5f, D, 32u};
        pg8::gemm_phase<pg8::EpiFinal, pg8::StaticOrder, true, true>(lds, g, S, E);
    } else {
        { pg8::Gemm g{HB, (const bf16*)(ws + WS_W2B), M, D, FF}; pg8::StaticOrder S; S.init(M, D, G, (int)blockIdx.x);
          pg8::EpiResidF E{XN, a.out, 0.5f, D};
          pg8::gemm_phase<pg8::EpiResidF, pg8::StaticOrder, true, true>(lds, g, S, E); }
        GSYNC(); STAMP(10);
        for (int m = blockIdx.x * NWAVES + wave; m < M; m += G * NWAVES) {
            f32x4* xr = (f32x4*)(a.out + (size_t)m * D) + lane; f32x4 v[4]; float s = 0.f;
#pragma unroll
            for (int j = 0; j < 4; ++j) { v[j] = xr[64 * j]; s += (v[j][0] * v[j][0] + v[j][1] * v[j][1]) + (v[j][2] * v[j][2] + v[j][3] * v[j][3]); }
            const float rstd = __builtin_amdgcn_rsqf(wave_sum(s) * (1.0f / 1024.0f) + EPS);
#pragma unroll
            for (int j = 0; j < 4; ++j) { const f32x4 g = *((const f32x4*)a.gf + lane + 64 * j); xr[64 * j] = v[j] * rstd * g; }
        }
    }
    if (PROBE_PH >= 0) {
        STAMP(10);
        if (blockIdx.x == 0) { const unsigned long long dt = (ts1 - ts0) * 4ull, t0 = __builtin_amdgcn_s_memrealtime(); while (__builtin_amdgcn_s_memrealtime() - t0 < dt) __builtin_amdgcn_s_sleep(8); }
    }
}

extern "C" void kernel_launch(void* const* d_in, const int* in_sizes, int n_in, void* d_out, int out_size, void* d_ws, size_t ws_size, hipStream_t stream) {
    static int grid = 0;
    if (grid == 0) {
        if (n_in != 18 || in_sizes[0] != M * D || out_size != M * D || ws_size < WS_END) { fprintf(stderr, "kernel_launch: unexpected shapes (n_in %d, in0 %d, out %d, ws %zu)\n", n_in, n_in > 0 ? in_sizes[0] : -1, out_size, ws_size); grid = -1; return; }
        int dev = 0, cus = 0, per_cu = 0;
        if (hipGetDevice(&dev) != hipSuccess || hipDeviceGetAttribute(&cus, hipDeviceAttributeMultiprocessorCount, dev) != hipSuccess) { grid = -1; return; }
        if (hipFuncSetAttribute((const void*)layer_fwd, hipFuncAttributeMaxDynamicSharedMemorySize, LDS_BYTES) != hipSuccess) { fprintf(stderr, "kernel_launch: hipFuncSetAttribute failed\n"); grid = -1; return; }
        if (hipOccupancyMaxActiveBlocksPerMultiprocessor(&per_cu, (const void*)layer_fwd, NTHR, LDS_BYTES) != hipSuccess || per_cu < 1) { fprintf(stderr, "kernel_launch: occupancy query gave %d\n", per_cu); per_cu = 1; }
        (void)hipGetLastError();
        grid = cus * per_cu;
    }
    if (grid < 0) return;
    (void)hipMemsetAsync((char*)d_ws + WS_CTL, 0, CTL_ZERO_BYTES, stream);
    Args a{};
    a.x = (const float*)d_in[0]; a.pos = (const int*)d_in[1]; a.g1 = (const float*)d_in[2]; a.w1a = (const float*)d_in[3]; a.w3a = (const float*)d_in[4]; a.w2a = (const float*)d_in[5];
    a.gm = (const float*)d_in[6]; a.win = (const float*)d_in[7]; a.wa2 = (const float*)d_in[8]; a.ba = (const float*)d_in[9]; a.ggla = (const float*)d_in[10]; a.gatt = (const float*)d_in[11];
    a.wout = (const float*)d_in[12]; a.g2 = (const float*)d_in[13]; a.w1b = (const float*)d_in[14]; a.w3b = (const float*)d_in[15]; a.w2b = (const float*)d_in[16]; a.gf = (const float*)d_in[17];
    a.out = (float*)d_out; a.ws = (unsigned char*)d_ws;
    void* args[] = {&a};
    const hipError_t e = hipLaunchCooperativeKernel((const void*)layer_fwd, dim3(grid), dim3(NTHR), args, LDS_BYTES, stream);
    if (e != hipSuccess) fprintf(stderr, "kernel_launch: cooperative launch failed: %s (grid %d)\n", hipGetErrorString(e), grid);
}
```

```cpp
#include <hip/hip_runtime.h>
#include <hip/hip_cooperative_groups.h>
#include <cstdio>
#include <cstdint>
namespace cg = cooperative_groups;
namespace pg8 {
#define PG8_LAS __attribute__((address_space(3)))
typedef unsigned short bf16_t;
typedef short bf16x8 __attribute__((ext_vector_type(8)));
typedef float f32x4 __attribute__((ext_vector_type(4)));
typedef unsigned u32x4 __attribute__((ext_vector_type(4)));
constexpr int BM = 256, BK = 64, HALF = 128, HTB = HALF * BK * 2  , STAGE_BYTES = 8 * HTB, NXCD = 8, WGM = 8;

__host__ __device__ __forceinline__ int lds_byte(int r, int c) { const int st = (r >> 4) * 2 + (c >> 5), rr = r & 15, cc = c & 31, ob = rr * 64 + cc * 2; return st * 1024 + (ob ^ (((ob >> 9) & 1) << 5)); }
__host__ __device__ __forceinline__ void stage_rc(int b, int& R, int& C) { const int st = b / 1024, sb = b % 1024, swz = sb ^ (((sb >> 9) & 1) << 5); R = (st >> 1) * 16 + swz / 64; C = (st & 1) * 32 + (swz % 64) / 2; }
__host__ __device__ __forceinline__ int perm32(int rho) { const int n = rho >> 4, i = rho & 15; return 8 * (i >> 2) + 4 * n + (i & 3); }

struct Unit { int pm, pn; };
struct Gemm { const bf16_t* A; const bf16_t* Bt; int M, N, K; };

struct StaticOrder {
    int nM, nN, nwg, G, c;
    __host__ __device__ void init(int M, int N, int G_, int c_) { nM = M / BM; nN = N / BM; nwg = nM * nN; G = G_; c = c_; }
    __host__ __device__ bool next(int i, Unit& u) const {
        const long L = (long)i * G + c; if (L >= nwg) return false;
        int wgid = (int)L; { const int q = nwg / NXCD, r = nwg % NXCD, xcd = wgid % NXCD, off = wgid / NXCD; wgid = (xcd < r ? xcd * (q + 1) : r * (q + 1) + (xcd - r) * q) + off; }
        const int nig = WGM * nN, gid = wgid / nig, fm = gid * WGM, gsz = (nM - fm) < WGM ? (nM - fm) : WGM;
        u.pm = fm + ((wgid % nig) % gsz); u.pn = (wgid % nig) / gsz; return true;
    }
    __device__ __forceinline__ void a_ready(const Unit&) const {}
    __device__ __forceinline__ void done(const Unit&) const {}
};

struct SsOrder : StaticOrder {
    const float* ss; PG8_LAS unsigned char* slots; mutable int k;
    __device__ __forceinline__ void a_ready(const Unit& u) const {
        const int slot = k & 1; ++k;
        if (__builtin_amdgcn_readfirstlane(threadIdx.x >> 6) == 0)
            __builtin_amdgcn_global_load_lds((const unsigned*)(ss + u.pm * BM + (threadIdx.x & 63) * 4), (PG8_LAS unsigned*)(slots + slot * 1024), 16, 0, 0);
    }
};
__device__ __forceinline__ unsigned cvt_pk_bf16(float lo, float hi) { unsigned r; asm volatile("v_cvt_pk_bf16_f32 %0, %1, %2" : "=v"(r) : "v"(lo), "v"(hi)); return r; }
__device__ __forceinline__ float sum_x16(float x) { auto r = __builtin_amdgcn_permlane16_swap(__float_as_uint(x), __float_as_uint(x), false, false); return __uint_as_float(r[0]) + __uint_as_float(r[1]); }
__device__ __forceinline__ float sum_x32(float x) { auto r = __builtin_amdgcn_permlane32_swap(__float_as_uint(x), __float_as_uint(x), false, false); return __uint_as_float(r[0]) + __uint_as_float(r[1]); }
__device__ __forceinline__ float max_x16(float x) { auto r = __builtin_amdgcn_permlane16_swap(__float_as_uint(x), __float_as_uint(x), false, false); return fmaxf(__uint_as_float(r[0]), __uint_as_float(r[1])); }
__device__ __forceinline__ float max_x32(float x) { auto r = __builtin_amdgcn_permlane32_swap(__float_as_uint(x), __float_as_uint(x), false, false); return fmaxf(__uint_as_float(r[0]), __uint_as_float(r[1])); }
typedef unsigned u32x2w __attribute__((ext_vector_type(2)));
__device__ __forceinline__ u32x4 widen_pair(u32x2w A, u32x2w B, bool odd) {
    auto rx = __builtin_amdgcn_permlane16_swap(A.x, B.x, false, false); auto ry = __builtin_amdgcn_permlane16_swap(A.y, B.y, false, false);
    u32x4 o; if (odd) { o.x = rx[0]; o.y = ry[0]; o.z = B.x; o.w = B.y; } else { o.x = A.x; o.y = A.y; o.z = rx[1]; o.w = ry[1]; }
    return o;
}
__device__ __forceinline__ float get_x16(float x, bool odd) { auto r = __builtin_amdgcn_permlane16_swap(__float_as_uint(x), __float_as_uint(x), false, false); return __uint_as_float(odd ? r[0] : r[1]); }
constexpr float RMS_EPS = 1e-6f;
__device__ __forceinline__ float silu_f(float x) { return x * __builtin_amdgcn_rcpf(1.0f + __expf(-x)); }
struct EpiSwiglu {
    static constexpr bool PERM = true, AFTER_DRAIN = false;
    bf16_t* O; int ldc; const PG8_LAS unsigned char* slots; mutable int k;
    __device__ __forceinline__ void operator()(const f32x4 (&acc)[2][2][4][2], const Unit& u, int wr, int wc, int fr, int fq) const {
        const int row0 = u.pm * BM + wr * 64 + fr, col0 = u.pn * HALF + wc * 32 + 8 * fq;
        const PG8_LAS float* ss = (const PG8_LAS float*)(slots + (k & 1) * 1024) - u.pm * BM; ++k;
        float ssv[2][4];
#pragma unroll
        for (int ai = 0; ai < 2; ++ai)
#pragma unroll
            for (int m = 0; m < 4; ++m) ssv[ai][m] = ss[row0 + ai * HALF + m * 16];
#pragma unroll
        for (int ai = 0; ai < 2; ++ai)
#pragma unroll
            for (int m = 0; m < 4; ++m) {
                const int row = row0 + ai * HALF + m * 16;
                const float rs = __builtin_amdgcn_rsqf(ssv[ai][m] * (1.0f / 1024.0f) + RMS_EPS);
                const f32x4 a0 = acc[ai][0][m][0] * rs, a1 = acc[ai][0][m][1] * rs, b0 = acc[ai][1][m][0] * rs, b1 = acc[ai][1][m][1] * rs;
                u32x4 w;
                w.x = cvt_pk_bf16(silu_f(a0[0]) * b0[0], silu_f(a0[1]) * b0[1]); w.y = cvt_pk_bf16(silu_f(a0[2]) * b0[2], silu_f(a0[3]) * b0[3]);
                w.z = cvt_pk_bf16(silu_f(a1[0]) * b1[0], silu_f(a1[1]) * b1[1]); w.w = cvt_pk_bf16(silu_f(a1[2]) * b1[2], silu_f(a1[3]) * b1[3]);
                *(u32x4*)(O + (size_t)row * ldc + col0) = w;
            }
    }
};
struct EpiProj {
    static constexpr bool PERM = true, AFTER_DRAIN = false;
    bf16_t* PG; bf16_t* PA; const PG8_LAS unsigned char* slots; const float* cs; mutable int k;
    __device__ __forceinline__ void operator()(const f32x4 (&acc)[2][2][4][2], const Unit& u, int wr, int wc, int fr, int fq) const {
        const int row0 = u.pm * BM + wr * 64 + fr;
        const PG8_LAS float* ss = (const PG8_LAS float*)(slots + (k & 1) * 1024) - u.pm * BM; ++k;
        bf16_t* base; int ldc;
        if (u.pn < 6) { base = PG + u.pn * BM; ldc = 1792; } else { base = PA + (u.pn - 6) * BM; ldc = 1536; }
        base += wc * 32 + 8 * fq;
        const bool rot = (u.pn >= 6) && (u.pn < 10) && ((wc & 1) == 0);
        const float qs = (u.pn == 6 || u.pn == 7) ? 0.125f * 1.4426950408889634f : 1.0f;
        float ssv[2][4];
#pragma unroll
        for (int ai = 0; ai < 2; ++ai)
#pragma unroll
            for (int m = 0; m < 4; ++m) ssv[ai][m] = ss[row0 + ai * HALF + m * 16];
#pragma unroll
        for (int ai = 0; ai < 2; ++ai)
#pragma unroll
            for (int m = 0; m < 4; ++m) {
                const int row = row0 + ai * HALF + m * 16;
                const float rs = __builtin_amdgcn_rsqf(ssv[ai][m] * (1.0f / 1024.0f) + RMS_EPS);
                f32x4 c0 = {1.f, 1.f, 1.f, 1.f}, c1 = c0, s0 = {0.f, 0.f, 0.f, 0.f}, s1 = s0;
                if (rot && fq < 2) { const float* cr = cs + (size_t)row * 16; c0 = *(const f32x4*)cr; c1 = *(const f32x4*)(cr + 4); s0 = *(const f32x4*)(cr + 8); s1 = *(const f32x4*)(cr + 12);
                    if (fq == 0) { s0 = -s0; s1 = -s1; } }
#pragma unroll
                for (int bj = 0; bj < 2; ++bj) {
                    f32x4 v0 = acc[ai][bj][m][0] * rs, v1 = acc[ai][bj][m][1] * rs;
                    if (rot) {
                        f32x4 p0, p1;
#pragma unroll
                        for (int j = 0; j < 4; ++j) { p0[j] = get_x16(v0[j], fq & 1); p1[j] = get_x16(v1[j], fq & 1); }
                        v0 = v0 * c0 + p0 * s0; v1 = v1 * c1 + p1 * s1;
                    }
                    v0 = v0 * qs; v1 = v1 * qs;
                    u32x4 w; w.x = cvt_pk_bf16(v0[0], v0[1]); w.y = cvt_pk_bf16(v0[2], v0[3]); w.z = cvt_pk_bf16(v1[0], v1[1]); w.w = cvt_pk_bf16(v1[2], v1[3]);
                    *(u32x4*)(base + (size_t)row * ldc + bj * HALF) = w;
                }
            }
    }
};
struct EpiResidF {
    static constexpr bool PERM = true, AFTER_DRAIN = false;
    const bf16_t* base; float* out; float alpha; int ldc;
    __device__ __forceinline__ void operator()(const f32x4 (&acc)[2][2][4][2], const Unit& u, int wr, int wc, int fr, int fq) const {
        const int row0 = u.pm * BM + wr * 64 + fr, col0 = u.pn * BM + wc * 32 + 8 * fq;
#pragma unroll
        for (int ai = 0; ai < 2; ++ai)
#pragma unroll
            for (int m = 0; m < 4; ++m) {
                const size_t off = (size_t)(row0 + ai * HALF + m * 16) * ldc + col0;
#pragma unroll
                for (int bj = 0; bj < 2; ++bj) {
                    const u32x4 w = *(const u32x4*)(base + off + bj * HALF);
                    const f32x4 r0 = {__uint_as_float(w.x << 16), __uint_as_float(w.x & 0xffff0000u), __uint_as_float(w.y << 16), __uint_as_float(w.y & 0xffff0000u)};
                    const f32x4 r1 = {__uint_as_float(w.z << 16), __uint_as_float(w.z & 0xffff0000u), __uint_as_float(w.w << 16), __uint_as_float(w.w & 0xffff0000u)};
                    *(f32x4*)(out + off + bj * HALF) = r0 + acc[ai][bj][m][0] * alpha; *(f32x4*)(out + off + bj * HALF + 4) = r1 + acc[ai][bj][m][1] * alpha;
                }
            }
    }
};
__device__ __forceinline__ void unpack8(const u32x4 w, f32x4& a, f32x4& b) {
    a = (f32x4){__uint_as_float(w.x << 16), __uint_as_float(w.x & 0xffff0000u), __uint_as_float(w.y << 16), __uint_as_float(w.y & 0xffff0000u)};
    b = (f32x4){__uint_as_float(w.z << 16), __uint_as_float(w.z & 0xffff0000u), __uint_as_float(w.w << 16), __uint_as_float(w.w & 0xffff0000u)};
}
template <bool BASE_BF16> struct EpiResidB {
    static constexpr bool PERM = true, AFTER_DRAIN = false;
    const void* base; bf16_t* xn; float* ss; float alpha; int ldc;
    __device__ __forceinline__ void operator()(const f32x4 (&acc)[2][2][4][2], const Unit& u, int wr, int wc, int fr, int fq) const {
        const int row0 = u.pm * BM + wr * 64 + fr, col0 = u.pn * BM + wc * 32 + 8 * fq;
        if constexpr (BASE_BF16) {
            u32x4 rb[2][4][2];
#pragma unroll
            for (int ai = 0; ai < 2; ++ai)
#pragma unroll
                for (int m = 0; m < 4; ++m)
#pragma unroll
                    for (int bj = 0; bj < 2; ++bj) rb[ai][m][bj] = *(const u32x4*)((const bf16_t*)base + (size_t)(row0 + ai * HALF + m * 16) * ldc + col0 + bj * HALF);
#pragma unroll
            for (int ai = 0; ai < 2; ++ai)
#pragma unroll
                for (int m = 0; m < 4; ++m) {
                    const int row = row0 + ai * HALF + m * 16; const size_t off = (size_t)row * ldc + col0; float s = 0.f;
#pragma unroll
                    for (int bj = 0; bj < 2; ++bj) {
                        f32x4 r0, r1; unpack8(rb[ai][m][bj], r0, r1);
                        const f32x4 o0 = r0 + acc[ai][bj][m][0] * alpha, o1 = r1 + acc[ai][bj][m][1] * alpha;
                        u32x4 w; w.x = cvt_pk_bf16(o0[0], o0[1]); w.y = cvt_pk_bf16(o0[2], o0[3]); w.z = cvt_pk_bf16(o1[0], o1[1]); w.w = cvt_pk_bf16(o1[2], o1[3]);
                        *(u32x4*)(xn + off + bj * HALF) = w;
                        s += (o0[0] * o0[0] + o0[1] * o0[1]) + (o0[2] * o0[2] + o0[3] * o0[3]) + (o1[0] * o1[0] + o1[1] * o1[1]) + (o1[2] * o1[2] + o1[3] * o1[3]);
                    }
                    s = sum_x32(sum_x16(s)); if (fq == 0) atomicAdd(ss + row, s);
                }
        } else {
#pragma unroll
            for (int ai = 0; ai < 2; ++ai) {
                f32x4 rf[4][2][2];
#pragma unroll
                for (int m = 0; m < 4; ++m)
#pragma unroll
                    for (int bj = 0; bj < 2; ++bj) { const float* bp = (const float*)base + (size_t)(row0 + ai * HALF + m * 16) * ldc + col0 + bj * HALF; rf[m][bj][0] = *(const f32x4*)bp; rf[m][bj][1] = *(const f32x4*)(bp + 4); }
#pragma unroll
                for (int m = 0; m < 4; ++m) {
                    const int row = row0 + ai * HALF + m * 16; const size_t off = (size_t)row * ldc + col0; float s = 0.f;
#pragma unroll
                    for (int bj = 0; bj < 2; ++bj) {
                        const f32x4 o0 = rf[m][bj][0] + acc[ai][bj][m][0] * alpha, o1 = rf[m][bj][1] + acc[ai][bj][m][1] * alpha;
                        u32x4 w; w.x = cvt_pk_bf16(o0[0], o0[1]); w.y = cvt_pk_bf16(o0[2], o0[3]); w.z = cvt_pk_bf16(o1[0], o1[1]); w.w = cvt_pk_bf16(o1[2], o1[3]);
                        *(u32x4*)(xn + off + bj * HALF) = w;
                        s += (o0[0] * o0[0] + o0[1] * o0[1]) + (o0[2] * o0[2] + o0[3] * o0[3]) + (o1[0] * o1[0] + o1[1] * o1[1]) + (o1[2] * o1[2] + o1[3] * o1[3]);
                    }
                    s = sum_x32(sum_x16(s)); if (fq == 0) atomicAdd(ss + row, s);
                }
            }
        }
    }
};
struct EpiFinal {
    static constexpr bool PERM = true, AFTER_DRAIN = false;
    const bf16_t* base; float* out; float* ss; unsigned* cnt; const float* gf; float alpha; int ldc; unsigned want;
    __device__ __forceinline__ void operator()(f32x4 (&acc)[2][2][4][2], const Unit& u, int wr, int wc, int fr, int fq) const {
        const int row0 = u.pm * BM + wr * 64 + fr, col0 = u.pn * BM + wc * 32 + 8 * fq;
        u32x4 rb[2][4][2];
#pragma unroll
        for (int ai = 0; ai < 2; ++ai)
#pragma unroll
            for (int m = 0; m < 4; ++m)
#pragma unroll
                for (int bj = 0; bj < 2; ++bj) rb[ai][m][bj] = *(const u32x4*)(base + (size_t)(row0 + ai * HALF + m * 16) * ldc + col0 + bj * HALF);
#pragma unroll
        for (int ai = 0; ai < 2; ++ai)
#pragma unroll
            for (int m = 0; m < 4; ++m) {
                const int row = row0 + ai * HALF + m * 16; const size_t off = (size_t)row * ldc + col0; float s = 0.f;
#pragma unroll
                for (int bj = 0; bj < 2; ++bj) {
                    f32x4 r0, r1; unpack8(rb[ai][m][bj], r0, r1);
                    const f32x4 o0 = r0 + acc[ai][bj][m][0] * alpha, o1 = r1 + acc[ai][bj][m][1] * alpha;
                    acc[ai][bj][m][0] = o0; acc[ai][bj][m][1] = o1;
                    s += (o0[0] * o0[0] + o0[1] * o0[1]) + (o0[2] * o0[2] + o0[3] * o0[3]) + (o1[0] * o1[0] + o1[1] * o1[1]) + (o1[2] * o1[2] + o1[3] * o1[3]);
                }
                s = sum_x32(sum_x16(s));
                if (fq == 0) { const float old = __hip_atomic_fetch_add(ss + row, s, __ATOMIC_RELAXED, __HIP_MEMORY_SCOPE_AGENT); asm volatile("" :: "v"(old)); }
            }
        asm volatile("s_waitcnt vmcnt(0)" ::: "memory");
        unsigned* pc = cnt + 64 * u.pm;
        if ((threadIdx.x & 63) == 0) __hip_atomic_fetch_add(pc, 1u, __ATOMIC_RELAXED, __HIP_MEMORY_SCOPE_AGENT);
        { unsigned spins = 0; while ((unsigned)__builtin_amdgcn_readfirstlane(__hip_atomic_load(pc, __ATOMIC_RELAXED, __HIP_MEMORY_SCOPE_AGENT)) < want) { __builtin_amdgcn_s_sleep(2); if (++spins > (1u << 22)) break; } }
        asm volatile("" ::: "memory");
        const f32x4 g00 = *(const f32x4*)(gf + col0), g01 = *(const f32x4*)(gf + col0 + 4), g10 = *(const f32x4*)(gf + col0 + HALF), g11 = *(const f32x4*)(gf + col0 + HALF + 4);
#pragma unroll
        for (int ai = 0; ai < 2; ++ai)
#pragma unroll
            for (int m = 0; m < 4; ++m) {
                const int row = row0 + ai * HALF + m * 16; const size_t off = (size_t)row * ldc + col0;
                const float rs = __builtin_amdgcn_rsqf(__hip_atomic_load(ss + row, __ATOMIC_RELAXED, __HIP_MEMORY_SCOPE_AGENT) * (1.0f / 1024.0f) + RMS_EPS);
                *(f32x4*)(out + off) = acc[ai][0][m][0] * rs * g00; *(f32x4*)(out + off + 4) = acc[ai][0][m][1] * rs * g01;
                *(f32x4*)(out + off + HALF) = acc[ai][1][m][0] * rs * g10; *(f32x4*)(out + off + HALF + 4) = acc[ai][1][m][1] * rs * g11;
            }
    }
};
template <class Epi, class Sched, bool ALIGN_EPI = false, bool SP2 = false>
__device__ __forceinline__ void gemm_phase(PG8_LAS unsigned char* lds, const Gemm g, const Sched& S, const Epi& E) {
    int tid_ = threadIdx.x; asm volatile("" : "+v"(tid_));
    const int tid = tid_, wid = __builtin_amdgcn_readfirstlane(tid >> 6), lane = tid & 63, wr = wid >> 2, wc = wid & 3, fr = lane & 15, fq = lane >> 4;
    const int K = g.K, nt = K / BK;
    unsigned voffA[2], voffB[2];
#pragma unroll
    for (int i = 0; i < 2; ++i) { int R, C; stage_rc(tid * 16 + i * 8192, R, C); const int Rb = Epi::PERM ? ((R & ~31) + perm32(R & 31)) : R;
        voffA[i] = (unsigned)(R * K + C) * 2u; voffB[i] = (unsigned)(Rb * K + C) * 2u; }
    const size_t kstep = (size_t)(BK * 2);
    const size_t hstep = (size_t)HALF * K * 2;
    const size_t tstep = 2 * hstep;
    const unsigned ldsw = (unsigned)wid * 1024u;
    const int aoff = lds_byte(wr * 64 + fr, fq * 8), boff = lds_byte(wc * 32 + fr, fq * 8);
#define PG8_SA(b, h) (((b) * 2 + (h)) * HTB)
#define PG8_SB(b, h) ((4 + (b) * 2 + (h)) * HTB)
#define PG8_STAGE(bufoff, gbase, voff) do { _Pragma("unroll") for (int _i = 0; _i < 2; ++_i) \
        __builtin_amdgcn_global_load_lds((const unsigned*)((const char*)(gbase) + (voff)[_i]), (PG8_LAS unsigned*)(lds + (bufoff) + ldsw + _i * 8192), 16, 0, 0); } while (0)
#define PG8_LDA(dst, b, h) do { _Pragma("unroll") for (int m = 0; m < 4; ++m) _Pragma("unroll") for (int k = 0; k < 2; ++k) dst[m][k] = *(const PG8_LAS bf16x8*)(lds + PG8_SA(b, h) + aoff + m * 2048 + k * 1024); } while (0)
#define PG8_LDB(dst, b, h) do { _Pragma("unroll") for (int n = 0; n < 2; ++n) _Pragma("unroll") for (int k = 0; k < 2; ++k) dst[n][k] = *(const PG8_LAS bf16x8*)(lds + PG8_SB(b, h) + boff + n * 2048 + k * 1024); } while (0)
#define PG8_MMA(ai, bj, At, Bt) do { __builtin_amdgcn_s_setprio(1); _Pragma("unroll") for (int m = 0; m < 4; ++m) _Pragma("unroll") for (int n = 0; n < 2; ++n) _Pragma("unroll") for (int k = 0; k < 2; ++k) \
        acc[ai][bj][m][n] = __builtin_amdgcn_mfma_f32_16x16x32_bf16(Bt[n][k], At[m][k], acc[ai][bj][m][n], 0, 0, 0); __builtin_amdgcn_s_setprio(0); } while (0)
#define PG8_WAIT_V(n) asm volatile("s_waitcnt vmcnt(" #n ")" ::: "memory")
#define PG8_WAIT_L(n) asm volatile("s_waitcnt lgkmcnt(" #n ")" ::: "memory")
#define PG8_BAR __builtin_amdgcn_s_barrier()
#define PG8_SCHED __builtin_amdgcn_sched_barrier(0)
    Unit cur, nxt; int ui = 0;
    if (!S.next(0, cur)) return;
    f32x4 acc[2][2][4][2];
#pragma unroll
    for (int a = 0; a < 2; ++a)
#pragma unroll
        for (int b = 0; b < 2; ++b)
#pragma unroll
            for (int m = 0; m < 4; ++m)
#pragma unroll
                for (int n = 0; n < 2; ++n) acc[a][b][m][n] = (f32x4){0.f, 0.f, 0.f, 0.f};
    bf16x8 At[4][2], B0[2][2], B1[2][2];
    const char* cA = (const char*)g.A + (size_t)cur.pm * tstep; const char* cB = (const char*)g.Bt + (size_t)cur.pn * tstep;
    S.a_ready(cur);
    if constexpr (SP2) {
        PG8_STAGE(PG8_SB(0, 0), cB, voffB); PG8_STAGE(PG8_SB(0, 1), cB + hstep, voffB); PG8_STAGE(PG8_SA(0, 0), cA, voffA); PG8_STAGE(PG8_SA(0, 1), cA + hstep, voffA);
        if (wr == 1) PG8_BAR;
        PG8_WAIT_V(2); PG8_BAR;
        PG8_STAGE(PG8_SB(1, 0), cB + kstep, voffB); PG8_STAGE(PG8_SA(1, 0), cA + kstep, voffA); PG8_STAGE(PG8_SB(1, 1), cB + hstep + kstep, voffB);
        PG8_WAIT_V(6); PG8_BAR;
    } else {
        PG8_STAGE(PG8_SB(0, 0), cB, voffB); PG8_STAGE(PG8_SA(0, 0), cA, voffA); PG8_STAGE(PG8_SB(0, 1), cB + hstep, voffB); PG8_STAGE(PG8_SA(0, 1), cA + hstep, voffA);
        if (wr == 1) PG8_BAR;
        PG8_WAIT_V(4); PG8_BAR;
        PG8_STAGE(PG8_SB(1, 0), cB + kstep, voffB); PG8_STAGE(PG8_SA(1, 0), cA + kstep, voffA); PG8_STAGE(PG8_SB(1, 1), cB + hstep + kstep, voffB);
        PG8_WAIT_V(6); PG8_BAR;
    }
    for (;;) {
        const bool has_next = S.next(ui + 1, nxt);
        const char* nA = has_next ? (const char*)g.A + (size_t)nxt.pm * tstep : cA; const char* nB = has_next ? (const char*)g.Bt + (size_t)nxt.pn * tstep : cB;
        for (int t = 0; t < nt; t += 2) {
            const bool last = (t == nt - 2);
            const char* a1 = cA + (size_t)(t + 1) * kstep;
            const char* a2 = last ? nA : cA + (size_t)(t + 2) * kstep; const char* b2 = last ? nB : cB + (size_t)(t + 2) * kstep;
            const char* a3 = a2 + kstep; const char* b3 = b2 + kstep;
            if (last && has_next) S.a_ready(nxt);
            if constexpr (SP2) {
            PG8_LDB(B0, 0, 0); PG8_LDB(B1, 0, 1); PG8_SCHED; PG8_LDA(At, 0, 0); PG8_STAGE(PG8_SA(1, 1), a1 + hstep, voffA);
            PG8_WAIT_V(8); PG8_WAIT_L(0); PG8_BAR; PG8_MMA(0, 0, At, B0); PG8_MMA(0, 1, At, B1); PG8_BAR; PG8_SCHED;
            PG8_LDA(At, 0, 1); PG8_STAGE(PG8_SB(0, 0), b2, voffB); PG8_STAGE(PG8_SB(0, 1), b2 + hstep, voffB); PG8_STAGE(PG8_SA(0, 0), a2, voffA);
            PG8_WAIT_V(8); PG8_WAIT_L(0); PG8_BAR; PG8_MMA(1, 0, At, B0); PG8_MMA(1, 1, At, B1); PG8_BAR; PG8_SCHED;
            PG8_LDB(B0, 1, 0); PG8_LDB(B1, 1, 1); PG8_SCHED; PG8_LDA(At, 1, 0); PG8_STAGE(PG8_SA(0, 1), a2 + hstep, voffA);
            PG8_WAIT_V(8); PG8_WAIT_L(0); PG8_BAR; PG8_MMA(0, 0, At, B0); PG8_MMA(0, 1, At, B1); PG8_BAR; PG8_SCHED;
            PG8_LDA(At, 1, 1); PG8_STAGE(PG8_SB(1, 0), b3, voffB); PG8_STAGE(PG8_SB(1, 1), b3 + hstep, voffB); PG8_STAGE(PG8_SA(1, 0), a3, voffA);
            PG8_WAIT_V(8); PG8_WAIT_L(0); PG8_BAR; PG8_MMA(1, 0, At, B0); PG8_MMA(1, 1, At, B1); PG8_BAR; PG8_SCHED;
            } else {
            PG8_LDB(B0, 0, 0); PG8_SCHED; PG8_LDA(At, 0, 0); PG8_STAGE(PG8_SA(1, 1), a1 + hstep, voffA);
            PG8_WAIT_L(8); PG8_BAR; PG8_WAIT_L(0); PG8_MMA(0, 0, At, B0); PG8_BAR; PG8_SCHED;
            PG8_LDB(B1, 0, 1); PG8_STAGE(PG8_SB(0, 0), b2, voffB);
            PG8_BAR; PG8_WAIT_L(0); PG8_MMA(0, 1, At, B1); PG8_BAR;
            PG8_LDA(At, 0, 1); PG8_STAGE(PG8_SA(0, 0), a2, voffA);
            PG8_BAR; PG8_WAIT_L(0); PG8_MMA(1, 0, At, B0); PG8_BAR; PG8_SCHED;
            PG8_STAGE(PG8_SB(0, 1), b2 + hstep, voffB);
            PG8_WAIT_V(6); PG8_BAR; PG8_MMA(1, 1, At, B1); PG8_BAR;
            PG8_LDB(B0, 1, 0); PG8_SCHED; PG8_LDA(At, 1, 0); PG8_STAGE(PG8_SA(0, 1), a2 + hstep, voffA);
            PG8_WAIT_L(8); PG8_BAR; PG8_WAIT_L(0); PG8_MMA(0, 0, At, B0); PG8_BAR; PG8_SCHED;
            PG8_LDB(B1, 1, 1); PG8_STAGE(PG8_SB(1, 0), b3, voffB);
            PG8_BAR; PG8_WAIT_L(0); PG8_MMA(0, 1, At, B1); PG8_BAR;
            PG8_LDA(At, 1, 1); PG8_STAGE(PG8_SA(1, 0), a3, voffA);
            PG8_BAR; PG8_WAIT_L(0); PG8_MMA(1, 0, At, B0); PG8_BAR; PG8_SCHED;
            PG8_STAGE(PG8_SB(1, 1), b3 + hstep, voffB);
            PG8_WAIT_V(6); PG8_BAR; PG8_MMA(1, 1, At, B1); PG8_BAR;
            }
        }
        if constexpr (ALIGN_EPI) { if (wr == 0) PG8_BAR; }
        if constexpr (!Epi::AFTER_DRAIN) { E(acc, cur, wr, wc, fr, fq); S.done(cur); }
        if (!has_next) break;
#pragma unroll
        for (int a = 0; a < 2; ++a)
#pragma unroll
            for (int b = 0; b < 2; ++b)
#pragma unroll
                for (int m = 0; m < 4; ++m)
#pragma unroll
                    for (int n = 0; n < 2; ++n) acc[a][b][m][n] = (f32x4){0.f, 0.f, 0.f, 0.f};
        cur = nxt; cA = nA; cB = nB; ++ui;
        if constexpr (ALIGN_EPI) { if (wr == 1) PG8_BAR; }
    }
    PG8_WAIT_V(0);
    if constexpr (!ALIGN_EPI) { if (wr == 0) PG8_BAR; }
    PG8_BAR;
    if constexpr (Epi::AFTER_DRAIN) { E.fused(acc, cur, wr, wc, fr, fq, lds, wid, lane); S.done(cur); }
#undef PG8_SA
#undef PG8_SB
#undef PG8_STAGE
#undef PG8_LDA
#undef PG8_LDB
#undef PG8_MMA
#undef PG8_WAIT_V
#undef PG8_WAIT_L
#undef PG8_BAR
#undef PG8_SCHED
}
}

#define LAS __attribute__((address_space(3)))
typedef unsigned short bf16;
typedef short bf16x8 __attribute__((ext_vector_type(8)));
typedef short s16x4 __attribute__((ext_vector_type(4)));
typedef float f32x4 __attribute__((ext_vector_type(4)));
typedef float f32x2 __attribute__((ext_vector_type(2)));
typedef unsigned u32x4 __attribute__((ext_vector_type(4)));
typedef unsigned u32x2 __attribute__((ext_vector_type(2)));
typedef __bf16 bf16x2_t __attribute__((ext_vector_type(2)));

#ifndef PROBE_PH
#define PROBE_PH -1
#endif
#define STAMP(k) do { if (PROBE_PH >= 0 && (k) == PROBE_PH) ts0 = __builtin_amdgcn_s_memrealtime(); if (PROBE_PH >= 0 && (k) == PROBE_PH + 1) ts1 = __builtin_amdgcn_s_memrealtime(); } while (0)
#ifndef REP_MIX
#define REP_MIX 1
#endif
#ifndef REP_MIXC
#define REP_MIXC 1
#endif
#ifndef REP_UP
#define REP_UP 1
#endif
#ifndef REP_DN
#define REP_DN 1
#endif
#ifndef REP_OUT
#define REP_OUT 1
#endif
#ifndef REP_SYNC
#define REP_SYNC 1
#endif
#ifndef REP_P0
#define REP_P0 1
#endif
#ifndef REP_IN
#define REP_IN 1
#endif
#define GSYNC() do { for (int _r = 0; _r < REP_SYNC; ++_r) xcd_barrier(bar); } while (0)
constexpr int NWAVES = 8, NTHR = 512;
constexpr int SEQ = 8192, M = 16384, D = 1024, FF = 2816, NUP = 2 * FF  , NIN = 3072, DIN_SRC = 3088;
constexpr int LDG = 1792, LDA = 1536;
constexpr float EPS = 1e-6f;

constexpr size_t MiB = 1u << 20;
constexpr size_t WS_CTL = 0, CTL_ZERO_BYTES = 1 * MiB;
constexpr size_t WS_SS1 = 64 * 1024, WS_SS2 = 128 * 1024, WS_SS3 = 192 * 1024, WS_BAR = 256 * 1024, WS_PCNT = 512 * 1024;
constexpr size_t WS_SS0 = 1 * MiB;
constexpr size_t WS_CS = 1 * MiB + 256 * 1024;
constexpr size_t WS_DEC = 2 * MiB + 512 * 1024;
constexpr size_t WS_LSE = 3 * MiB;
constexpr size_t WS_WGA = 4 * MiB + 512 * 1024;
constexpr size_t WS_GA = 232 * MiB;
constexpr size_t WS_W13A = 5 * MiB, WS_W2A = 16 * MiB, WS_WIN = 22 * MiB, WS_WOUT = 29 * MiB, WS_W13B = 31 * MiB, WS_W2B = 42 * MiB;
constexpr size_t WS_ST = 5 * MiB;
constexpr size_t WS_XN = 48 * MiB;
constexpr size_t WS_UT = 48 * MiB;
constexpr size_t WS_PG = 80 * MiB;
constexpr size_t WS_PA = 136 * MiB;
constexpr size_t WS_OM = 136 * MiB;
constexpr size_t WS_OB = 184 * MiB;
constexpr size_t WS_H = 80 * MiB;
constexpr size_t WS_END = 233 * MiB;
static_assert(WS_W13A + (size_t)NUP * D * 2 <= WS_W2A && WS_W2A + (size_t)D * FF * 2 <= WS_WIN && WS_WIN + (size_t)NIN * D * 2 <= WS_WOUT && WS_WOUT + (size_t)D * D * 2 <= WS_W13B &&
              WS_W13B + (size_t)NUP * D * 2 <= WS_W2B && WS_W2B + (size_t)D * FF * 2 <= WS_XN && WS_ST + 16 * MiB <= WS_WIN && WS_PG + (size_t)M * LDG * 2 <= WS_PA &&
              WS_PA + (size_t)M * LDA * 2 <= WS_OB && WS_H + (size_t)M * FF * 2 <= WS_OB && WS_OB + (size_t)3 * M * 512 * 2 <= WS_END, "d_ws map");

constexpr int RING_BYTES = 131072, LDS_BYTES = 147456, MISC_OFF = RING_BYTES;

__device__ __forceinline__ float bf2f(unsigned short v) { return __uint_as_float(((unsigned)v) << 16); }
__device__ __forceinline__ unsigned pk2(float lo, float hi) { f32x2 v = {lo, hi}; bf16x2_t b = __builtin_convertvector(v, bf16x2_t); return __builtin_bit_cast(unsigned, b); }
__device__ __forceinline__ unsigned short f2bf(float x) { return (unsigned short)(pk2(x, 0.f) & 0xffffu); }
__device__ __forceinline__ float wave_sum(float v) {
#pragma unroll
    for (int o = 1; o < 64; o <<= 1) v += __shfl_xor(v, o);
    return v;
}
#define MFMA16(a, b, c) __builtin_amdgcn_mfma_f32_16x16x32_bf16((a), (b), (c), 0, 0, 0)

struct Args {
    const float* x; const int* pos; const float* g1; const float* w1a; const float* w3a; const float* w2a; const float* gm; const float* win; const float* wa2; const float* ba;
    const float* ggla; const float* gatt; const float* wout; const float* g2; const float* w1b; const float* w3b; const float* w2b; const float* gf;
    float* out; unsigned char* ws; int use_cg_sync; int pad;
};

__device__ __forceinline__ void tr_item(const float* W, int ldw, int col0, int k0, const float* gain, bf16* WT, int K, int drow0, LAS float* scr, int lane) {
    const float* src = W + (size_t)(k0 + (lane >> 5)) * ldw + col0 + (lane & 31);
    float v[32];
#pragma unroll
    for (int i = 0; i < 32; ++i) v[i] = __builtin_nontemporal_load(src + (size_t)(2 * i) * ldw);
    const int c = lane & 7;
    f32x4 g0 = {1.f, 1.f, 1.f, 1.f}, g1 = g0;
    if (gain) { g0 = *(const f32x4*)(gain + k0 + 8 * c); g1 = *(const f32x4*)(gain + k0 + 8 * c + 4); }
#pragma unroll
    for (int i = 0; i < 32; ++i) scr[(2 * i + (lane >> 5)) * 33 + (lane & 31)] = v[i];
    asm volatile("s_waitcnt lgkmcnt(0)" ::: "memory");
#pragma unroll
    for (int j = 0; j < 4; ++j) { const int n = (lane >> 3) + 8 * j; const LAS float* s = scr + (8 * c) * 33 + n;
        u32x4 o; o.x = pk2(s[0 * 33] * g0[0], s[1 * 33] * g0[1]); o.y = pk2(s[2 * 33] * g0[2], s[3 * 33] * g0[3]); o.z = pk2(s[4 * 33] * g1[0], s[5 * 33] * g1[1]); o.w = pk2(s[6 * 33] * g1[2], s[7 * 33] * g1[3]);
        *(u32x4*)(WT + (size_t)(drow0 + n) * K + k0 + 8 * c) = o; }
    asm volatile("s_waitcnt lgkmcnt(0)" ::: "memory");
}
__device__ __forceinline__ void up_item(const float* w1, const float* w3, const float* g, bf16* WT, int r, LAS float* scr, int lane) {
    const int which = r / 1408, rr = r % 1408, kb = rr / 88, nb = rr % 88;
    tr_item(which ? w3 : w1, FF, 32 * nb, 64 * kb, g, WT, D, 256 * (nb >> 2) + 32 * (nb & 3) + 128 * which, scr, lane);
}
__device__ __forceinline__ void conv_items(const Args& a, LAS unsigned char* lds, int lo, int hi, int widx, int nw, int lane_in, int wave) {
    int lane = lane_in; asm volatile("" : "+v"(lane));
    unsigned char* ws = a.ws;
    LAS float* scr = (LAS float*)(lds + wave * 16384);
    bf16* W13A = (bf16*)(ws + WS_W13A); bf16* W2A = (bf16*)(ws + WS_W2A); bf16* WIN = (bf16*)(ws + WS_WIN); bf16* WOUT = (bf16*)(ws + WS_WOUT); bf16* W13B = (bf16*)(ws + WS_W13B); bf16* W2B = (bf16*)(ws + WS_W2B);
    constexpr int I_UP = 2816, I_DN = 1408, I_IN = 1536, I_OUT = 512;
    for (int it = lo + widx; it < hi; it += nw) {
        int r = it;
        if (r < I_UP) { up_item(a.w1a, a.w3a, a.g1, W13A, r, scr, lane); continue; } r -= I_UP;
        if (r < I_DN) { tr_item(a.w2a, D, 32 * (r % 32), 64 * (r / 32), nullptr, W2A, FF, 32 * (r % 32), scr, lane); continue; } r -= I_DN;
        if (r < I_IN) { const int kb = r / 96, nb = r % 96; tr_item(a.win, DIN_SRC, nb < 48 ? 32 * nb : 32 * nb + 16, 64 * kb, a.gm, WIN, D, 32 * nb, scr, lane); continue; } r -= I_IN;
        if (r < I_OUT) { tr_item(a.wout, D, 32 * (r % 32), 64 * (r / 32), nullptr, WOUT, D, 32 * (r % 32), scr, lane); continue; } r -= I_OUT;
        if (r < I_UP) { up_item(a.w1b, a.w3b, a.g2, W13B, r, scr, lane); continue; } r -= I_UP;
        tr_item(a.w2b, D, 32 * (r % 32), 64 * (r / 32), nullptr, W2B, FF, 32 * (r % 32), scr, lane);
    }
}
constexpr int IT_W13A = 0, IT_W2A = 2816, IT_W13B = 6272, IT_W2B = 9088, IT_END = 10496;
__device__ __forceinline__ void gate_cols(const Args& a, int tidx, int nthr) {
    bf16* WGA = (bf16*)(a.ws + WS_WGA);
    for (int item = tidx; item < 16 * 128; item += nthr) {
        const int r = item & 15, kc = item >> 4; float o[8];
#pragma unroll
        for (int i = 0; i < 8; ++i) { const int k = 8 * kc + i; o[i] = a.win[(size_t)k * DIN_SRC + 1536 + r] * a.gm[k]; }
        u32x4 w; w.x = pk2(o[0], o[1]); w.y = pk2(o[2], o[3]); w.z = pk2(o[4], o[5]); w.w = pk2(o[6], o[7]);
        *(u32x4*)(WGA + (size_t)r * D + 8 * kc) = w;
    }
}
__device__ __forceinline__ void ga_job(LAS unsigned char* L, const bf16* XN, const bf16* WGA, const float* ss, float* GA, int tid, int G) {
    const int lane = tid & 63, w = tid >> 6, c = lane & 15, quad = lane >> 4, mt = w & 3, kh = w >> 2;
    for (int rb = blockIdx.x; rb < M / 64; rb += G) {
        const bf16* ap = XN + (size_t)(rb * 64 + 16 * mt + c) * D + kh * 512 + 8 * quad; const bf16* bp = WGA + (size_t)c * D + kh * 512 + 8 * quad;
        f32x4 acc = {0.f, 0.f, 0.f, 0.f};
        {   bf16x8 af[16], bfr[16];
#pragma unroll
            for (int ks = 0; ks < 16; ++ks) { af[ks] = *(const bf16x8*)(ap + ks * 32); bfr[ks] = *(const bf16x8*)(bp + ks * 32); }
#pragma unroll
            for (int ks = 0; ks < 16; ++ks) acc = MFMA16(af[ks], bfr[ks], acc);
        }
        LAS float* P = (LAS float*)L;
#pragma unroll
        for (int i = 0; i < 4; ++i) P[(kh * 64 + 16 * mt + 4 * quad + i) * 16 + c] = acc[i];
        __syncthreads();
        { const int row = tid >> 3, r2 = (tid & 7) * 2; const float rs = __builtin_amdgcn_rsqf(ss[rb * 64 + row] * (1.0f / 1024.0f) + EPS);
          f32x2 o; o.x = (P[row * 16 + r2] + P[(64 + row) * 16 + r2]) * rs; o.y = (P[row * 16 + r2 + 1] + P[(64 + row) * 16 + r2 + 1]) * rs;
          *(f32x2*)(GA + (size_t)(rb * 64 + row) * 16 + r2) = o; }
        __syncthreads();
    }
}
__device__ __forceinline__ void light_wg(int nunits, int G, int& idx, int& nlight) { const int rem = nunits % G; nlight = rem ? G - rem : G; idx = rem ? (int)blockIdx.x - rem : (int)blockIdx.x; }
__device__ __forceinline__ void p0_xn(const Args& a, int lane, int wave) {
    unsigned char* ws = a.ws;
    const int gw = blockIdx.x * NWAVES + wave, NGW = gridDim.x * NWAVES;
    bf16* XN = (bf16*)(ws + WS_XN); float* SS0 = (float*)(ws + WS_SS0);
    for (int m0 = gw * 8; m0 < M; m0 += NGW * 8) {
        f32x4 v[8][4];
#pragma unroll
        for (int r = 0; r < 8; ++r) { const f32x4* xr = (const f32x4*)(a.x + (size_t)(m0 + r) * D) + lane;
#pragma unroll
            for (int j = 0; j < 4; ++j) v[r][j] = __builtin_nontemporal_load(xr + 64 * j); }
#pragma unroll
        for (int r = 0; r < 8; ++r) { unsigned long long* o8 = (unsigned long long*)(XN + (size_t)(m0 + r) * D) + lane; float s = 0.f;
#pragma unroll
            for (int j = 0; j < 4; ++j) { const f32x4 x4 = v[r][j]; s += (x4[0] * x4[0] + x4[1] * x4[1]) + (x4[2] * x4[2] + x4[3] * x4[3]);
                o8[64 * j] = (unsigned long long)pk2(x4[0], x4[1]) | ((unsigned long long)pk2(x4[2], x4[3]) << 32); }
            s = wave_sum(s); if (lane == 0) SS0[m0 + r] = s; }
    }
}
__device__ __forceinline__ void p0_cs(const Args& a, int tidx, int nthr) {
    unsigned char* ws = a.ws;
    float* CS = (float*)(ws + WS_CS);
    for (int e = tidx; e < M * 8; e += nthr) {
        const int tok = e >> 3, i = e & 7;
        const float inv = i == 0 ? 1.0f : i == 1 ? 0.1939227432012558f : i == 2 ? 0.03760603070259094f : i == 3 ? 0.007292664609849453f : i == 4 ? 0.0014142135623842478f : i == 5 ? 0.00027424818836152554f : i == 6 ? 5.318296098266728e-05f : 1.0313386155758053e-05f;
        const float ang = (float)a.pos[tok] * inv;
        const double ad = (double)ang, kq = __builtin_rint(ad * 0.15915494309189535), rd = ad - kq * 6.283185307179586;
        const float rr = (float)rd;
        CS[tok * 16 + i] = cosf(rr); CS[tok * 16 + 8 + i] = sinf(rr);
    }
}

constexpr int AT_KS = 0, AT_VS = 384 * 144, AT_BYTES = 2 * 384 * 144;
static_assert(AT_BYTES <= RING_BYTES, "attention LDS");
typedef short v4i16_t __attribute__((ext_vector_type(4)));
__device__ __forceinline__ s16x4 tr16(const LAS unsigned char* p) { return __builtin_amdgcn_ds_read_tr16_b64_v4i16((LAS v4i16_t*)p); }
struct AttnRegs { u32x4 k[6], v[6]; bf16x8 q[2][2]; };
struct AttnCoord { int br, dl, tokb, h, n2; };
__device__ __forceinline__ AttnCoord attn_coord(int U) {
    AttnCoord c; c.br = U >> 9; const int rem = U & 511, b = rem >> 8, idx = rem & 31; c.h = (rem >> 5) & 7; c.dl = 2 * c.br; const int pl = 5 - c.dl;
    c.tokb = b * SEQ + (idx >> pl); c.n2 = idx & ((1 << pl) - 1); return c;
}
__device__ __forceinline__ void attn_load(AttnRegs& R, int U, const bf16* PA, int tid) {
    const AttnCoord c = attn_coord(U); const int ch = tid & 7, r0 = tid >> 3, jq0 = 256 * c.n2, jk0 = jq0 - 128;
    const int lane = tid & 63, w = tid >> 6, cc = lane & 15, quad = lane >> 4;
#pragma unroll
    for (int p = 0; p < 6; ++p) { const int j = jk0 + r0 + 64 * p; const bool valid = j >= 0; const int tok = c.tokb + ((valid ? j : 0) << c.dl);
        const bf16* src = PA + (size_t)tok * LDA + 512 + c.h * 64 + ch * 8;
        R.k[p] = (u32x4){0u, 0u, 0u, 0u}; R.v[p] = (u32x4){0u, 0u, 0u, 0u};
        if (valid) { R.k[p] = *(const u32x4*)src; R.v[p] = *(const u32x4*)(src + 512); } }
#pragma unroll
    for (int qa = 0; qa < 2; ++qa) { const int tok = c.tokb + ((jq0 + 32 * w + 16 * qa + cc) << c.dl);
#pragma unroll
        for (int ks = 0; ks < 2; ++ks) R.q[qa][ks] = *(const bf16x8*)(PA + (size_t)tok * LDA + c.h * 64 + ks * 32 + quad * 8); }
}
__device__ __forceinline__ void attn_store(const AttnRegs& R, LAS unsigned char* L, int tid) {
    const int ch = tid & 7, r0 = tid >> 3;
#pragma unroll
    for (int p = 0; p < 6; ++p) { *(LAS u32x4*)(L + AT_KS + (r0 + 64 * p) * 144 + ch * 16) = R.k[p]; *(LAS u32x4*)(L + AT_VS + (r0 + 64 * p) * 144 + ch * 16) = R.v[p]; }
}
__device__ __forceinline__ void attn_compute(LAS unsigned char* L, int U, const bf16x8 (&qf)[2][2], bf16* OB, float* LSE, int tid) {
    const AttnCoord cd = attn_coord(U); const int jq0 = 256 * cd.n2;
    const int lane = tid & 63, w = tid >> 6, c = lane & 15, quad = lane >> 4;
    const int kbase = 32 * w;
    f32x4 sa[10], sb[10];
#pragma unroll
    for (int t = 0; t < 10; ++t) { sa[t] = (f32x4){0.f, 0.f, 0.f, 0.f}; sb[t] = (f32x4){0.f, 0.f, 0.f, 0.f}; }
    {
        const LAS unsigned char* kp = L + AT_KS + (kbase + c) * 144 + quad * 16;
        bf16x8 kf[2][2];
#pragma unroll
        for (int ks = 0; ks < 2; ++ks) kf[0][ks] = *(const LAS bf16x8*)(kp + ks * 64);
#pragma unroll
        for (int t = 0; t < 10; ++t) {
            if (t + 1 < 10) {
#pragma unroll
                for (int ks = 0; ks < 2; ++ks) kf[(t + 1) & 1][ks] = *(const LAS bf16x8*)(kp + (16 * (t + 1)) * 144 + ks * 64); }
            __builtin_amdgcn_sched_barrier(0);
#pragma unroll
            for (int ks = 0; ks < 2; ++ks) { if (t != 9) sa[t] = MFMA16(kf[t & 1][ks], qf[0][ks], sa[t]); if (t != 0) sb[t] = MFMA16(kf[t & 1][ks], qf[1][ks], sb[t]); }
            __builtin_amdgcn_sched_barrier(0);
        }
    }
#pragma unroll
    for (int i = 0; i < 4; ++i) { const bool lo = 4 * quad + i >= c, hi = 4 * quad + i <= c;
        sa[0][i] = lo ? sa[0][i] : -3.0e38f; sa[8][i] = hi ? sa[8][i] : -3.0e38f; sb[1][i] = lo ? sb[1][i] : -3.0e38f; sb[9][i] = hi ? sb[9][i] : -3.0e38f; }
    if (cd.n2 == 0 && w < 4) {
#pragma unroll
        for (int t = 0; t < 10; ++t)
#pragma unroll
            for (int i = 0; i < 4; ++i) { const bool ex = kbase + 16 * t + 4 * quad + i >= 128; if (t != 9) sa[t][i] = ex ? sa[t][i] : -3.0e38f; if (t != 0) sb[t][i] = ex ? sb[t][i] : -3.0e38f; }
    }
    float ma = -3.0e38f, mb = -3.0e38f;
#pragma unroll
    for (int t = 0; t < 10; ++t) { if (t != 9) ma = fmaxf(fmaxf(ma, fmaxf(sa[t][0], sa[t][1])), fmaxf(sa[t][2], sa[t][3])); if (t != 0) mb = fmaxf(fmaxf(mb, fmaxf(sb[t][0], sb[t][1])), fmaxf(sb[t][2], sb[t][3])); }
    ma = pg8::max_x32(pg8::max_x16(ma)); mb = pg8::max_x32(pg8::max_x16(mb));
    float la = 0.f, lb = 0.f;
#pragma unroll
    for (int t = 0; t < 10; ++t)
#pragma unroll
        for (int i = 0; i < 4; ++i) { if (t != 9) { const float p = __builtin_amdgcn_exp2f(sa[t][i] - ma); sa[t][i] = p; la += p; } if (t != 0) { const float p = __builtin_amdgcn_exp2f(sb[t][i] - mb); sb[t][i] = p; lb += p; } }
    la = pg8::sum_x32(pg8::sum_x16(la)); lb = pg8::sum_x32(pg8::sum_x16(lb));
    f32x4 oa[4], ob[4];
#pragma unroll
    for (int dt = 0; dt < 4; ++dt) { oa[dt] = (f32x4){0.f, 0.f, 0.f, 0.f}; ob[dt] = (f32x4){0.f, 0.f, 0.f, 0.f}; }
    const LAS unsigned char* vb = L + AT_VS + (kbase + 4 * quad + (c >> 2)) * 144 + 8 * (c & 3);
#pragma unroll
    for (int kk = 0; kk < 5; ++kk) {
        u32x4 pa, pb;
        pa.x = pk2(sa[2 * kk][0], sa[2 * kk][1]); pa.y = pk2(sa[2 * kk][2], sa[2 * kk][3]); pa.z = pk2(sa[2 * kk + 1][0], sa[2 * kk + 1][1]); pa.w = pk2(sa[2 * kk + 1][2], sa[2 * kk + 1][3]);
        pb.x = pk2(sb[2 * kk][0], sb[2 * kk][1]); pb.y = pk2(sb[2 * kk][2], sb[2 * kk][3]); pb.z = pk2(sb[2 * kk + 1][0], sb[2 * kk + 1][1]); pb.w = pk2(sb[2 * kk + 1][2], sb[2 * kk + 1][3]);
        const bf16x8 pfa = __builtin_bit_cast(bf16x8, pa), pfb = __builtin_bit_cast(bf16x8, pb);
        s16x4 vl[4], vh[4];
#pragma unroll
        for (int dt = 0; dt < 4; ++dt) { vl[dt] = tr16(vb + (32 * kk) * 144 + dt * 32); vh[dt] = tr16(vb + (32 * kk + 16) * 144 + dt * 32); }
#pragma unroll
        for (int dt = 0; dt < 4; ++dt) {
            const bf16x8 vf = {vl[dt][0], vl[dt][1], vl[dt][2], vl[dt][3], vh[dt][0], vh[dt][1], vh[dt][2], vh[dt][3]};
            oa[dt] = MFMA16(vf, pfa, oa[dt]); ob[dt] = MFMA16(vf, pfb, ob[dt]);
        }
    }
    {   const float inv = 1.0f / la; const int tok = cd.tokb + ((jq0 + 32 * w + c) << cd.dl);
        bf16* orow = OB + ((size_t)cd.br * M + tok) * 512 + cd.h * 64 + ((quad & 1) ? 16 + 4 * (quad - 1) : 4 * quad);
#pragma unroll
        for (int p2 = 0; p2 < 2; ++p2) { u32x2 wa, wb; wa.x = pk2(oa[2 * p2][0] * inv, oa[2 * p2][1] * inv); wa.y = pk2(oa[2 * p2][2] * inv, oa[2 * p2][3] * inv);
            wb.x = pk2(oa[2 * p2 + 1][0] * inv, oa[2 * p2 + 1][1] * inv); wb.y = pk2(oa[2 * p2 + 1][2] * inv, oa[2 * p2 + 1][3] * inv);
            *(u32x4*)(orow + 32 * p2) = pg8::widen_pair(wa, wb, quad & 1); }
        if (quad == 0) LSE[((size_t)cd.br * M + tok) * 8 + cd.h] = (ma + __builtin_amdgcn_logf(la)) * 0.6931471805599453f; }
    {   const float inv = 1.0f / lb; const int tok = cd.tokb + ((jq0 + 32 * w + 16 + c) << cd.dl);
        bf16* orow = OB + ((size_t)cd.br * M + tok) * 512 + cd.h * 64 + ((quad & 1) ? 16 + 4 * (quad - 1) : 4 * quad);
#pragma unroll
        for (int p2 = 0; p2 < 2; ++p2) { u32x2 wa, wb; wa.x = pk2(ob[2 * p2][0] * inv, ob[2 * p2][1] * inv); wa.y = pk2(ob[2 * p2][2] * inv, ob[2 * p2][3] * inv);
            wb.x = pk2(ob[2 * p2 + 1][0] * inv, ob[2 * p2 + 1][1] * inv); wb.y = pk2(ob[2 * p2 + 1][2] * inv, ob[2 * p2 + 1][3] * inv);
            *(u32x4*)(orow + 32 * p2) = pg8::widen_pair(wa, wb, quad & 1); }
        if (quad == 0) LSE[((size_t)cd.br * M + tok) * 8 + cd.h] = (mb + __builtin_amdgcn_logf(lb)) * 0.6931471805599453f; }
}

constexpr int GL_TOT = 0, GL_KT = 2048, GL_V = GL_KT + 9216, GL_QD = GL_V + 64 * 272, GL_SSQ = GL_QD + 9216, GL_GA = GL_SSQ + 512;
struct GateRegs { f32x4 ga0, ga1; float wb[2][8]; float bias[2]; };
__device__ __forceinline__ void gate_load(GateRegs& Gt, int tok0, int h, const float* GA, const float* wa2, const float* ba, int tid) {
    const int lane = tid & 63, w = tid >> 6, c = lane & 15, quad = lane >> 4, tt = w & 3, dp = w >> 2;
    Gt.ga0 = (f32x4){0.f, 0.f, 0.f, 0.f}; Gt.ga1 = Gt.ga0;
#pragma unroll
    for (int p = 0; p < 2; ++p) { Gt.bias[p] = ba[h * 64 + 16 * (2 * dp + p) + c];
#pragma unroll
        for (int j = 0; j < 8; ++j) Gt.wb[p][j] = 0.f; }
    if (quad < 2) {
        const float* gp = GA + (size_t)(tok0 + 16 * tt + c) * 16 + 8 * quad; Gt.ga0 = *(const f32x4*)gp; Gt.ga1 = *(const f32x4*)(gp + 4);
#pragma unroll
        for (int p = 0; p < 2; ++p)
#pragma unroll
            for (int j = 0; j < 8; ++j) Gt.wb[p][j] = wa2[(8 * quad + j) * 256 + h * 64 + 16 * (2 * dp + p) + c];
    }
}
__device__ __forceinline__ void gla_gate(LAS unsigned char* L, const GateRegs& Gt, int tid, float (&la)[8]) {
    const int lane = tid & 63, w = tid >> 6, c = lane & 15, quad = lane >> 4, tt = w & 3, dp = w >> 2, seg = tid >> 6, d = tid & 63;
    u32x4 aw; aw.x = pk2(Gt.ga0[0], Gt.ga0[1]); aw.y = pk2(Gt.ga0[2], Gt.ga0[3]); aw.z = pk2(Gt.ga1[0], Gt.ga1[1]); aw.w = pk2(Gt.ga1[2], Gt.ga1[3]);
    const bf16x8 af = __builtin_bit_cast(bf16x8, aw);
    LAS float* LA = (LAS float*)(L + GL_GA);
#pragma unroll
    for (int p = 0; p < 2; ++p) {
        u32x4 bw; bw.x = pk2(Gt.wb[p][0], Gt.wb[p][1]); bw.y = pk2(Gt.wb[p][2], Gt.wb[p][3]); bw.z = pk2(Gt.wb[p][4], Gt.wb[p][5]); bw.w = pk2(Gt.wb[p][6], Gt.wb[p][7]);
        const f32x4 z4 = MFMA16(af, __builtin_bit_cast(bf16x8, bw), ((f32x4){0.f, 0.f, 0.f, 0.f}));
        float s4 = 0.f;
#pragma unroll
        for (int i = 0; i < 4; ++i) { const float z = z4[i] + Gt.bias[p]; const float lv = (fminf(z, 0.f) - __logf(1.0f + __expf(-fabsf(z)))) * (1.0f / 16.0f);
            LA[(16 * tt + 4 * quad + i) * 65 + 16 * (2 * dp + p) + c] = lv; s4 += lv; }
        const float s8 = pg8::sum_x16(s4);
        if ((quad & 1) == 0) ((LAS float*)(L + GL_TOT))[(2 * tt + (quad >> 1)) * 64 + 16 * (2 * dp + p) + c] = s8;
    }
    __syncthreads();
#pragma unroll
    for (int i = 0; i < 8; ++i) la[i] = LA[(8 * seg + i) * 65 + d];
}
__device__ __forceinline__ void gla_gate_prefix(LAS unsigned char* L, const GateRegs& Gt, int tid, float (&bb)[8], float& blast) {
    const int seg = tid >> 6, d = tid & 63;
    float la[8]; gla_gate(L, Gt, tid, la);
    const LAS float* tot = (const LAS float*)(L + GL_TOT);
    float off = 0.f, all = 0.f;
#pragma unroll
    for (int sgi = 0; sgi < 8; ++sgi) { const float v = tot[sgi * 64 + d]; all += v; off += (sgi < seg) ? v : 0.f; }
    float run = off;
#pragma unroll
    for (int i = 0; i < 8; ++i) { run += la[i]; bb[i] = run; }
    blast = all;
}
__device__ __forceinline__ void gla_prefix(LAS unsigned char* L, const float (&la)[8], int tid, float (&bb)[8], float& blast) {
    const int seg = tid >> 6, d = tid & 63; float run = 0.f;
#pragma unroll
    for (int i = 0; i < 8; ++i) { run += la[i]; bb[i] = run; }
    LAS float* tot = (LAS float*)(L + GL_TOT);
    tot[seg * 64 + d] = run;
    __syncthreads();
    float off = 0.f, all = 0.f;
#pragma unroll
    for (int s = 0; s < 8; ++s) { const float v = tot[s * 64 + d]; all += v; off += (s < seg) ? v : 0.f; }
#pragma unroll
    for (int i = 0; i < 8; ++i) bb[i] += off;
    blast = all;
}
__device__ __forceinline__ int gla_first_unit(int G) { if ((G & 7) == 0) { const int n = (int)blockIdx.x >> 3; return n < 128 ? ((int)blockIdx.x & 7) * 128 + n : 1024; } return (int)blockIdx.x; }
__device__ __forceinline__ int gla_next_unit(int unit, int G) { if ((G & 7) == 0) { const int st = G >> 3; return ((unit & 127) + st < 128) ? unit + st : 1024; } return unit + G; }
struct GlaURegs { unsigned short kr[8]; u32x4 vr[2]; GateRegs gt; };
__device__ __forceinline__ void gla_u_load(GlaURegs& R, int unit, const bf16* PG, const float* GA, const float* wa2, const float* ba, int tid) {
    const int bh = unit >> 7, n = unit & 127, b = bh >> 2, h = bh & 3, tok0 = b * SEQ + 64 * n, seg = tid >> 6, d = tid & 63;
#pragma unroll
    for (int i = 0; i < 8; ++i) { const bf16* rp = PG + (size_t)(tok0 + 8 * seg + i) * LDG + h * 64 + d; R.kr[i] = rp[256]; }
#pragma unroll
    for (int p = 0; p < 2; ++p) { const int id = tid + 512 * p; R.vr[p] = *(const u32x4*)(PG + (size_t)(tok0 + (id >> 4)) * LDG + 512 + h * 128 + (id & 15) * 8); }
    gate_load(R.gt, tok0, h, GA, wa2, ba, tid);
}
__device__ __forceinline__ void gla_u_phase(LAS unsigned char* L, const bf16* PG, const float* GA, const float* wa2, const float* ba, bf16* UT, float* DEC, int tid, int G) {
    const int lane = tid & 63, w = tid >> 6, c = lane & 15, quad = lane >> 4, seg = tid >> 6, d = tid & 63;
    int unit = gla_first_unit(G);
    GlaURegs R;
    if (unit < 1024) gla_u_load(R, unit, PG, GA, wa2, ba, tid);
    while (unit < 1024) {
        float bb[8], blast; gla_gate_prefix(L, R.gt, tid, bb, blast);
        { float kv[8];
#pragma unroll
          for (int i = 0; i < 8; ++i) kv[i] = bf2f(R.kr[i]) * __expf(blast - bb[i]);
          u32x4 wv; wv.x = pk2(kv[0], kv[1]); wv.y = pk2(kv[2], kv[3]); wv.z = pk2(kv[4], kv[5]); wv.w = pk2(kv[6], kv[7]);
          *(LAS u32x4*)(L + GL_KT + d * 144 + seg * 16) = wv;
          if (seg == 0) DEC[(size_t)unit * 64 + d] = __expf(blast); }
#pragma unroll
        for (int p = 0; p < 2; ++p) { const int id = tid + 512 * p; *(LAS u32x4*)(L + GL_V + (id >> 4) * 272 + (id & 15) * 16) = R.vr[p]; }
        __syncthreads();
        const int nu = gla_next_unit(unit, G);
        if (nu < 1024) gla_u_load(R, nu, PG, GA, wa2, ba, tid);
        f32x4 acc[4];
#pragma unroll
        for (int dt = 0; dt < 4; ++dt) acc[dt] = (f32x4){0.f, 0.f, 0.f, 0.f};
#pragma unroll
        for (int ks = 0; ks < 2; ++ks) {
            const LAS unsigned char* vp = L + GL_V + (32 * ks + 8 * quad + (c >> 2)) * 272 + (16 * w) * 2 + 8 * (c & 3);
            const s16x4 lo = tr16(vp), hi = tr16(vp + 4 * 272);
            const bf16x8 af = {lo[0], lo[1], lo[2], lo[3], hi[0], hi[1], hi[2], hi[3]};
#pragma unroll
            for (int dt = 0; dt < 4; ++dt) { const bf16x8 bfr = *(const LAS bf16x8*)(L + GL_KT + (16 * dt + c) * 144 + ks * 64 + quad * 16); acc[dt] = MFMA16(af, bfr, acc[dt]); } }
        bf16* up = UT + ((size_t)unit * 128 + 16 * w + 4 * quad) * 64 + c;
#pragma unroll
        for (int dt = 0; dt < 4; ++dt)
#pragma unroll
            for (int i = 0; i < 4; ++i) up[i * 64 + 16 * dt] = f2bf(acc[dt][i]);
        __syncthreads();
        unit = nu;
    }
}
struct GlaORegs { unsigned short qr[8], kr[8]; u32x4 vr[2]; GateRegs gt; };
__device__ __forceinline__ void gla_o_load(GlaORegs& R, int unit, const bf16* PG, const float* GA, const float* wa2, const float* ba, int tid) {
    const int bh = unit >> 7, n = unit & 127, b = bh >> 2, h = bh & 3, tok0 = b * SEQ + 64 * n, seg = tid >> 6, d = tid & 63;
#pragma unroll
    for (int i = 0; i < 8; ++i) { const bf16* rp = PG + (size_t)(tok0 + 8 * seg + i) * LDG + h * 64 + d; R.qr[i] = rp[0]; R.kr[i] = rp[256]; }
#pragma unroll
    for (int p = 0; p < 2; ++p) { const int id = tid + 512 * p; R.vr[p] = *(const u32x4*)(PG + (size_t)(tok0 + (id >> 4)) * LDG + 512 + h * 128 + (id & 15) * 8); }
    gate_load(R.gt, tok0, h, GA, wa2, ba, tid);
}
__device__ __forceinline__ void gla_o_phase(LAS unsigned char* L, const bf16* PG, const float* GA, const float* wa2, const float* ba, const bf16* ST, const float* ggla, bf16* OM, int tid, int G) {
    const int lane = tid & 63, w = tid >> 6, c = lane & 15, quad = lane >> 4, seg = tid >> 6, d = tid & 63;
    const int it = w & 3, eh = w >> 2, itok = 16 * it + c;
    int unit = gla_first_unit(G);
    GlaORegs R;
    if (unit < 1024) gla_o_load(R, unit, PG, GA, wa2, ba, tid);
    while (unit < 1024) {
        const int bh = unit >> 7, n = unit & 127, b = bh >> 2, h = bh & 3, tok0 = b * SEQ + 64 * n;
        const size_t trow = (size_t)(tok0 + itok);
        bf16x8 sf[4][2]; u32x2 rv[4]; f32x4 gg[4];
#pragma unroll
        for (int e4 = 0; e4 < 4; ++e4) { const int et = 4 * eh + e4;
#pragma unroll
            for (int ks = 0; ks < 2; ++ks) sf[e4][ks] = *(const bf16x8*)(ST + ((size_t)unit * 128 + 16 * et + c) * 64 + 32 * ks + 8 * quad);
            rv[e4] = *(const u32x2*)(PG + trow * LDG + 1024 + h * 128 + 16 * et + 4 * quad); gg[e4] = *(const f32x4*)(ggla + h * 128 + 16 * et + 4 * quad); }
        float bb[8], blast; gla_gate_prefix(L, R.gt, tid, bb, blast);
#pragma unroll
        for (int i = 0; i < 8; ++i) { const int t = 8 * seg + i;
            const float qv = bf2f(R.qr[i]) * 0.125f * __expf(bb[i]), kv = bf2f(R.kr[i]) * __expf(-bb[i]);
            *(LAS unsigned short*)(L + GL_QD + t * 144 + d * 2) = f2bf(qv); *(LAS unsigned short*)(L + GL_KT + t * 144 + d * 2) = f2bf(kv); }
#pragma unroll
        for (int p = 0; p < 2; ++p) { const int id = tid + 512 * p; *(LAS u32x4*)(L + GL_V + (id >> 4) * 272 + (id & 15) * 16) = R.vr[p]; }
        __syncthreads();
        const int nu = gla_next_unit(unit, G);
        if (nu < 1024) gla_o_load(R, nu, PG, GA, wa2, ba, tid);
        bf16x8 qf[2];
#pragma unroll
        for (int ks = 0; ks < 2; ++ks) qf[ks] = *(const LAS bf16x8*)(L + GL_QD + itok * 144 + ks * 64 + quad * 16);
        f32x4 at[4];
#pragma unroll
        for (int jt = 0; jt < 4; ++jt) { at[jt] = (f32x4){0.f, 0.f, 0.f, 0.f};
#pragma unroll
            for (int ks = 0; ks < 2; ++ks) { const bf16x8 kf = *(const LAS bf16x8*)(L + GL_KT + (16 * jt + c) * 144 + ks * 64 + quad * 16); at[jt] = MFMA16(kf, qf[ks], at[jt]); }
#pragma unroll
            for (int i = 0; i < 4; ++i) at[jt][i] = (16 * jt + 4 * quad + i <= itok) ? at[jt][i] : 0.f; }
        bf16x8 pf[2];
#pragma unroll
        for (int kk = 0; kk < 2; ++kk) { u32x4 pw; pw.x = pk2(at[2 * kk][0], at[2 * kk][1]); pw.y = pk2(at[2 * kk][2], at[2 * kk][3]); pw.z = pk2(at[2 * kk + 1][0], at[2 * kk + 1][1]); pw.w = pk2(at[2 * kk + 1][2], at[2 * kk + 1][3]);
            pf[kk] = __builtin_bit_cast(bf16x8, pw); }
        f32x4 o[4]; float ssq = 0.f;
        const LAS unsigned char* vb = L + GL_V + (4 * quad + (c >> 2)) * 272 + 8 * (c & 3);
#pragma unroll
        for (int e4 = 0; e4 < 4; ++e4) { const int et = 4 * eh + e4; f32x4 acc = {0.f, 0.f, 0.f, 0.f};
#pragma unroll
            for (int kk = 0; kk < 2; ++kk) { const s16x4 lo = tr16(vb + (32 * kk) * 272 + et * 32), hi = tr16(vb + (32 * kk + 16) * 272 + et * 32);
                const bf16x8 vf = {lo[0], lo[1], lo[2], lo[3], hi[0], hi[1], hi[2], hi[3]};
                acc = MFMA16(vf, pf[kk], acc); }
#pragma unroll
            for (int ks = 0; ks < 2; ++ks) acc = MFMA16(sf[e4][ks], qf[ks], acc);
            o[e4] = acc; ssq += (acc[0] * acc[0] + acc[1] * acc[1]) + (acc[2] * acc[2] + acc[3] * acc[3]); }
        ssq = pg8::sum_x32(pg8::sum_x16(ssq));
        LAS float* SSQ = (LAS float*)(L + GL_SSQ);
        if (quad == 0) SSQ[eh * 64 + itok] = ssq;
        __syncthreads();
        const float rstd = __builtin_amdgcn_rsqf((SSQ[itok] + SSQ[64 + itok]) * (1.0f / 128.0f) + EPS);
        u32x2 wv4[4];
#pragma unroll
        for (int e4 = 0; e4 < 4; ++e4) { const f32x4 g = gg[e4];
            const float r0 = __uint_as_float(rv[e4].x << 16), r1 = __uint_as_float(rv[e4].x & 0xffff0000u), r2 = __uint_as_float(rv[e4].y << 16), r3 = __uint_as_float(rv[e4].y & 0xffff0000u);
            wv4[e4].x = pk2(o[e4][0] * rstd * g[0] * pg8::silu_f(r0), o[e4][1] * rstd * g[1] * pg8::silu_f(r1)); wv4[e4].y = pk2(o[e4][2] * rstd * g[2] * pg8::silu_f(r2), o[e4][3] * rstd * g[3] * pg8::silu_f(r3)); }
        { bf16* orow = OM + trow * D + h * 128 + 64 * eh + ((quad & 1) ? 16 + 4 * (quad - 1) : 4 * quad);
#pragma unroll
          for (int p2 = 0; p2 < 2; ++p2) *(u32x4*)(orow + 32 * p2) = pg8::widen_pair(wv4[2 * p2], wv4[2 * p2 + 1], quad & 1); }
        __syncthreads();
        unit = nu;
    }
}

#define XB_TMO      128
#define XB_XCNT(j)  (256  + 64 * (j))
#define XB_XSUB(j)  (1280 + 64 * (j))
#define XB_XGEN(j)  (2304 + 64 * (j))
#define XB_TOP      3328
#define XB_TOPGEN   3392
#define XCD_BAR_WORDS 3456
#define XB_SPIN_CAP (1u << 18)

__device__ __forceinline__ unsigned xb_ld(unsigned* p)              { return __hip_atomic_load(p, __ATOMIC_RELAXED, __HIP_MEMORY_SCOPE_AGENT); }
__device__ __forceinline__ unsigned xb_add(unsigned* p, unsigned v) { return __hip_atomic_fetch_add(p, v, __ATOMIC_RELAXED, __HIP_MEMORY_SCOPE_AGENT); }
__device__ __forceinline__ unsigned xb_xcc_id() { return (unsigned)__builtin_amdgcn_s_getreg((3 << 11) | 20) & 0xFu; }
#define XB_SPIN(cond, bar) do { unsigned _sp = 0; while (cond) { __builtin_amdgcn_s_sleep(1); \
    if ((++_sp & 255u) == 0u) { if (xb_ld(&(bar)[XB_TMO])) break; if (_sp > XB_SPIN_CAP) { atomicAdd(&(bar)[XB_TMO], 1u); break; } } } } while (0)

struct XcdBarrier {
    unsigned* bar; unsigned x;
    volatile LAS unsigned* st;
};

__device__ __forceinline__ XcdBarrier xcd_barrier_post(unsigned* bar, volatile LAS unsigned* st) {
    XcdBarrier b; b.bar = bar; b.x = xb_xcc_id(); b.st = st;
    if (threadIdx.x == 0) (void)xb_add(&bar[XB_XCNT(b.x)], 1u);
    return b;
}
__device__ __forceinline__ void xcd_barrier_complete(unsigned* bar, unsigned x, unsigned& nloc, unsigned& nx) {
    const unsigned G = gridDim.x * gridDim.y * gridDim.z;
    unsigned sum, cnt, mine, sp = 0u;
    for (;;) {
        sum = 0u; cnt = 0u; mine = 0u;
#pragma unroll
        for (unsigned j = 0; j < 16; ++j) { const unsigned c = xb_ld(&bar[XB_XCNT(j)]); sum += c; cnt += (c > 0u) ? 1u : 0u; mine = (j == x) ? c : mine; }
        if (sum == G) break;
        __builtin_amdgcn_s_sleep(1);
        if ((++sp & 255u) == 0u) { if (xb_ld(&bar[XB_TMO])) break; if (sp > XB_SPIN_CAP) { atomicAdd(&bar[XB_TMO], 1u); break; } }
    }
    nloc = mine > 0u ? mine : 1u; nx = cnt > 0u ? cnt : 1u;
}

__device__ __forceinline__ void xcd_barrier(const XcdBarrier& b) {
    asm volatile("s_waitcnt vmcnt(0)" ::: "memory");
    __syncthreads();
    if (threadIdx.x == 0) {
        unsigned* bar = b.bar;
        __builtin_amdgcn_s_waitcnt(0);
        unsigned nloc = b.st[0], nx = b.st[1];
        if (nloc == 0u) { xcd_barrier_complete(bar, b.x, nloc, nx); b.st[0] = nloc; b.st[1] = nx; }
        const unsigned old = xb_add(&bar[XB_XSUB(b.x)], 1u);
        const unsigned gen = old / nloc;
        if (old + 1u == (gen + 1u) * nloc) {
            __builtin_amdgcn_fence(__ATOMIC_RELEASE, "agent");
            asm volatile("s_waitcnt vmcnt(0)" ::: "memory");
            const unsigned og = xb_add(&bar[XB_TOP], 1u);
            const unsigned tg = og / nx;
            if (og + 1u == (tg + 1u) * nx) xb_add(&bar[XB_TOPGEN], 1u);
            else XB_SPIN(xb_ld(&bar[XB_TOPGEN]) == tg, bar);
            __builtin_amdgcn_fence(__ATOMIC_ACQUIRE, "agent");
            xb_add(&bar[XB_XGEN(b.x)], 1u);
            asm volatile("s_waitcnt vmcnt(0)" ::: "memory");
        } else {
            XB_SPIN(xb_ld(&bar[XB_XGEN(b.x)]) == gen, bar);
            __builtin_amdgcn_fence(__ATOMIC_ACQUIRE, "agent");
            asm volatile("s_waitcnt vmcnt(0)" ::: "memory");
        }
    }
    __syncthreads();
}

constexpr unsigned ATT_END = 0xffffffffu;
__device__ __forceinline__ unsigned attn_unit_of(unsigned q, unsigned t) {
    const unsigned bh = 2u * q + t / 96u, wi = t % 96u, c4 = wi / 48u, w48 = wi % 48u;
    unsigned br, idx;
    if (w48 < 16u) { br = 2u; idx = (w48 << 1) | c4; }
    else { const unsigned w32 = w48 - 16u, c1 = w32 >> 3, w8 = w32 & 7u;
        if (w8 < 4u) { br = 1u; idx = (w8 << 3) | (4u * c4 + c1); } else { br = 0u; idx = 16u * c4 + 4u * c1 + (w8 - 4u); } }
    return br * 512u + bh * 32u + idx;
}
__device__ __forceinline__ unsigned attn_draw(unsigned* qctr, unsigned x0, volatile LAS unsigned* qoffp) {
    unsigned qoff = *qoffp;
    while (qoff < 8u) { const unsigned q = (x0 + qoff) & 7u, t = atomicAdd(qctr + 64u * q, 1u); if (t < 192u) { *qoffp = qoff; return attn_unit_of(q, t); } ++qoff; }
    *qoffp = qoff; return ATT_END;
}
__global__ void __launch_bounds__(NTHR, 2) layer_fwd(Args a) {
    extern __shared__ __attribute__((aligned(16))) unsigned char lds_raw[];
    cg::grid_group grid = cg::this_grid();
    LAS unsigned char* lds = (LAS unsigned char*)lds_raw;
    const int tid = threadIdx.x, lane = tid & 63, wave = __builtin_amdgcn_readfirstlane(tid >> 6);
    const int G = gridDim.x;
    unsigned char* ws = a.ws;
    bf16* XN = (bf16*)(ws + WS_XN); bf16* HB = (bf16*)(ws + WS_H); bf16* PG = (bf16*)(ws + WS_PG); bf16* PA = (bf16*)(ws + WS_PA); bf16* OM = (bf16*)(ws + WS_OM); bf16* OB = (bf16*)(ws + WS_OB);
    bf16* ST = (bf16*)(ws + WS_ST); bf16* UT = (bf16*)a.out;     float* DEC = (float*)(ws + WS_DEC); float* LSE = (float*)(ws + WS_LSE); float* CS = (float*)(ws + WS_CS);
    float* GA = (float*)(ws + WS_GA); float* SS0 = (float*)(ws + WS_SS0); float* SS1 = (float*)(ws + WS_SS1); float* SS2 = (float*)(ws + WS_SS2);
    unsigned* CTR = (unsigned*)(ws + WS_CTL);
    if (tid < 32) ((LAS unsigned*)(lds + MISC_OFF))[tid] = 0u;
    __syncthreads();
    if (a.use_cg_sync) grid.sync();
    const XcdBarrier bar = xcd_barrier_post((unsigned*)(ws + WS_BAR), (volatile LAS unsigned*)(lds + MISC_OFF) + 8);
    unsigned long long ts0 = 0, ts1 = 0; STAMP(0);

    p0_xn(a, lane, wave);
    conv_items(a, lds, IT_W13A, IT_W2A, blockIdx.x * NWAVES + wave, G * NWAVES, lane, wave);
    GSYNC(); STAMP(1);
    { pg8::Gemm g{XN, (const bf16*)(ws + WS_W13A), M, NUP, D}; pg8::SsOrder S; S.init(M, NUP, G, (int)blockIdx.x); S.ss = SS0; S.slots = lds + MISC_OFF + 4096; S.k = 0;
      pg8::EpiSwiglu E{HB, FF, lds + MISC_OFF + 4096, 0};
      for (int rp = 0; rp < REP_UP; ++rp) pg8::gemm_phase<pg8::EpiSwiglu, pg8::SsOrder, true, true>(lds, g, S, E); }
    { int li, nl; light_wg((M / 256) * (NUP / 256), G, li, nl);
      if (li >= 0) { p0_cs(a, li * NTHR + tid, nl * NTHR); conv_items(a, lds, IT_W2A, IT_W13B, li * NWAVES + wave, nl * NWAVES, lane, wave); gate_cols(a, li * NTHR + tid, nl * NTHR); } }
    GSYNC(); STAMP(2);
    { pg8::Gemm g{HB, (const bf16*)(ws + WS_W2A), M, D, FF}; pg8::StaticOrder S; S.init(M, D, G, (int)blockIdx.x);
      pg8::EpiResidB<true> E{XN, XN, SS1, 0.5f, D};
      pg8::gemm_phase<pg8::EpiResidB<true>, pg8::StaticOrder, true, true>(lds, g, S, E); }
    GSYNC(); STAMP(3);
    { pg8::Gemm g{XN, (const bf16*)(ws + WS_WIN), M, NIN, D}; pg8::SsOrder S; S.init(M, NIN, G, (int)blockIdx.x); S.ss = SS1; S.slots = lds + MISC_OFF + 4096; S.k = 0;
      pg8::EpiProj E{PG, PA, lds + MISC_OFF + 4096, CS, 0};
      ga_job(lds, XN, (const bf16*)(ws + WS_WGA), SS1, GA, tid, G);
      for (int rp = 0; rp < REP_IN; ++rp) pg8::gemm_phase<pg8::EpiProj, pg8::SsOrder, true, true>(lds, g, S, E); }
    GSYNC(); STAMP(4);
    for (int rp = 0; rp < REP_MIX; ++rp) {
    gla_u_phase(lds, PG, GA, a.wa2, a.ba, UT, DEC, tid, G);
    GSYNC(); STAMP(5);
    const bool xal = (G & 7) == 0; const int sstep = xal ? (G >> 3) : G, slim = xal ? 64 : 512, sbase = xal ? ((int)blockIdx.x & 7) * 64 : 0;
    for (int sl0 = xal ? ((int)blockIdx.x >> 3) : (int)blockIdx.x; sl0 < slim; sl0 += 2 * sstep) {
        const int sg = tid >> 7, cl = tid & 127;
        float uu[2][32], dd[2][32]; bf16* sp[2];
#pragma unroll
        for (int j = 0; j < 2; ++j) {
            const int set = sbase + ((sl0 + j * sstep < slim) ? sl0 + j * sstep : sl0);
            const int gcol = set * 128 + cl, bh = gcol >> 13, ed = gcol & 8191, d = ed & 63;
            const bf16* up = UT + ((size_t)bh * 128 + 32 * sg) * 8192 + ed; const float* dp = DEC + ((size_t)bh * 128 + 32 * sg) * 64 + d; sp[j] = ST + ((size_t)bh * 128 + 32 * sg) * 8192 + ed;
#pragma unroll
            for (int k = 0; k < 32; ++k) { uu[j][k] = bf2f(up[(size_t)k * 8192]); dd[j][k] = dp[k * 64]; }
        }
        LAS f32x2* agg = (LAS f32x2*)lds;
#pragma unroll
        for (int j = 0; j < 2; ++j) { float S = 0.f, P = 1.f;
#pragma unroll
            for (int k = 0; k < 32; ++k) { S = dd[j][k] * S + uu[j][k]; P *= dd[j][k]; }
            agg[(j * 4 + sg) * 128 + cl] = (f32x2){P, S}; }
        __syncthreads();
#pragma unroll
        for (int j = 0; j < 2; ++j) { float st = 0.f;
#pragma unroll
            for (int q = 0; q < 3; ++q) { const f32x2 ag = agg[(j * 4 + q) * 128 + cl]; if (q < sg) st = ag.x * st + ag.y; }
#pragma unroll
            for (int k = 0; k < 32; ++k) { sp[j][(size_t)k * 8192] = f2bf(st); st = dd[j][k] * st + uu[j][k]; } }
        __syncthreads();
    }
    {
        volatile LAS unsigned* nxt = (volatile LAS unsigned*)(lds + MISC_OFF);
        constexpr unsigned NCONV = (IT_W2B - IT_W13B) / 8;
        for (;;) {
            if (tid == 0) nxt[0] = atomicAdd(CTR + 64 * rp, 1u);
            __syncthreads();
            const unsigned t = nxt[0];
            __syncthreads();
            if (t >= NCONV) break;
            const int lo = IT_W13B + 8 * (int)t;
            conv_items(a, lds, lo, lo + 8, wave, NWAVES, lane, wave);
        }
        unsigned* qctr = CTR + 64 * (2 + 8 * rp); const unsigned x0 = bar.x & 7u;
        if (tid == 0) { nxt[4] = 0u; nxt[0] = attn_draw(qctr, x0, nxt + 4); nxt[1] = attn_draw(qctr, x0, nxt + 4); }
        __syncthreads();
        unsigned u = nxt[0], un = nxt[1];
        AttnRegs R;
        if (u != ATT_END) attn_load(R, (int)u, PA, tid);
        while (u != ATT_END) {
            attn_store(R, lds, tid);
            bf16x8 qf[2][2];
#pragma unroll
            for (int qa = 0; qa < 2; ++qa)
#pragma unroll
                for (int ks = 0; ks < 2; ++ks) qf[qa][ks] = R.q[qa][ks];
            unsigned tk = 0u;
            if (tid == 0) tk = attn_draw(qctr, x0, nxt + 4);
            __syncthreads();
            if (un != ATT_END) attn_load(R, (int)un, PA, tid);
            attn_compute(lds, (int)u, qf, OB, LSE, tid);
            if (tid == 0) nxt[2] = tk;
            __syncthreads();
            u = un; un = nxt[2];
        }
    }
    GSYNC(); STAMP(6);
    }
    for (int rp = 0; rp < REP_MIXC; ++rp) {
    gla_o_phase(lds, PG, GA, a.wa2, a.ba, ST, a.ggla, OM, tid, G);
    {
        const f32x4 g0 = *(const f32x4*)(a.gatt + 8 * lane), g1 = *(const f32x4*)(a.gatt + 8 * lane + 4);
        const int hh = lane >> 3;
        for (int tk0 = (blockIdx.x * NWAVES + wave) * 4; tk0 < M; tk0 += G * NWAVES * 4) {
            float ls[4][3]; u32x4 vv[4][3];
#pragma unroll
            for (int q = 0; q < 4; ++q)
#pragma unroll
                for (int r = 0; r < 3; ++r) { ls[q][r] = LSE[((size_t)r * M + tk0 + q) * 8 + hh]; vv[q][r] = *(const u32x4*)(OB + ((size_t)r * M + tk0 + q) * 512 + 8 * lane); }
#pragma unroll
            for (int q = 0; q < 4; ++q) {
                const float mx = fmaxf(ls[q][0], fmaxf(ls[q][1], ls[q][2])); float w0 = __expf(ls[q][0] - mx), w1 = __expf(ls[q][1] - mx), w2 = __expf(ls[q][2] - mx); const float iw = 1.0f / (w0 + w1 + w2); w0 *= iw; w1 *= iw; w2 *= iw;
                float o[8]; float ssq = 0.f;
#pragma unroll
                for (int i = 0; i < 4; ++i) {
                    o[2 * i] = w0 * __uint_as_float(vv[q][0][i] << 16) + w1 * __uint_as_float(vv[q][1][i] << 16) + w2 * __uint_as_float(vv[q][2][i] << 16);
                    o[2 * i + 1] = w0 * __uint_as_float(vv[q][0][i] & 0xffff0000u) + w1 * __uint_as_float(vv[q][1][i] & 0xffff0000u) + w2 * __uint_as_float(vv[q][2][i] & 0xffff0000u);
                    ssq += o[2 * i] * o[2 * i] + o[2 * i + 1] * o[2 * i + 1]; }
                ssq = wave_sum(ssq);
                const float rstd = __builtin_amdgcn_rsqf(ssq * (1.0f / 512.0f) + EPS);
                u32x4 wv; wv.x = pk2(o[0] * rstd * g0[0], o[1] * rstd * g0[1]); wv.y = pk2(o[2] * rstd * g0[2], o[3] * rstd * g0[3]); wv.z = pk2(o[4] * rstd * g1[0], o[5] * rstd * g1[1]); wv.w = pk2(o[6] * rstd * g1[2], o[7] * rstd * g1[3]);
                *(u32x4*)(OM + (size_t)(tk0 + q) * D + 512 + 8 * lane) = wv;
            }
        }
    }
    GSYNC(); STAMP(7);
    }
    { pg8::Gemm g{OM, (const bf16*)(ws + WS_WOUT), M, D, D}; pg8::StaticOrder S; S.init(M, D, G, (int)blockIdx.x);
      pg8::EpiResidB<true> E{XN, XN, SS2, 1.0f, D};
      pg8::gemm_phase<pg8::EpiResidB<true>, pg8::StaticOrder, true, true>(lds, g, S, E); }
    GSYNC(); STAMP(8);
    { pg8::Gemm g{XN, (const bf16*)(ws + WS_W13B), M, NUP, D}; pg8::SsOrder S; S.init(M, NUP, G, (int)blockIdx.x); S.ss = SS2; S.slots = lds + MISC_OFF + 4096; S.k = 0;
      pg8::EpiSwiglu E{HB, FF, lds + MISC_OFF + 4096, 0};
      pg8::gemm_phase<pg8::EpiSwiglu, pg8::SsOrder, true, true>(lds, g, S, E); }
    { int li, nl; light_wg((M / 256) * (NUP / 256), G, li, nl);
      if (li >= 0) conv_items(a, lds, IT_W2B, IT_END, li * NWAVES + wave, nl * NWAVES, lane, wave); }
    GSYNC(); STAMP(9);
    if (G == (M / 256) * (D / 256)) {
        pg8::Gemm g{HB, (const bf16*)(ws + WS_W2B), M, D, FF}; pg8::StaticOrder S; S.init(M, D, G, (int)blockIdx.x);
        pg8::EpiFinal E{XN, a.out, (float*)(ws + WS_SS3), (unsigned*)(ws + WS_PCNT), a.gf, 0.5f, D, 32u};
        pg8::gemm_phase<pg8::EpiFinal, pg8::StaticOrder, true, true>(lds, g, S, E);
    } else {
        { pg8::Gemm g{HB, (const bf16*)(ws + WS_W2B), M, D, FF}; pg8::StaticOrder S; S.init(M, D, G, (int)blockIdx.x);
          pg8::EpiResidF E{XN, a.out, 0.5f, D};
          pg8::gemm_phase<pg8::EpiResidF, pg8::StaticOrder, true, true>(lds, g, S, E); }
        GSYNC(); STAMP(10);
        for (int m = blockIdx.x * NWAVES + wave; m < M; m += G * NWAVES) {
            f32x4* xr = (f32x4*)(a.out + (size_t)m * D) + lane; f32x4 v[4]; float s = 0.f;
#pragma unroll
            for (int j = 0; j < 4; ++j) { v[j] = xr[64 * j]; s += (v[j][0] * v[j][0] + v[j][1] * v[j][1]) + (v[j][2] * v[j][2] + v[j][3] * v[j][3]); }
            const float rstd = __builtin_amdgcn_rsqf(wave_sum(s) * (1.0f / 1024.0f) + EPS);
#pragma unroll
            for (int j = 0; j < 4; ++j) { const f32x4 g = *((const f32x4*)a.gf + lane + 64 * j); xr[64 * j] = v[j] * rstd * g; }
        }
    }
    if (PROBE_PH >= 0) {
        STAMP(10);
        if (blockIdx.x == 0) { const unsigned long long dt = (ts1 - ts0) * 4ull, t0 = __builtin_amdgcn_s_memrealtime(); while (__builtin_amdgcn_s_memrealtime() - t0 < dt) __builtin_amdgcn_s_sleep(8); }
    }
}

extern "C" void kernel_launch(void* const* d_in, const int* in_sizes, int n_in, void* d_out, int out_size, void* d_ws, size_t ws_size, hipStream_t stream) {
    static int grid = 0;
    if (grid == 0) {
        if (n_in != 18 || in_sizes[0] != M * D || out_size != M * D || ws_size < WS_END) { fprintf(stderr, "kernel_launch: unexpected shapes (n_in %d, in0 %d, out %d, ws %zu)\n", n_in, n_in > 0 ? in_sizes[0] : -1, out_size, ws_size); grid = -1; return; }
        int dev = 0, cus = 0, per_cu = 0;
        if (hipGetDevice(&dev) != hipSuccess || hipDeviceGetAttribute(&cus, hipDeviceAttributeMultiprocessorCount, dev) != hipSuccess) { grid = -1; return; }
        if (hipFuncSetAttribute((const void*)layer_fwd, hipFuncAttributeMaxDynamicSharedMemorySize, LDS_BYTES) != hipSuccess) { fprintf(stderr, "kernel_launch: hipFuncSetAttribute failed\n"); grid = -1; return; }
        if (hipOccupancyMaxActiveBlocksPerMultiprocessor(&per_cu, (const void*)layer_fwd, NTHR, LDS_BYTES) != hipSuccess || per_cu < 1) { fprintf(stderr, "kernel_launch: occupancy query gave %d\n", per_cu); per_cu = 1; }
        (void)hipGetLastError();
        grid = cus * per_cu;
    }
    if (grid < 0) return;
    (void)hipMemsetAsync((char*)d_ws + WS_CTL, 0, CTL_ZERO_BYTES, stream);
    Args a{};
    a.x = (const float*)d_in[0]; a.pos = (const int*)d_in[1]; a.g1 = (const float*)d_in[2]; a.w1a = (const float*)d_in[3]; a.w3a = (const float*)d_in[4]; a.w2a = (const float*)d_in[5];
    a.gm = (const float*)d_in[6]; a.win = (const float*)d_in[7]; a.wa2 = (const float*)d_in[8]; a.ba = (const float*)d_in[9]; a.ggla = (const float*)d_in[10]; a.gatt = (const float*)d_in[11];
    a.wout = (const float*)d_in[12]; a.g2 = (const float*)d_in[13]; a.w1b = (const float*)d_in[14]; a.w3b = (const float*)d_in[15]; a.w2b = (const float*)d_in[16]; a.gf = (const float*)d_in[17];
    a.out = (float*)d_out; a.ws = (unsigned char*)d_ws;
    void* args[] = {&a};
    const hipError_t e = hipLaunchCooperativeKernel((const void*)layer_fwd, dim3(grid), dim3(NTHR), args, LDS_BYTES, stream);
    if (e != hipSuccess) fprintf(stderr, "kernel_launch: cooperative launch failed: %s (grid %d)\n", hipGetErrorString(e), grid);
}
```
